# Optimizing an MI355X kernel written in HIP

```python
import jax, jax.numpy as jnp
from jax import lax
import numpy as np

D_MODEL = 1024
BATCH = 16
SEQ = 256
DEPTH = 1
DEC_BATCH = 4
DEC_SEQ = 2048
PAST_LEN = 256

GRID_W = 64
RET_HEADS = 4
RET_DK = 128
RET_DV = 256
RET_CHUNK = 128
HG_HEADS = 8
HG_DK = 128
HG_DV = 128
HG_CHUNK = 32
D_FF = 2816
N_MOD = 9
ROPE_BASE = 10000.0
EPS = 1e-6
RET_QK = RET_HEADS * RET_DK
RET_V = RET_HEADS * RET_DV
HG_KW = HG_HEADS * HG_DK
HG_VW = HG_HEADS * HG_DV
SPLITS = (RET_QK, RET_QK, RET_V, RET_V, HG_KW, HG_KW, HG_KW, HG_VW, HG_VW, D_MODEL, D_MODEL)
IN_WIDTH = sum(SPLITS)

kernel_name = 'hybrid_retention_hgrn2_diffusion_step'


def rms_norm(x, w):
    xf = x.astype(jnp.float32)
    y = xf * lax.rsqrt(jnp.mean(xf * xf, axis=-1, keepdims=True) + EPS)
    return (y * w.astype(jnp.float32)).astype(x.dtype)


def head_rms(x):
    return x * lax.rsqrt(jnp.mean(x * x, axis=-1, keepdims=True) + EPS)


def modulate(x, shift, scale):
    return x * (1.0 + scale) + shift


def swiglu(h, w13, w2):
    a, b = jnp.split(h @ w13, 2, axis=-1)
    return (jax.nn.silu(a) * b) @ w2


def rope_2d(x, n_tokens):
    rows = n_tokens // GRID_W
    r, cl = jnp.meshgrid(jnp.arange(rows), jnp.arange(GRID_W), indexing='ij')
    r = r.reshape(-1).astype(jnp.float32)
    cl = cl.reshape(-1).astype(jnp.float32)
    half = x.shape[-1] // 2
    quarter = half // 2
    inv_freq = ROPE_BASE ** (-jnp.arange(quarter, dtype=jnp.float32) / quarter)

    def rot(xh, pos):
        ang = pos[:, None] * inv_freq[None, :]
        cos = jnp.cos(ang)[None, :, None, :]
        sin = jnp.sin(ang)[None, :, None, :]
        x1, x2 = jnp.split(xh, 2, axis=-1)
        return jnp.concatenate([x1 * cos - x2 * sin, x2 * cos + x1 * sin], axis=-1)

    return jnp.concatenate([rot(x[..., :half], r), rot(x[..., half:], cl)], axis=-1)


def to_chunks(x, chunk):
    b, n = x.shape[:2]
    return x.reshape(b, n // chunk, chunk, *x.shape[2:]).swapaxes(0, 1)


def from_chunks(y):
    n, b, chunk = y.shape[:3]
    return y.swapaxes(0, 1).reshape(b, n * chunk, *y.shape[3:])


def retention_scan(q, k, v, log_g, s0):
    C = RET_CHUNK
    idx = jnp.arange(C, dtype=jnp.float32)
    diff = idx[:, None] - idx[None, :]
    causal = diff >= 0
    dmat = jnp.where(causal[None], jnp.exp(jnp.where(causal, diff, 0.0)[None] * log_g[:, None, None]), 0.0)
    q_dec = jnp.exp((idx + 1.0)[:, None] * log_g[None, :])
    k_dec = jnp.exp((C - 1.0 - idx)[:, None] * log_g[None, :])
    c_dec = jnp.exp(C * log_g)

    def step(s, inp):
        qc, kc, vc = inp
        scores = jnp.einsum('bihd,bjhd->bhij', qc, kc) * dmat[None]
        o = (jnp.einsum('bhij,bjhe->bihe', scores, vc)
             + jnp.einsum('bihd,bhde->bihe', qc * q_dec[None, :, :, None], s))
        s = c_dec[None, :, None, None] * s + jnp.einsum('bjhd,bjhe->bhde', kc * k_dec[None, :, :, None], vc)
        return s, o

    s_fin, o = lax.scan(step, s0, (to_chunks(q, C), to_chunks(k, C), to_chunks(v, C)))
    return from_chunks(o), s_fin


def gla_scan(q, k, v, log_f, s0):
    C = HG_CHUNK
    tri = jnp.tril(jnp.ones((C, C), dtype=bool))[None, :, :, None, None]

    def step(s, inp):
        qc, kc, vc, gc = inp
        b = jnp.cumsum(gc, axis=1)
        diff = b[:, :, None] - b[:, None, :]
        dec = jnp.where(tri, jnp.exp(jnp.where(tri, diff, 0.0)), 0.0)
        a = jnp.einsum('bthk,bshk,btshk->bhts', qc, kc, dec)
        o = jnp.einsum('bhts,bshv->bthv', a, vc) + jnp.einsum('bthk,bhkv->bthv', qc * jnp.exp(b), s)
        b_last = b[:, -1]
        s = (jnp.exp(b_last)[..., None] * s
             + jnp.einsum('bshk,bshv->bhkv', kc * jnp.exp(b_last[:, None] - b), vc))
        return s, o

    s_fin, o = lax.scan(step, s0, (to_chunks(q, C), to_chunks(k, C), to_chunks(v, C), to_chunks(log_f, C)))
    return from_chunks(o), s_fin


def flip(t):
    return jnp.flip(t, axis=1)


def mixer(h, s0_ret, s0_hg, use_rope, lp):
    f32 = jnp.float32
    B, L, _ = h.shape
    proj = h @ lp['w_in']
    cuts = np.cumsum(SPLITS)[:-1].tolist()
    rq, rk, rv, rg, hq, hff, hfb, hi, hog, gr, gh = jnp.split(proj, cuts, axis=-1)

    rq = rq.reshape(B, L, RET_HEADS, RET_DK).astype(f32)
    rk = rk.reshape(B, L, RET_HEADS, RET_DK).astype(f32)
    rv = rv.reshape(B, L, RET_HEADS, RET_DV).astype(f32)
    if use_rope:
        rq = rope_2d(rq, L)
        rk = rope_2d(rk, L)
    rk = rk * (RET_DK ** -0.5)
    log_gam = jax.nn.log_sigmoid(lp['ret_decay'].astype(f32))
    of, sf = retention_scan(rq, rk, rv, log_gam[0], s0_ret[:, 0])
    ob, sb = retention_scan(flip(rq), flip(rk), flip(rv), log_gam[1], s0_ret[:, 1])
    o_ret = head_rms(of + flip(ob)).reshape(B, L, RET_V) * jax.nn.silu(rg.astype(f32))
    y_ret = o_ret.astype(h.dtype) @ lp['w_ret_proj']

    q = jax.nn.silu(hq.reshape(B, L, HG_HEADS, HG_DK).astype(f32)) * (HG_DK ** -0.5)
    iv = hi.reshape(B, L, HG_HEADS, HG_DV).astype(f32)
    lb = lp['lb'].reshape(2, HG_HEADS, HG_DK)
    f_f = lb[0] + (1.0 - lb[0]) * jax.nn.sigmoid(hff.reshape(B, L, HG_HEADS, HG_DK).astype(f32))
    f_b = lb[1] + (1.0 - lb[1]) * jax.nn.sigmoid(hfb.reshape(B, L, HG_HEADS, HG_DK).astype(f32))
    of2, sf2 = gla_scan(q, 1.0 - f_f, iv, jnp.log(f_f), s0_hg[:, 0])
    ob2, sb2 = gla_scan(flip(q), flip(1.0 - f_b), flip(iv), flip(jnp.log(f_b)), s0_hg[:, 1])
    o_hg = head_rms(of2 + flip(ob2)) * lp['hg_norm_w'].astype(f32).reshape(HG_HEADS, HG_DV)
    o_hg = o_hg.reshape(B, L, HG_VW) * jax.nn.silu(hog.astype(f32))
    y_hg = o_hg.astype(h.dtype) @ lp['w_hg_proj']

    merged = jax.nn.sigmoid(gr) * y_ret + jax.nn.sigmoid(gh) * y_hg
    out = merged @ lp['w_o']
    return out, jnp.stack([sf, sb], axis=1), jnp.stack([sf2, sb2], axis=1)


def trunk_layer(x, mod, s0_ret, s0_hg, use_rope, lp):
    sh1, sc1, g1, sh2, sc2, g2, sh3, sc3, g3 = jnp.split(mod, N_MOD, axis=-1)
    nw = lp['norm_w']
    x = x + 0.5 * g1 * swiglu(modulate(rms_norm(x, nw[0]), sh1, sc1), lp['ffn1_w13'], lp['ffn1_w2'])
    mix, s_ret, s_hg = mixer(modulate(rms_norm(x, nw[1]), sh2, sc2), s0_ret, s0_hg, use_rope, lp)
    x = x + g2 * mix
    x = x + 0.5 * g3 * swiglu(modulate(rms_norm(x, nw[2]), sh3, sc3), lp['ffn2_w13'], lp['ffn2_w2'])
    return x, s_ret, s_hg


def setup_inputs(seed: int = 0) -> dict:
    key = jax.random.key(seed)
    ks = jax.random.split(key, 24)
    f32 = jnp.float32

    def nrm(k, shape, scale):
        return jax.random.normal(k, shape, f32) * scale

    ret_base = jnp.asarray(np.log(2.0 ** (5.0 + np.arange(RET_HEADS)) - 1.0), f32)
    return {
        'x_prompt': nrm(ks[0], (BATCH, SEQ, D_MODEL), 1.0),
        'x_sample': nrm(ks[1], (DEC_BATCH, DEC_SEQ, D_MODEL), 1.0),
        'state_ret': nrm(ks[2], (DEC_BATCH, DEPTH, 2, RET_HEADS, RET_DK, RET_DV), 0.5),
        'state_hgrn': nrm(ks[3], (DEC_BATCH, DEPTH, 2, HG_HEADS, HG_DK, HG_DV), 0.5),
        'c': nrm(ks[4], (DEC_BATCH, D_MODEL), 1.0),
        'c_ctx': nrm(ks[5], (D_MODEL,), 1.0),
        'ada_w': nrm(ks[6], (DEPTH, D_MODEL, N_MOD * D_MODEL), 0.5 * D_MODEL ** -0.5),
        'ada_b': nrm(ks[7], (DEPTH, N_MOD * D_MODEL), 0.01),
        'norm_w': 1.0 + nrm(ks[8], (DEPTH, 3, D_MODEL), 0.01),
        'ffn1_w13': nrm(ks[9], (DEPTH, D_MODEL, 2 * D_FF), D_MODEL ** -0.5),
        'ffn1_w2': nrm(ks[10], (DEPTH, D_FF, D_MODEL), D_FF ** -0.5),
        'ffn2_w13': nrm(ks[11], (DEPTH, D_MODEL, 2 * D_FF), D_MODEL ** -0.5),
        'ffn2_w2': nrm(ks[12], (DEPTH, D_FF, D_MODEL), D_FF ** -0.5),
        'w_in': nrm(ks[13], (DEPTH, D_MODEL, IN_WIDTH), D_MODEL ** -0.5),
        'ret_decay': ret_base[None, None, :] + nrm(ks[14], (DEPTH, 2, RET_HEADS), 0.1),
        'hg_lb_logits': nrm(ks[15], (2, DEPTH + 1, HG_KW), 0.1),
        'hg_norm_w': 1.0 + nrm(ks[16], (DEPTH, HG_VW), 0.01),
        'w_ret_proj': nrm(ks[17], (DEPTH, RET_V, D_MODEL), RET_V ** -0.5),
        'w_hg_proj': nrm(ks[18], (DEPTH, HG_VW, D_MODEL), HG_VW ** -0.5),
        'w_o': nrm(ks[19], (DEPTH, D_MODEL, D_MODEL), D_MODEL ** -0.5),
        'final_norm_w': 1.0 + nrm(ks[20], (D_MODEL,), 0.01),
    }


def reference(x_prompt, x_sample, state_ret, state_hgrn, c, c_ctx, ada_w, ada_b, norm_w,
              ffn1_w13, ffn1_w2, ffn2_w13, ffn2_w2, w_in, ret_decay, hg_lb_logits, hg_norm_w,
              w_ret_proj, w_hg_proj, w_o, final_norm_w):
    f32 = jnp.float32
    lb_all = jnp.cumsum(jax.nn.softmax(hg_lb_logits.astype(f32), axis=1), axis=1)
    bp = x_prompt.shape[0]
    zero_ret = jnp.zeros((bp, 2, RET_HEADS, RET_DK, RET_DV), f32)
    zero_hg = jnp.zeros((bp, 2, HG_HEADS, HG_DK, HG_DV), f32)
    xp, xs = x_prompt, x_sample
    new_ret, new_hg = [], []
    for l in range(DEPTH):
        lp = {
            'norm_w': norm_w[l], 'ffn1_w13': ffn1_w13[l], 'ffn1_w2': ffn1_w2[l],
            'ffn2_w13': ffn2_w13[l], 'ffn2_w2': ffn2_w2[l], 'w_in': w_in[l],
            'ret_decay': ret_decay[l], 'lb': lb_all[:, l], 'hg_norm_w': hg_norm_w[l],
            'w_ret_proj': w_ret_proj[l], 'w_hg_proj': w_hg_proj[l], 'w_o': w_o[l],
        }
        mod_ctx = (jax.nn.silu(c_ctx) @ ada_w[l] + ada_b[l])[None, None, :]
        mod_lat = (jax.nn.silu(c) @ ada_w[l] + ada_b[l])[:, None, :]
        xp, s_ret, s_hg = trunk_layer(xp, mod_ctx, zero_ret, zero_hg, False, lp)
        new_ret.append(s_ret)
        new_hg.append(s_hg)
        xs, _, _ = trunk_layer(xs, mod_lat, state_ret[:, l].astype(f32), state_hgrn[:, l].astype(f32), True, lp)
    y_prompt = rms_norm(xp, final_norm_w)
    y_sample = rms_norm(xs, final_norm_w)
    new_state_ret = jnp.stack(new_ret, axis=1).astype(x_prompt.dtype)
    new_state_hgrn = jnp.stack(new_hg, axis=1).astype(x_prompt.dtype)
    return (y_prompt, y_sample, new_state_ret, new_state_hgrn)
```

```cpp
#include <hip/hip_runtime.h>
#include <cstdint>
#include <cstdio>

typedef unsigned short bf16_t;
#define DEVI __device__ __forceinline__

DEVI float bf2f(bf16_t v) { return __uint_as_float(((unsigned)v) << 16); }
DEVI bf16_t f2bf(float f) { unsigned u = __float_as_uint(f); return (bf16_t)((u + 0x7fffu + ((u >> 16) & 1u)) >> 16); }
DEVI float sigmoidf_(float x) { return 1.0f / (1.0f + __expf(-x)); }
DEVI float siluf_(float x) { return x / (1.0f + __expf(-x)); }

constexpr int D = 1024, MP = 4096, MS = 8192, MT = 12288, FF = 2816, NPROJ = 8192, NMOD = 9 * 1024;
constexpr int PASS_ROWS = 4096;
constexpr float EPS = 1e-6f;
constexpr int C_RQ = 0, C_RK = 512, C_RV = 1024, C_RG = 2048, C_HQ = 3072, C_GF = 4096, C_GB = 5120, C_HI = 6144, C_HOG = 7168;
constexpr int W_GR = 8192, W_GH = 9216, WIN_N = 10240;

constexpr size_t MiB = 1u << 20;
constexpr size_t WS_MOD = 0;
constexpr size_t WS_LB = 192 * 1024;
constexpr size_t WS_ROPE = 200 * 1024;
constexpr size_t WS_H = 61 * MiB;
constexpr size_t WS_OCAT = 85 * MiB;
constexpr size_t WS_PROJ = 133 * MiB;
constexpr size_t WS_ST = 199 * MiB;

struct P {
    const float* in[21];
    float* out;
    unsigned char* ws;
};

DEVI int mod_row(int m) { return m < MP ? 0 : 1 + ((m - MP) >> 11); }

__global__ void k_mod(P p) {
    const int j = blockIdx.x * 256 + threadIdx.x, r = blockIdx.y;
    const float* cv = r == 0 ? p.in[5] : p.in[4] + (size_t)(r - 1) * D;
    const float* W = p.in[6];
    float acc = 0.f;
    for (int k = 0; k < D; ++k) acc += siluf_(cv[k]) * W[(size_t)k * NMOD + j];
    ((float*)(p.ws + WS_MOD))[r * NMOD + j] = acc + p.in[7][j];
}
__global__ void k_misc(P p) {
    const int i = blockIdx.x * 256 + threadIdx.x;
    if (i < 2048) {
        const int d = i >> 10, k = i & 1023;
        const float l0 = p.in[15][(d * 2 + 0) * 1024 + k], l1 = p.in[15][(d * 2 + 1) * 1024 + k];
        ((float*)(p.ws + WS_LB))[i] = 1.0f / (1.0f + expf(l1 - l0));
        const int pos = i >> 5, fi = i & 31;
        const double inv = exp(-(double)fi / 32.0 * log(10000.0));
        const float invf = (float)inv;
        const float angf = (float)pos * invf;
        double a = (double)angf;
        const double twopi = 6.283185307179586476925;
        a -= twopi * rint(a / twopi);
        double s = 0.0, c = 0.0, term = 1.0;
        double a2 = a * a;
        double tc = 1.0, ts = a;
        for (int n = 0; n < 14; ++n) { c += tc; s += ts; tc *= -a2 / ((2 * n + 1) * (2 * n + 2)); ts *= -a2 / ((2 * n + 2) * (2 * n + 3)); }
        (void)term;
        float* rt = (float*)(p.ws + WS_ROPE);
        rt[i * 2] = (float)c; rt[i * 2 + 1] = (float)s;
    }
}

__global__ void k_modnorm(P p, const float* xp, const float* xs, int which) {
    const int lane = threadIdx.x & 63, m = blockIdx.x * 4 + (threadIdx.x >> 6);
    const float* xr = m < MP ? xp + (size_t)m * D : xs + (size_t)(m - MP) * D;
    float v[16]; float ss = 0.f;
#pragma unroll
    for (int j = 0; j < 16; ++j) { v[j] = xr[lane + 64 * j]; ss += v[j] * v[j]; }
#pragma unroll
    for (int o = 1; o < 64; o <<= 1) ss += __shfl_xor(ss, o);
    const float rstd = rsqrtf(ss * (1.0f / D) + EPS);
    if (which == 3) {
        float* o = p.out + (size_t)m * D;
#pragma unroll
        for (int j = 0; j < 16; ++j) o[lane + 64 * j] = v[j] * rstd * p.in[20][lane + 64 * j];
    } else {
        const float* nw = p.in[8] + which * D;
        const float* mod = (const float*)(p.ws + WS_MOD) + (size_t)mod_row(m) * NMOD;
        const float* sh = mod + (which * 3) * D; const float* sc = mod + (which * 3 + 1) * D;
        bf16_t* h = (bf16_t*)(p.ws + WS_H) + (size_t)m * D;
#pragma unroll
        for (int j = 0; j < 16; ++j) { const int c = lane + 64 * j; h[c] = f2bf(v[j] * rstd * nw[c] * (1.0f + sc[c]) + sh[c]); }
    }
}

DEVI void dot8(const bf16_t* __restrict__ A, size_t lda, int m0, int K, const float* __restrict__ W, size_t ldw, int col, float (&acc)[8], float* sA) {
    for (int k0 = 0; k0 < K; k0 += 256) {
        __syncthreads();
        for (int i = threadIdx.x; i < 8 * 256; i += 256) { const int r = i >> 8, kk = i & 255; sA[i] = bf2f(A[(size_t)(m0 + r) * lda + k0 + kk]); }
        __syncthreads();
        for (int kk = 0; kk < 256; ++kk) {
            const float w = W[(size_t)(k0 + kk) * ldw + col];
#pragma unroll
            for (int r = 0; r < 8; ++r) acc[r] += sA[r * 256 + kk] * w;
        }
    }
}

__global__ void k_ffn_up(P p, int wi) {
    __shared__ float sA[8 * 256];
    const int j = blockIdx.x * 256 + threadIdx.x, m0 = blockIdx.y * 8;
    const bf16_t* H = (const bf16_t*)(p.ws + WS_H);
    float a[8] = {}, b[8] = {};
    dot8(H, D, m0, D, p.in[wi], 2 * FF, j, a, sA);
    dot8(H, D, m0, D, p.in[wi], 2 * FF, FF + j, b, sA);
    bf16_t* act = (bf16_t*)(p.ws + WS_PROJ);
#pragma unroll
    for (int r = 0; r < 8; ++r) act[(size_t)(m0 + r) * FF + j] = f2bf(siluf_(a[r]) * b[r]);
}
__global__ void k_ffn_down(P p, int wi, int gidx, const float* xp, const float* xs) {
    __shared__ float sA[8 * 256];
    const int c = blockIdx.x * 256 + threadIdx.x, m0 = blockIdx.y * 8;
    const bf16_t* act = (const bf16_t*)(p.ws + WS_PROJ);
    float a[8] = {};
    dot8(act, FF, m0, FF, p.in[wi], D, c, a, sA);
#pragma unroll
    for (int r = 0; r < 8; ++r) { const int m = m0 + r;
        const float g = ((const float*)(p.ws + WS_MOD))[(size_t)mod_row(m) * NMOD + gidx * D + c];
        const float xin = m < MP ? xp[(size_t)m * D + c] : xs[(size_t)(m - MP) * D + c];
        p.out[(size_t)m * D + c] = xin + 0.5f * g * a[r]; }
}

__global__ void k_win(P p, int pass) {
    __shared__ float sA[8 * 256];
    const int c = blockIdx.x * 256 + threadIdx.x, r0 = blockIdx.y * 8, m0 = pass * PASS_ROWS + r0;
    const bf16_t* H = (const bf16_t*)(p.ws + WS_H);
    bf16_t* PR = (bf16_t*)(p.ws + WS_PROJ);
    const float* W = p.in[13];
    const float* lb = (const float*)(p.ws + WS_LB);
    if (c < 1024) {
        const int c1 = c & ~32, c2 = c1 + 32;
        float a1[8] = {}, a2[8] = {};
        dot8(H, D, m0, D, W, WIN_N, c1, a1, sA);
        dot8(H, D, m0, D, W, WIN_N, c2, a2, sA);
        const int d = c & 127, part = (d >> 6) & 1, fi = d & 31, isx2 = (c >> 5) & 1;
        const float* rt = (const float*)(p.ws + WS_ROPE);
#pragma unroll
        for (int r = 0; r < 8; ++r) { const int m = m0 + r; float cs = 1.f, sn = 0.f;
            if (m >= MP) { const int t = (m - MP) & 2047; const int pos = part == 0 ? (t >> 6) : (t & 63); cs = rt[(pos * 32 + fi) * 2]; sn = rt[(pos * 32 + fi) * 2 + 1]; }
            float v = isx2 ? (a2[r] * cs + a1[r] * sn) : (a1[r] * cs - a2[r] * sn);
            if (c >= C_RK) v *= 0.08838834764831845f;
            PR[(size_t)(r0 + r) * NPROJ + c] = f2bf(v); }
    } else {
        float a[8] = {};
        dot8(H, D, m0, D, W, WIN_N, c, a, sA);
#pragma unroll
        for (int r = 0; r < 8; ++r) { float v = a[r];
            if (c >= C_RG && c < C_HQ) v = siluf_(v);
            else if (c >= C_HQ && c < C_GF) v = siluf_(v) * 0.08838834764831845f;
            else if (c >= C_GF && c < C_HI) { const int dir = c >= C_GB; const float l = lb[dir * 1024 + ((c - C_GF) & 1023)]; v = __logf(l + (1.0f - l) * sigmoidf_(v)); }
            else if (c >= C_HOG) v = siluf_(v);
            PR[(size_t)(r0 + r) * NPROJ + c] = f2bf(v); }
    }
}

__global__ void __launch_bounds__(256) k_ret_scan(P p, int pass) {
    __shared__ float sq[128], sk[128];
    const int L = pass == 0 ? 256 : 2048;
    const int dir = blockIdx.x & 1, h = (blockIdx.x >> 1) & 3, s = blockIdx.x >> 3, e = threadIdx.x;
    const bf16_t* PR = (const bf16_t*)(p.ws + WS_PROJ);
    float* O = (float*)(p.ws + WS_ST) + (size_t)dir * PASS_ROWS * 1024;
    const float rd = p.in[14][dir * 4 + h];
    const float gam = 1.0f / (1.0f + expf(-rd));
    float S[128];
    if (pass == 0) {
#pragma unroll
        for (int k = 0; k < 128; ++k) S[k] = 0.f;
    } else {
        const int b = (pass - 1) * 2 + s;
        const float* st = p.in[2] + ((size_t)(b * 2 + dir) * 4 + h) * 128 * 256;
#pragma unroll
        for (int k = 0; k < 128; ++k) S[k] = st[k * 256 + e];
    }
    for (int i = 0; i < L; ++i) {
        const int t = dir == 0 ? i : L - 1 - i;
        const size_t row = (size_t)s * L + t;
        __syncthreads();
        if (e < 128) sq[e] = bf2f(PR[row * NPROJ + C_RQ + h * 128 + e]); else sk[e - 128] = bf2f(PR[row * NPROJ + C_RK + h * 128 + e - 128]);
        __syncthreads();
        const float v = bf2f(PR[row * NPROJ + C_RV + h * 256 + e]);
        float o = 0.f;
#pragma unroll
        for (int k = 0; k < 128; ++k) { S[k] = gam * S[k] + sk[k] * v; o += sq[k] * S[k]; }
        O[row * 1024 + h * 256 + e] = o;
    }
    if (pass == 0) {
        float* ns = p.out + (size_t)MT * D + ((size_t)(s * 2 + dir) * 4 + h) * 128 * 256;
#pragma unroll
        for (int k = 0; k < 128; ++k) ns[k * 256 + e] = S[k];
    }
}
__global__ void k_ret_fin(P p, int pass) {
    const int lane = threadIdx.x & 63, id = blockIdx.x * 4 + (threadIdx.x >> 6), row = id >> 2, h = id & 3;
    const float* O0 = (const float*)(p.ws + WS_ST); const float* O1 = O0 + (size_t)PASS_ROWS * 1024;
    const bf16_t* PR = (const bf16_t*)(p.ws + WS_PROJ);
    float v[4]; float ss = 0.f;
#pragma unroll
    for (int j = 0; j < 4; ++j) { const size_t ix = (size_t)row * 1024 + h * 256 + lane + 64 * j; v[j] = O0[ix] + O1[ix]; ss += v[j] * v[j]; }
#pragma unroll
    for (int o = 1; o < 64; o <<= 1) ss += __shfl_xor(ss, o);
    const float rstd = rsqrtf(ss * (1.0f / 256.0f) + EPS);
    bf16_t* OC = (bf16_t*)(p.ws + WS_OCAT) + (size_t)(pass * PASS_ROWS + row) * 2048;
#pragma unroll
    for (int j = 0; j < 4; ++j) { const int e = lane + 64 * j; OC[h * 256 + e] = f2bf(v[j] * rstd * bf2f(PR[(size_t)row * NPROJ + C_RG + h * 256 + e])); }
}
__global__ void __launch_bounds__(128) k_hg_scan(P p, int pass) {
    __shared__ float sq[128], sf[128];
    const int L = pass == 0 ? 256 : 2048;
    const int dir = blockIdx.x & 1, h = (blockIdx.x >> 1) & 7, s = blockIdx.x >> 4, e = threadIdx.x;
    const bf16_t* PR = (const bf16_t*)(p.ws + WS_PROJ);
    float* O = (float*)(p.ws + WS_ST) + (size_t)dir * PASS_ROWS * 1024;
    float S[128];
    if (pass == 0) {
#pragma unroll
        for (int k = 0; k < 128; ++k) S[k] = 0.f;
    } else {
        const int b = (pass - 1) * 2 + s;
        const float* st = p.in[3] + ((size_t)(b * 2 + dir) * 8 + h) * 128 * 128;
#pragma unroll
        for (int k = 0; k < 128; ++k) S[k] = st[k * 128 + e];
    }
    for (int i = 0; i < L; ++i) {
        const int t = dir == 0 ? i : L - 1 - i;
        const size_t row = (size_t)s * L + t;
        __syncthreads();
        sq[e] = bf2f(PR[row * NPROJ + C_HQ + h * 128 + e]);
        sf[e] = __expf(bf2f(PR[row * NPROJ + (dir ? C_GB : C_GF) + h * 128 + e]));
        __syncthreads();
        const float v = bf2f(PR[row * NPROJ + C_HI + h * 128 + e]);
        float o = 0.f;
#pragma unroll
        for (int k = 0; k < 128; ++k) { const float f = sf[k]; S[k] = f * S[k] + (1.0f - f) * v; o += sq[k] * S[k]; }
        O[row * 1024 + h * 128 + e] = o;
    }
    if (pass == 0) {
        float* ns = p.out + (size_t)MT * D + (size_t)16 * 2 * 4 * 128 * 256 + ((size_t)(s * 2 + dir) * 8 + h) * 128 * 128;
#pragma unroll
        for (int k = 0; k < 128; ++k) ns[k * 128 + e] = S[k];
    }
}
__global__ void k_hg_fin(P p, int pass) {
    const int lane = threadIdx.x & 63, id = blockIdx.x * 4 + (threadIdx.x >> 6), row = id >> 3, h = id & 7;
    const float* O0 = (const float*)(p.ws + WS_ST); const float* O1 = O0 + (size_t)PASS_ROWS * 1024;
    const bf16_t* PR = (const bf16_t*)(p.ws + WS_PROJ);
    float v[2]; float ss = 0.f;
#pragma unroll
    for (int j = 0; j < 2; ++j) { const size_t ix = (size_t)row * 1024 + h * 128 + lane + 64 * j; v[j] = O0[ix] + O1[ix]; ss += v[j] * v[j]; }
#pragma unroll
    for (int o = 1; o < 64; o <<= 1) ss += __shfl_xor(ss, o);
    const float rstd = rsqrtf(ss * (1.0f / 128.0f) + EPS);
    bf16_t* OC = (bf16_t*)(p.ws + WS_OCAT) + (size_t)(pass * PASS_ROWS + row) * 2048 + 1024;
#pragma unroll
    for (int j = 0; j < 2; ++j) { const int e = lane + 64 * j; OC[h * 128 + e] = f2bf(v[j] * rstd * p.in[16][h * 128 + e] * bf2f(PR[(size_t)row * NPROJ + C_HOG + h * 128 + e])); }
}

__global__ void k_gates(P p) {
    __shared__ float sA[8 * 256];
    const int c = blockIdx.x * 256 + threadIdx.x, m0 = blockIdx.y * 8;
    float a[8] = {};
    dot8((const bf16_t*)(p.ws + WS_H), D, m0, D, p.in[13], WIN_N, W_GR + c, a, sA);
    bf16_t* G = (bf16_t*)(p.ws + WS_PROJ);
#pragma unroll
    for (int r = 0; r < 8; ++r) G[(size_t)(m0 + r) * 2048 + c] = f2bf(sigmoidf_(a[r]));
}
__global__ void k_merge(P p) {
    __shared__ float sA[8 * 256];
    const int c = blockIdx.x * 256 + threadIdx.x, m0 = blockIdx.y * 8;
    const bf16_t* OC = (const bf16_t*)(p.ws + WS_OCAT);
    const bf16_t* G = (const bf16_t*)(p.ws + WS_PROJ);
    float a[8] = {}, b[8] = {};
    dot8(OC, 2048, m0, 1024, p.in[17], D, c, a, sA);
    dot8(OC + 1024, 2048, m0, 1024, p.in[18], D, c, b, sA);
    bf16_t* Mg = (bf16_t*)(p.ws + WS_H);
#pragma unroll
    for (int r = 0; r < 8; ++r) { const size_t m = m0 + r; Mg[m * D + c] = f2bf(bf2f(G[m * 2048 + c]) * a[r] + bf2f(G[m * 2048 + 1024 + c]) * b[r]); }
}
__global__ void k_wo(P p) {
    __shared__ float sA[8 * 256];
    const int c = blockIdx.x * 256 + threadIdx.x, m0 = blockIdx.y * 8;
    float a[8] = {};
    dot8((const bf16_t*)(p.ws + WS_H), D, m0, D, p.in[19], D, c, a, sA);
#pragma unroll
    for (int r = 0; r < 8; ++r) { const int m = m0 + r;
        const float g = ((const float*)(p.ws + WS_MOD))[(size_t)mod_row(m) * NMOD + 5 * D + c];
        p.out[(size_t)m * D + c] += g * a[r]; }
}

extern "C" void kernel_launch(void* const* d_in, const int* in_sizes, int n_in, void* d_out, int out_size, void* d_ws, size_t ws_size, hipStream_t stream) {
    P p{};
    for (int i = 0; i < 21; ++i) p.in[i] = (const float*)d_in[i];
    p.out = (float*)d_out; p.ws = (unsigned char*)d_ws;
    const float* xp = p.in[0]; const float* xs = p.in[1];
    const float* op = p.out; const float* os = p.out + (size_t)MP * D;
    k_mod<<<dim3(NMOD / 256, 5), 256, 0, stream>>>(p);
    k_misc<<<8, 256, 0, stream>>>(p);
    k_modnorm<<<MT / 4, 256, 0, stream>>>(p, xp, xs, 0);
    k_ffn_up<<<dim3(FF / 256, MT / 8), 256, 0, stream>>>(p, 9);
    k_ffn_down<<<dim3(D / 256, MT / 8), 256, 0, stream>>>(p, 10, 2, xp, xs);
    k_modnorm<<<MT / 4, 256, 0, stream>>>(p, op, os, 1);
    for (int pass = 0; pass < 3; ++pass) {
        const int nseq = pass == 0 ? 16 : 2;
        k_win<<<dim3(NPROJ / 256, PASS_ROWS / 8), 256, 0, stream>>>(p, pass);
        k_ret_scan<<<nseq * 8, 256, 0, stream>>>(p, pass);
        k_ret_fin<<<PASS_ROWS * 4 / 4, 256, 0, stream>>>(p, pass);
        k_hg_scan<<<nseq * 16, 128, 0, stream>>>(p, pass);
        k_hg_fin<<<PASS_ROWS * 8 / 4, 256, 0, stream>>>(p, pass);
    }
    k_gates<<<dim3(2048 / 256, MT / 8), 256, 0, stream>>>(p);
    k_merge<<<dim3(D / 256, MT / 8), 256, 0, stream>>>(p);
    k_wo<<<dim3(D / 256, MT / 8), 256, 0, stream>>>(p);
    k_modnorm<<<MT / 4, 256, 0, stream>>>(p, op, os, 2);
    k_ffn_up<<<dim3(FF / 256, MT / 8), 256, 0, stream>>>(p, 11);
    k_ffn_down<<<dim3(D / 256, MT / 8), 256, 0, stream>>>(p, 12, 8, op, os);
    k_modnorm<<<MT / 4, 256, 0, stream>>>(p, op, os, 3);
}
```

```cpp
#include <hip/hip_runtime.h>
#include <hip/hip_cooperative_groups.h>
#include <cstdint>
#include <cstdio>
namespace cg = cooperative_groups;

#define DEVI __device__ __forceinline__
#define LAS __attribute__((address_space(3)))
#define GAS __attribute__((address_space(1)))

constexpr int D = 1024, MP = 4096, MS = 8192, MT = 12288, FF = 2816, NPROJ = 8192, NMOD = 9 * 1024;
constexpr int PASS_ROWS = 4096;
constexpr float EPS = 1e-6f;
constexpr int C_RQ = 0, C_RK = 512, C_RV = 1024, C_RG = 2048, C_HQ = 3072, C_GF = 4096, C_GB = 5120, C_HI = 6144, C_HOG = 7168;
constexpr int W_GR = 8192, WIN_N = 10240;
constexpr float QK_SCALE = 0.08838834764831845f;

constexpr size_t MiB = 1u << 20;
constexpr size_t WS_MOD = 0;
constexpr size_t WS_LB = 192 * 1024;
constexpr size_t WS_ROPE = 200 * 1024;
constexpr size_t WS_W13A = 1 * MiB, WS_W2A = 12 * MiB, WS_W13B = 18 * MiB, WS_W2B = 29 * MiB;
constexpr size_t WS_WIN = 35 * MiB, WS_WG = 51 * MiB, WS_WR = 55 * MiB, WS_WH = 57 * MiB, WS_WO = 59 * MiB;
constexpr size_t WS_H = 61 * MiB;
constexpr size_t WS_ORET = 85 * MiB, WS_OHG = 109 * MiB;
constexpr size_t WS_PROJ = 133 * MiB;
constexpr size_t WS_ST = 199 * MiB;

typedef unsigned short bf16_t;
typedef float f32x4 __attribute__((ext_vector_type(4)));
typedef float f32x2 __attribute__((ext_vector_type(2)));
typedef unsigned u32x4 __attribute__((ext_vector_type(4)));
typedef unsigned u32x2 __attribute__((ext_vector_type(2)));
typedef short bf16x8 __attribute__((ext_vector_type(8)));

struct P {
    const float* in[21];
    float* out;
    unsigned char* ws;
    int lo, hi;
};

DEVI float bf2f(bf16_t v) { return __uint_as_float(((unsigned)v) << 16); }
DEVI unsigned f2bf(float f) { unsigned u = __float_as_uint(f); return (u + 0x7fffu + ((u >> 16) & 1u)) >> 16; }
typedef __bf16 bf16x2_t __attribute__((ext_vector_type(2)));
DEVI unsigned pk2(float lo, float hi) { bf16x2_t v; v[0] = (__bf16)lo; v[1] = (__bf16)hi; return __builtin_bit_cast(unsigned, v); }
DEVI float bflo(unsigned w) { return __uint_as_float(w << 16); }
DEVI float bfhi(unsigned w) { return __uint_as_float(w & 0xffff0000u); }
DEVI float sigmoidf_(float x) { return 1.0f / (1.0f + __expf(-x)); }
DEVI float siluf_(float x) { return x / (1.0f + __expf(-x)); }
DEVI int mod_row(int m) { return m < MP ? 0 : 1 + ((m - MP) >> 11); }

typedef LAS unsigned char* ldsp;
#define HYBRID 0
namespace pg8 {
#define PG8_LAS __attribute__((address_space(3)))
typedef unsigned short bf16_t;
typedef short bf16x8 __attribute__((ext_vector_type(8)));
typedef float f32x4 __attribute__((ext_vector_type(4)));
typedef unsigned u32x4 __attribute__((ext_vector_type(4)));
constexpr int BM = 256, BK = 64, HALF = 128, HTB = HALF * BK * 2  , STAGE_BYTES = 8 * HTB, NXCD = 8, WGM = 8;

__host__ __device__ __forceinline__ int lds_byte(int r, int c) { const int st = (r >> 4) * 2 + (c >> 5), rr = r & 15, cc = c & 31, ob = rr * 64 + cc * 2; return st * 1024 + (ob ^ (((ob >> 9) & 1) << 5)); }
__host__ __device__ __forceinline__ void stage_rc(int b, int& R, int& C) { const int st = b / 1024, sb = b % 1024, swz = sb ^ (((sb >> 9) & 1) << 5); R = (st >> 1) * 16 + swz / 64; C = (st & 1) * 32 + (swz % 64) / 2; }
__host__ __device__ __forceinline__ int perm32(int rho) { const int n = rho >> 4, i = rho & 15; return 8 * (i >> 2) + 4 * n + (i & 3); }

struct Unit { int pm, pn; };
struct Gemm { const bf16_t* A; const bf16_t* Bt; int M, N, K; };

struct StaticOrder {
    int nM, nN, nwg, G, c;
    __host__ __device__ void init(int M, int N, int G_, int c_) { nM = M / BM; nN = N / BM; nwg = nM * nN; G = G_; c = c_; }
    __host__ __device__ bool next(int i, Unit& u) const {
        const long L = (long)i * G + c; if (L >= nwg) return false;
        int wgid = (int)L; { const int q = nwg / NXCD, r = nwg % NXCD, xcd = wgid % NXCD, off = wgid / NXCD; wgid = (xcd < r ? xcd * (q + 1) : r * (q + 1) + (xcd - r) * q) + off; }
        const int nig = WGM * nN, gid = wgid / nig, fm = gid * WGM, gsz = (nM - fm) < WGM ? (nM - fm) : WGM;
        u.pm = fm + ((wgid % nig) % gsz); u.pn = (wgid % nig) / gsz; return true;
    }
    __device__ __forceinline__ void a_ready(const Unit&) const {}
    __device__ __forceinline__ void done(const Unit&) const {}
};


struct EpiSwiglu {
    static constexpr bool PERM = true, AFTER_DRAIN = false, HAS_MID = false;
    bf16_t* act;
    __device__ __forceinline__ void mid(f32x4 (&)[2][2][4][2], const Unit&, int, int, int, int) const {}
    __device__ __forceinline__ void operator()(const f32x4 (&acc)[2][2][4][2], const Unit& u, int wr, int wc, int fr, int fq) const {
        const int row0 = u.pm * BM + wr * 64 + fr, col0 = u.pn * 128 + wc * 32 + 8 * fq;
#pragma unroll
        for (int ai = 0; ai < 2; ++ai)
#pragma unroll
            for (int m = 0; m < 4; ++m) {
                float v[8];
#pragma unroll
                for (int n = 0; n < 2; ++n)
#pragma unroll
                    for (int e = 0; e < 4; ++e) { const float a = acc[ai][0][m][n][e], b = acc[ai][1][m][n][e]; v[n * 4 + e] = a / (1.0f + __expf(-a)) * b; }
                u32x4 w; w.x = ::pk2(v[0], v[1]); w.y = ::pk2(v[2], v[3]); w.z = ::pk2(v[4], v[5]); w.w = ::pk2(v[6], v[7]);
                *(u32x4*)(act + (size_t)(row0 + ai * HALF + m * 16) * 2816 + col0) = w;
            }
    }
};
struct EpiResid {
    static constexpr bool PERM = false, AFTER_DRAIN = false, HAS_MID = false;
    const float* xp; const float* xs; float* out; const float* mod; int gidx; float scale;
    __device__ __forceinline__ void mid(f32x4 (&)[2][2][4][2], const Unit&, int, int, int, int) const {}
    __device__ __forceinline__ void operator()(const f32x4 (&acc)[2][2][4][2], const Unit& u, int wr, int wc, int fr, int fq) const {
        const int rowt = u.pm * BM, row0 = rowt + wr * 64 + fr, col0 = u.pn * BM + wc * 32 + 4 * fq;
        const float* gate = mod + (size_t)(rowt < 4096 ? 0 : 1 + ((rowt - 4096) >> 11)) * 9216 + gidx * 1024;
        const float* xb = rowt < 4096 ? xp : xs - (size_t)4096 * 1024;
#pragma unroll
        for (int bj = 0; bj < 2; ++bj)
#pragma unroll
            for (int n = 0; n < 2; ++n) {
                const int c = col0 + bj * HALF + n * 16;
                const f32x4 g4 = *(const f32x4*)(gate + c) * scale;
#pragma unroll
                for (int ai = 0; ai < 2; ++ai)
#pragma unroll
                    for (int m = 0; m < 4; ++m) { const size_t off = (size_t)(row0 + ai * HALF + m * 16) * 1024 + c;
                        const f32x4 xin = *(const f32x4*)(xb + off); *(f32x4*)(out + off) = xin + g4 * acc[ai][bj][m][n]; }
            }
    }
};
struct EpiWin {
    static constexpr bool PERM = true, AFTER_DRAIN = false, HAS_MID = false;
    bf16_t* PR; const float* lb; const float* rope; int pass;
    __device__ __forceinline__ void mid(f32x4 (&)[2][2][4][2], const Unit&, int, int, int, int) const {}
    __device__ __forceinline__ void operator()(const f32x4 (&acc)[2][2][4][2], const Unit& u, int wr, int wc, int fr, int fq) const {
        const int row0 = u.pm * BM + wr * 64 + fr;
        if (u.pn < 4) {
            const int hh = wc >> 1, part = wc & 1, i0 = 8 * fq;
            const float sc = u.pn >= 2 ? 0.08838834764831845f : 1.0f;
#pragma unroll
            for (int ai = 0; ai < 2; ++ai)
#pragma unroll
                for (int m = 0; m < 4; ++m) {
                    const int row = row0 + ai * HALF + m * 16;
                    float cs[8], sn[8];
                    if (pass > 0) { const int t = row & 2047; const int pos = part ? (t & 63) : (t >> 6);
                        const f32x4* rp = (const f32x4*)(rope + (size_t)(pos * 32 + i0) * 2);
#pragma unroll
                        for (int q = 0; q < 4; ++q) { const f32x4 r4 = rp[q]; cs[2 * q] = r4[0]; sn[2 * q] = r4[1]; cs[2 * q + 1] = r4[2]; sn[2 * q + 1] = r4[3]; } }
                    else {
#pragma unroll
                        for (int q = 0; q < 8; ++q) { cs[q] = 1.0f; sn[q] = 0.0f; } }
                    float y1[8], y2[8];
#pragma unroll
                    for (int e = 0; e < 8; ++e) { const float x1 = acc[ai][0][m][e >> 2][e & 3], x2 = acc[ai][1][m][e >> 2][e & 3];
                        y1[e] = (x1 * cs[e] - x2 * sn[e]) * sc; y2[e] = (x2 * cs[e] + x1 * sn[e]) * sc; }
                    bf16_t* dst = PR + (size_t)row * 8192 + u.pn * BM + 128 * hh + 64 * part + i0;
                    u32x4 w; w.x = ::pk2(y1[0], y1[1]); w.y = ::pk2(y1[2], y1[3]); w.z = ::pk2(y1[4], y1[5]); w.w = ::pk2(y1[6], y1[7]);
                    *(u32x4*)dst = w;
                    w.x = ::pk2(y2[0], y2[1]); w.y = ::pk2(y2[2], y2[3]); w.z = ::pk2(y2[4], y2[5]); w.w = ::pk2(y2[6], y2[7]);
                    *(u32x4*)(dst + 32) = w;
                }
        } else {
            const int seg = u.pn >> 2;
#pragma unroll
            for (int bj = 0; bj < 2; ++bj) {
                const int col = u.pn * BM + bj * HALF + wc * 32 + 8 * fq;
                float l[8];
                if (seg == 4 || seg == 5) {
                    const f32x4 l0 = *(const f32x4*)(lb + (col - 4096)), l1 = *(const f32x4*)(lb + (col - 4096) + 4);
#pragma unroll
                    for (int e = 0; e < 4; ++e) { l[e] = l0[e]; l[4 + e] = l1[e]; }
                } else {
#pragma unroll
                    for (int e = 0; e < 8; ++e) l[e] = 0.f;
                }
#pragma unroll
                for (int ai = 0; ai < 2; ++ai)
#pragma unroll
                    for (int m = 0; m < 4; ++m) {
                        float v[8];
#pragma unroll
                        for (int e = 0; e < 8; ++e) { float x = acc[ai][bj][m][e >> 2][e & 3];
                            if (seg == 2 || seg == 7) x = x / (1.0f + __expf(-x));
                            else if (seg == 3) x = x / (1.0f + __expf(-x)) * 0.08838834764831845f;
                            else if (seg == 4 || seg == 5) x = __logf(l[e] + (1.0f - l[e]) / (1.0f + __expf(-x)));
                            v[e] = x; }
                        u32x4 w; w.x = ::pk2(v[0], v[1]); w.y = ::pk2(v[2], v[3]); w.z = ::pk2(v[4], v[5]); w.w = ::pk2(v[6], v[7]);
                        *(u32x4*)(PR + (size_t)(row0 + ai * HALF + m * 16) * 8192 + col) = w;
                    }
            }
        }
    }
};
struct EpiGates {
    static constexpr bool PERM = true, AFTER_DRAIN = false, HAS_MID = false;
    bf16_t* G;
    __device__ __forceinline__ void mid(f32x4 (&)[2][2][4][2], const Unit&, int, int, int, int) const {}
    __device__ __forceinline__ void operator()(const f32x4 (&acc)[2][2][4][2], const Unit& u, int wr, int wc, int fr, int fq) const {
        const int row0 = u.pm * BM + wr * 64 + fr;
#pragma unroll
        for (int bj = 0; bj < 2; ++bj) {
            const int col = u.pn * BM + bj * HALF + wc * 32 + 8 * fq;
#pragma unroll
            for (int ai = 0; ai < 2; ++ai)
#pragma unroll
                for (int m = 0; m < 4; ++m) {
                    float v[8];
#pragma unroll
                    for (int e = 0; e < 8; ++e) v[e] = 1.0f / (1.0f + __expf(-acc[ai][bj][m][e >> 2][e & 3]));
                    u32x4 w; w.x = ::pk2(v[0], v[1]); w.y = ::pk2(v[2], v[3]); w.z = ::pk2(v[4], v[5]); w.w = ::pk2(v[6], v[7]);
                    *(u32x4*)(G + (size_t)(row0 + ai * HALF + m * 16) * 2048 + col) = w;
                }
        }
    }
};
struct EpiMergeA {
    static constexpr bool PERM = false, AFTER_DRAIN = false, HAS_MID = false;
    const bf16_t* G; float* T;
    __device__ __forceinline__ void mid(f32x4 (&)[2][2][4][2], const Unit&, int, int, int, int) const {}
    __device__ __forceinline__ void operator()(const f32x4 (&acc)[2][2][4][2], const Unit& u, int wr, int wc, int fr, int fq) const {
        const int row0 = u.pm * BM + wr * 64 + fr, col0 = u.pn * BM + wc * 32 + 4 * fq;
#pragma unroll
        for (int ai = 0; ai < 2; ++ai)
#pragma unroll
            for (int m = 0; m < 4; ++m) { const size_t row = (size_t)(row0 + ai * HALF + m * 16);
#pragma unroll
                for (int bj = 0; bj < 2; ++bj)
#pragma unroll
                    for (int n = 0; n < 2; ++n) { const int c = col0 + bj * HALF + n * 16;
                        const u32x2 g = *(const u32x2*)(G + row * 2048 + c);
                        f32x4 v = acc[ai][bj][m][n]; v[0] *= ::bflo(g.x); v[1] *= ::bfhi(g.x); v[2] *= ::bflo(g.y); v[3] *= ::bfhi(g.y);
                        *(f32x4*)(T + row * 1024 + c) = v; } }
    }
};
struct EpiMergeB {
    static constexpr bool PERM = false, AFTER_DRAIN = false, HAS_MID = false;
    const bf16_t* G; const float* T; bf16_t* Mg;
    __device__ __forceinline__ void mid(f32x4 (&)[2][2][4][2], const Unit&, int, int, int, int) const {}
    __device__ __forceinline__ void operator()(const f32x4 (&acc)[2][2][4][2], const Unit& u, int wr, int wc, int fr, int fq) const {
        const int row0 = u.pm * BM + wr * 64 + fr, col0 = u.pn * BM + wc * 32 + 4 * fq;
#pragma unroll
        for (int ai = 0; ai < 2; ++ai)
#pragma unroll
            for (int m = 0; m < 4; ++m) { const size_t row = (size_t)(row0 + ai * HALF + m * 16);
#pragma unroll
                for (int bj = 0; bj < 2; ++bj)
#pragma unroll
                    for (int n = 0; n < 2; ++n) { const int c = col0 + bj * HALF + n * 16;
                        const u32x2 g = *(const u32x2*)(G + row * 2048 + 1024 + c);
                        f32x4 v = acc[ai][bj][m][n]; const f32x4 t = *(const f32x4*)(T + row * 1024 + c);
                        v[0] = v[0] * ::bflo(g.x) + t[0]; v[1] = v[1] * ::bfhi(g.x) + t[1]; v[2] = v[2] * ::bflo(g.y) + t[2]; v[3] = v[3] * ::bfhi(g.y) + t[3];
                        u32x2 w; w.x = ::pk2(v[0], v[1]); w.y = ::pk2(v[2], v[3]);
                        *(u32x2*)(Mg + row * 1024 + c) = w; } }
    }
};

template <class Epi, class Sched, bool ALIGN_EPI = false, bool SP2 = false>
__device__ __forceinline__ void gemm_phase(PG8_LAS unsigned char* lds, const Gemm g, const Sched& S, const Epi& E) {
    int tid_ = threadIdx.x; asm volatile("" : "+v"(tid_)); const int tid = tid_, wid = __builtin_amdgcn_readfirstlane(tid >> 6), lane = tid & 63, wr = wid >> 2, wc = wid & 3, fr = lane & 15, fq = lane >> 4;
    const int K = g.K, nt = K / BK;
    unsigned voffA[2], voffB[2];
#pragma unroll
    for (int i = 0; i < 2; ++i) { int R, C; stage_rc(tid * 16 + i * 8192, R, C); const int Rb = Epi::PERM ? ((R & ~31) + perm32(R & 31)) : R;
        voffA[i] = (unsigned)(R * K + C) * 2u; voffB[i] = (unsigned)(Rb * K + C) * 2u; }
    const size_t kstep = (size_t)(BK * 2);
    const size_t hstep = (size_t)HALF * K * 2;
    const size_t tstep = 2 * hstep;
    const unsigned ldsw = (unsigned)wid * 1024u;
    const int aoff = lds_byte(wr * 64 + fr, fq * 8), boff = lds_byte(wc * 32 + fr, fq * 8);
#define PG8_SA(b, h) (((b) * 2 + (h)) * HTB)
#define PG8_SB(b, h) ((4 + (b) * 2 + (h)) * HTB)
#define PG8_STAGE(bufoff, gbase, voff) do { _Pragma("unroll") for (int _i = 0; _i < 2; ++_i) \
        __builtin_amdgcn_global_load_lds((const unsigned*)((const char*)(gbase) + (voff)[_i]), (PG8_LAS unsigned*)(lds + (bufoff) + ldsw + _i * 8192), 16, 0, 0); } while (0)
#define PG8_LDA(dst, b, h) do { _Pragma("unroll") for (int m = 0; m < 4; ++m) _Pragma("unroll") for (int k = 0; k < 2; ++k) dst[m][k] = *(const PG8_LAS bf16x8*)(lds + PG8_SA(b, h) + aoff + m * 2048 + k * 1024); } while (0)
#define PG8_LDB(dst, b, h) do { _Pragma("unroll") for (int n = 0; n < 2; ++n) _Pragma("unroll") for (int k = 0; k < 2; ++k) dst[n][k] = *(const PG8_LAS bf16x8*)(lds + PG8_SB(b, h) + boff + n * 2048 + k * 1024); } while (0)
#define PG8_MMA(ai, bj, At, Bt) do { __builtin_amdgcn_s_setprio(1); _Pragma("unroll") for (int m = 0; m < 4; ++m) _Pragma("unroll") for (int n = 0; n < 2; ++n) _Pragma("unroll") for (int k = 0; k < 2; ++k) \
        acc[ai][bj][m][n] = __builtin_amdgcn_mfma_f32_16x16x32_bf16(Bt[n][k], At[m][k], acc[ai][bj][m][n], 0, 0, 0); __builtin_amdgcn_s_setprio(0); } while (0)
#define PG8_WAIT_V(n) asm volatile("s_waitcnt vmcnt(" #n ")" ::: "memory")
#define PG8_WAIT_L(n) asm volatile("s_waitcnt lgkmcnt(" #n ")" ::: "memory")
#define PG8_BAR __builtin_amdgcn_s_barrier()
#define PG8_SCHED __builtin_amdgcn_sched_barrier(0)
    Unit cur, nxt; int ui = 0;
    if (!S.next(0, cur)) return;
    f32x4 acc[2][2][4][2];
#pragma unroll
    for (int a = 0; a < 2; ++a)
#pragma unroll
        for (int b = 0; b < 2; ++b)
#pragma unroll
            for (int m = 0; m < 4; ++m)
#pragma unroll
                for (int n = 0; n < 2; ++n) acc[a][b][m][n] = (f32x4){0.f, 0.f, 0.f, 0.f};
    bf16x8 At[4][2], B0[2][2], B1[2][2];
    const char* cA = (const char*)g.A + (size_t)cur.pm * tstep; const char* cB = (const char*)g.Bt + (size_t)cur.pn * tstep;
    S.a_ready(cur);
    if constexpr (SP2) {
        PG8_STAGE(PG8_SB(0, 0), cB, voffB); PG8_STAGE(PG8_SB(0, 1), cB + hstep, voffB); PG8_STAGE(PG8_SA(0, 0), cA, voffA); PG8_STAGE(PG8_SA(0, 1), cA + hstep, voffA);
        if (wr == 1) PG8_BAR;
        PG8_WAIT_V(2); PG8_BAR;
        PG8_STAGE(PG8_SB(1, 0), cB + kstep, voffB); PG8_STAGE(PG8_SA(1, 0), cA + kstep, voffA); PG8_STAGE(PG8_SB(1, 1), cB + hstep + kstep, voffB);
        PG8_WAIT_V(6); PG8_BAR;
    } else {
        PG8_STAGE(PG8_SB(0, 0), cB, voffB); PG8_STAGE(PG8_SA(0, 0), cA, voffA); PG8_STAGE(PG8_SB(0, 1), cB + hstep, voffB); PG8_STAGE(PG8_SA(0, 1), cA + hstep, voffA);
        if (wr == 1) PG8_BAR;
        PG8_WAIT_V(4); PG8_BAR;
        PG8_STAGE(PG8_SB(1, 0), cB + kstep, voffB); PG8_STAGE(PG8_SA(1, 0), cA + kstep, voffA); PG8_STAGE(PG8_SB(1, 1), cB + hstep + kstep, voffB);
        PG8_WAIT_V(6); PG8_BAR;
    }
    for (;;) {
        const bool has_next = S.next(ui + 1, nxt);
        const char* nA = has_next ? (const char*)g.A + (size_t)nxt.pm * tstep : cA; const char* nB = has_next ? (const char*)g.Bt + (size_t)nxt.pn * tstep : cB;
        for (int t = 0; t < nt; t += 2) {
            if constexpr (Epi::HAS_MID) { if (t == (nt >> 1)) E.mid(acc, cur, wr, wc, fr, fq); }
            const bool last = (t == nt - 2);
            const char* a1 = cA + (size_t)(t + 1) * kstep;
            const char* a2 = last ? nA : cA + (size_t)(t + 2) * kstep; const char* b2 = last ? nB : cB + (size_t)(t + 2) * kstep;
            const char* a3 = a2 + kstep; const char* b3 = b2 + kstep;
            if (last && has_next) S.a_ready(nxt);
            if constexpr (SP2) {
            PG8_LDB(B0, 0, 0); PG8_LDB(B1, 0, 1); PG8_SCHED; PG8_LDA(At, 0, 0); PG8_STAGE(PG8_SA(1, 1), a1 + hstep, voffA);
            PG8_WAIT_V(8); PG8_WAIT_L(0); PG8_BAR; PG8_MMA(0, 0, At, B0); PG8_MMA(0, 1, At, B1); PG8_BAR; PG8_SCHED;
            PG8_LDA(At, 0, 1); PG8_STAGE(PG8_SB(0, 0), b2, voffB); PG8_STAGE(PG8_SB(0, 1), b2 + hstep, voffB); PG8_STAGE(PG8_SA(0, 0), a2, voffA);
            PG8_WAIT_V(8); PG8_WAIT_L(0); PG8_BAR; PG8_MMA(1, 0, At, B0); PG8_MMA(1, 1, At, B1); PG8_BAR; PG8_SCHED;
            PG8_LDB(B0, 1, 0); PG8_LDB(B1, 1, 1); PG8_SCHED; PG8_LDA(At, 1, 0); PG8_STAGE(PG8_SA(0, 1), a2 + hstep, voffA);
            PG8_WAIT_V(8); PG8_WAIT_L(0); PG8_BAR; PG8_MMA(0, 0, At, B0); PG8_MMA(0, 1, At, B1); PG8_BAR; PG8_SCHED;
            PG8_LDA(At, 1, 1); PG8_STAGE(PG8_SB(1, 0), b3, voffB); PG8_STAGE(PG8_SB(1, 1), b3 + hstep, voffB); PG8_STAGE(PG8_SA(1, 0), a3, voffA);
            PG8_WAIT_V(8); PG8_WAIT_L(0); PG8_BAR; PG8_MMA(1, 0, At, B0); PG8_MMA(1, 1, At, B1); PG8_BAR; PG8_SCHED;
            } else {
            PG8_LDB(B0, 0, 0); PG8_SCHED; PG8_LDA(At, 0, 0); PG8_STAGE(PG8_SA(1, 1), a1 + hstep, voffA);
            PG8_WAIT_L(8); PG8_BAR; PG8_WAIT_L(0); PG8_MMA(0, 0, At, B0); PG8_BAR; PG8_SCHED;
            PG8_LDB(B1, 0, 1); PG8_STAGE(PG8_SB(0, 0), b2, voffB);
            PG8_BAR; PG8_WAIT_L(0); PG8_MMA(0, 1, At, B1); PG8_BAR;
            PG8_LDA(At, 0, 1); PG8_STAGE(PG8_SA(0, 0), a2, voffA);
            PG8_BAR; PG8_WAIT_L(0); PG8_MMA(1, 0, At, B0); PG8_BAR; PG8_SCHED;
            PG8_STAGE(PG8_SB(0, 1), b2 + hstep, voffB);
            PG8_WAIT_V(6); PG8_BAR; PG8_MMA(1, 1, At, B1); PG8_BAR;
            PG8_LDB(B0, 1, 0); PG8_SCHED; PG8_LDA(At, 1, 0); PG8_STAGE(PG8_SA(0, 1), a2 + hstep, voffA);
            PG8_WAIT_L(8); PG8_BAR; PG8_WAIT_L(0); PG8_MMA(0, 0, At, B0); PG8_BAR; PG8_SCHED;
            PG8_LDB(B1, 1, 1); PG8_STAGE(PG8_SB(1, 0), b3, voffB);
            PG8_BAR; PG8_WAIT_L(0); PG8_MMA(0, 1, At, B1); PG8_BAR;
            PG8_LDA(At, 1, 1); PG8_STAGE(PG8_SA(1, 0), a3, voffA);
            PG8_BAR; PG8_WAIT_L(0); PG8_MMA(1, 0, At, B0); PG8_BAR; PG8_SCHED;
            PG8_STAGE(PG8_SB(1, 1), b3 + hstep, voffB);
            PG8_WAIT_V(6); PG8_BAR; PG8_MMA(1, 1, At, B1); PG8_BAR;
            }
        }
        if constexpr (ALIGN_EPI) { if (wr == 0) PG8_BAR; }
        if constexpr (!Epi::AFTER_DRAIN) { E(acc, cur, wr, wc, fr, fq); S.done(cur); }
        if (!has_next) break;
#pragma unroll
        for (int a = 0; a < 2; ++a)
#pragma unroll
            for (int b = 0; b < 2; ++b)
#pragma unroll
                for (int m = 0; m < 4; ++m)
#pragma unroll
                    for (int n = 0; n < 2; ++n) acc[a][b][m][n] = (f32x4){0.f, 0.f, 0.f, 0.f};
        cur = nxt; cA = nA; cB = nB; ++ui;
        if constexpr (ALIGN_EPI) { if (wr == 1) PG8_BAR; }
    }
    PG8_WAIT_V(0);
    if constexpr (!ALIGN_EPI) { if (wr == 0) PG8_BAR; }
    PG8_BAR;
    if constexpr (Epi::AFTER_DRAIN) { E.fused(acc, cur, wr, wc, fr, fq, lds, wid, lane); S.done(cur); }
#undef PG8_SA
#undef PG8_SB
#undef PG8_STAGE
#undef PG8_LDA
#undef PG8_LDB
#undef PG8_MMA
#undef PG8_WAIT_V
#undef PG8_WAIT_L
#undef PG8_BAR
#undef PG8_SCHED
}
}

typedef float f32x16 __attribute__((ext_vector_type(16)));
constexpr size_t WS_RST = WS_ST;
constexpr size_t WS_HST = WS_ST + 16 * MiB;
constexpr size_t WS_HD = WS_ST + 48 * MiB;
constexpr size_t OUT_RET = (size_t)MT * D, OUT_HG = OUT_RET + (size_t)16 * 2 * 4 * 128 * 256;

DEVI bf16x8 ldfrag(ldsp base, int stride, int row, int k0, int hh) { return *(const LAS bf16x8*)(base + row * stride + (k0 + 8 * hh) * 2); }
template <int NX> DEVI void mma_nx1(f32x16 (&acc)[NX], ldsp X, int xs, int x0, ldsp Y, int ys, int y0, int ksteps, int r, int hh) {
    for (int s = 0; s < ksteps; ++s) {
        const bf16x8 b = ldfrag(Y, ys, y0 + r, 16 * s, hh);
#pragma unroll
        for (int t = 0; t < NX; ++t) { const bf16x8 a = ldfrag(X, xs, x0 + 32 * t + r, 16 * s, hh); acc[t] = __builtin_amdgcn_mfma_f32_32x32x16_bf16(a, b, acc[t], 0, 0, 0); }
    }
}
template <int NX> DEVI void zero_acc(f32x16 (&acc)[NX]) {
#pragma unroll
    for (int t = 0; t < NX; ++t)
#pragma unroll
        for (int i = 0; i < 16; ++i) acc[t][i] = 0.f;
}
DEVI void stage_nat(ldsp dst, int ls, const bf16_t* src, size_t gstride, int rows, int lc, int tid) {
    const int n = rows << lc;
    for (int u = tid; u < n; u += 512) { const int rr = u >> lc, c = u & ((1 << lc) - 1);
        const u32x4 v = *(const u32x4*)(src + (size_t)rr * gstride + c * 8);
        *(LAS u32x4*)(dst + rr * ls + c * 16) = v; }
}
template <class F> DEVI void stage_tr(ldsp dst, int ls, const bf16_t* src, size_t gstride, int T, int ncol, int tid, F scale) {
    const int lane = tid & 63, wv = tid >> 6, nbj = T >> 5, nbc = ncol >> 5;
    for (int blk = wv; blk < nbj * nbc; blk += 8) {
        const int bj = blk % nbj, bc = blk / nbj, jp = bj * 16 + (lane & 15), cc = bc * 4 + (lane >> 4);
        const u32x4 v0 = *(const u32x4*)(src + (size_t)(2 * jp) * gstride + cc * 8), v1 = *(const u32x4*)(src + (size_t)(2 * jp + 1) * gstride + cc * 8);
        const float s0 = scale(2 * jp), s1 = scale(2 * jp + 1);
#pragma unroll
        for (int q = 0; q < 4; ++q) {
            *(LAS unsigned*)(dst + (cc * 8 + 2 * q) * ls + jp * 4) = pk2(bflo(v0[q]) * s0, bflo(v1[q]) * s1);
            *(LAS unsigned*)(dst + (cc * 8 + 2 * q + 1) * ls + jp * 4) = pk2(bfhi(v0[q]) * s0, bfhi(v1[q]) * s1);
        }
    }
}
DEVI float log2_gamma(const P& p, int dir, int h) { const float rd = p.in[14][dir * 4 + h]; return -log2f(1.0f + expf(-rd)); }
DEVI u32x2 pack4(const f32x16& a, int g) { u32x2 w; w.x = pk2(a[4 * g], a[4 * g + 1]); w.y = pk2(a[4 * g + 2], a[4 * g + 3]); return w; }

DEVI void ret_stage_a(const P& p, ldsp lds, int pass, int item, int tid) {
    const int cg = item >> 2, h = item & 3, lane = tid & 63, w = __builtin_amdgcn_readfirstlane(tid >> 6), r = lane & 31, hh = lane >> 5;
    const bf16_t* PR = (const bf16_t*)(p.ws + WS_PROJ) + (size_t)(cg * 128) * NPROJ;
    const float lgf = log2_gamma(p, 0, h), lgb = log2_gamma(p, 1, h);
    ldsp vT = lds, kfT = lds + 69632, kbT = lds + 104448;
    stage_tr(vT, 272, PR + C_RV + h * 256, NPROJ, 128, 256, tid, [](int) { return 1.0f; });
    stage_tr(kfT, 272, PR + C_RK + h * 128, NPROJ, 128, 128, tid, [lgf](int j) { return exp2f(lgf * (float)(127 - j)); });
    stage_tr(kbT, 272, PR + C_RK + h * 128, NPROJ, 128, 128, tid, [lgb](int j) { return exp2f(lgb * (float)j); });
    __syncthreads();
#pragma unroll 1
    for (int dir = 0; dir < 2; ++dir) {
        f32x16 acc[4]; zero_acc(acc);
        mma_nx1<4>(acc, dir ? kbT : kfT, 272, 0, vT, 272, 32 * w, 8, r, hh);
        bf16_t* ST = (bf16_t*)(p.ws + WS_RST) + ((size_t)(cg * 4 + h) * 2 + dir) * 32768 + (size_t)(32 * w + r) * 128;
#pragma unroll
        for (int t = 0; t < 4; ++t)
#pragma unroll
            for (int g = 0; g < 4; ++g) *(u32x2*)(ST + 32 * t + 8 * g + 4 * hh) = pack4(acc[t], g);
    }
    __syncthreads();
}
DEVI void ret_stage_b(const P& p, int pass, int tid, int G) {
    const int nseq = pass == 0 ? 16 : 2, nc = pass == 0 ? 2 : 16;
    const int total = nseq * 8 * 4096;
    for (int idx = blockIdx.x * 512 + tid; idx < total; idx += G * 512) {
        const int dkg = idx & 15, e = (idx >> 4) & 255, hd = (idx >> 12) & 7, s = idx >> 15, dir = hd & 1, h = hd >> 1, dk0 = dkg * 8;
        const float cdec = exp2f(log2_gamma(p, dir, h) * 128.0f);
        float S[8];
        if (pass == 0) {
#pragma unroll
            for (int i = 0; i < 8; ++i) S[i] = 0.f;
        } else {
            const float* st = p.in[2] + ((size_t)(((pass - 1) * 2 + s) * 2 + dir) * 4 + h) * 32768;
#pragma unroll
            for (int i = 0; i < 8; ++i) S[i] = st[(dk0 + i) * 256 + e];
        }
        for (int cc = 0; cc < nc; ++cc) {
            const int c = dir ? nc - 1 - cc : cc;
            bf16_t* q = (bf16_t*)(p.ws + WS_RST) + ((size_t)((s * nc + c) * 4 + h) * 2 + dir) * 32768 + e * 128 + dk0;
            const u32x4 u = *(const u32x4*)q;
            u32x4 o; o.x = pk2(S[0], S[1]); o.y = pk2(S[2], S[3]); o.z = pk2(S[4], S[5]); o.w = pk2(S[6], S[7]);
            *(u32x4*)q = o;
#pragma unroll
            for (int qq = 0; qq < 4; ++qq) { S[2 * qq] = cdec * S[2 * qq] + bflo(u[qq]); S[2 * qq + 1] = cdec * S[2 * qq + 1] + bfhi(u[qq]); }
        }
        if (pass == 0) {
            float* ns = p.out + OUT_RET + ((size_t)(s * 2 + dir) * 4 + h) * 32768;
#pragma unroll
            for (int i = 0; i < 8; ++i) ns[(dk0 + i) * 256 + e] = S[i];
        }
    }
}
DEVI void ret_stage_c(const P& p, ldsp lds, int pass, int item, int tid) {
    const int cg = item >> 2, h = item & 3, lane = tid & 63, w = __builtin_amdgcn_readfirstlane(tid >> 6), r = lane & 31, hh = lane >> 5;
    const int nc = pass == 0 ? 2 : 16, c = cg % nc;
    const bf16_t* PR = (const bf16_t*)(p.ws + WS_PROJ) + (size_t)(cg * 128) * NPROJ;
    const float lgf = log2_gamma(p, 0, h), lgb = log2_gamma(p, 1, h);
    ldsp qL = lds, kP = lds + 34816, vS = lds + 69632; LAS float* red = (LAS float*)(lds + 139264);
    stage_nat(qL, 272, PR + C_RQ + h * 128, NPROJ, 128, 4, tid);
    stage_nat(kP, 272, PR + C_RK + h * 128, NPROJ, 128, 4, tid);
    stage_tr(vS, 272, PR + C_RV + h * 256, NPROJ, 128, 256, tid, [](int) { return 1.0f; });
    __syncthreads();
    const int ib = w & 3, wh = w >> 2, i = 32 * ib + r;
    {
        f32x16 ap[2]; zero_acc(ap);
        mma_nx1<2>(ap, kP, 272, 64 * wh, qL, 272, 32 * ib, 8, r, hh);
        __syncthreads();
#pragma unroll
        for (int t = 0; t < 2; ++t)
#pragma unroll
            for (int g = 0; g < 4; ++g) {
                float v[4];
#pragma unroll
                for (int e2 = 0; e2 < 4; ++e2) { const int j = 64 * wh + 32 * t + 8 * g + 4 * hh + e2, d = i - j;
                    const float wgt = d > 0 ? exp2f(lgf * (float)d) : (d < 0 ? exp2f(lgb * (float)(-d)) : 2.0f);
                    v[e2] = ap[t][4 * g + e2] * wgt; }
                u32x2 o; o.x = pk2(v[0], v[1]); o.y = pk2(v[2], v[3]);
                *(LAS u32x2*)(kP + i * 272 + (64 * wh + 32 * t + 8 * g + 4 * hh) * 2) = o;
            }
        __syncthreads();
    }
    f32x16 acc[4]; zero_acc(acc);
    mma_nx1<4>(acc, vS, 272, 128 * wh, kP, 272, 32 * ib, 8, r, hh);
    __syncthreads();
#pragma unroll 1
    for (int dir = 0; dir < 2; ++dir) {
        const bool has = pass != 0 || (dir == 0 ? c != 0 : c != nc - 1);
        if (has) {
            const bf16_t* ST = (const bf16_t*)(p.ws + WS_RST) + ((size_t)(cg * 4 + h) * 2 + dir) * 32768;
            stage_nat(vS, 272, ST, 128, 256, 4, tid);
            __syncthreads();
            f32x16 tmp[4]; zero_acc(tmp);
            mma_nx1<4>(tmp, vS, 272, 128 * wh, qL, 272, 32 * ib, 8, r, hh);
            const float sc = dir == 0 ? exp2f(lgf * (float)(i + 1)) : exp2f(lgb * (float)(128 - i));
#pragma unroll
            for (int t = 0; t < 4; ++t)
#pragma unroll
                for (int q = 0; q < 16; ++q) acc[t][q] += tmp[t][q] * sc;
            __syncthreads();
        }
    }
    float ss = 0.f;
#pragma unroll
    for (int t = 0; t < 4; ++t)
#pragma unroll
        for (int q = 0; q < 16; ++q) ss += acc[t][q] * acc[t][q];
    ss += __shfl_xor(ss, 32);
    if (hh == 0) red[wh * 128 + i] = ss;
    __syncthreads();
    const float rstd = rsqrtf((red[i] + red[128 + i]) * (1.0f / 256.0f) + EPS);
    const bf16_t* rg = PR + (size_t)i * NPROJ + C_RG + h * 256 + 128 * wh;
    bf16_t* O = (bf16_t*)(p.ws + WS_ORET) + (size_t)(pass * PASS_ROWS + cg * 128 + i) * 1024 + h * 256 + 128 * wh;
#pragma unroll
    for (int t = 0; t < 4; ++t)
#pragma unroll
        for (int g = 0; g < 4; ++g) { const int e = 32 * t + 8 * g + 4 * hh; const u32x2 gv = *(const u32x2*)(rg + e);
            u32x2 o; o.x = pk2(acc[t][4 * g] * rstd * bflo(gv.x), acc[t][4 * g + 1] * rstd * bfhi(gv.x)); o.y = pk2(acc[t][4 * g + 2] * rstd * bflo(gv.y), acc[t][4 * g + 3] * rstd * bfhi(gv.y));
            *(u32x2*)(O + e) = o; }
    __syncthreads();
}

DEVI void hg_stage_a(const P& p, ldsp lds, int pass, int item, int tid) {
    const int cg = item >> 3, h = item & 7, lane = tid & 63, w = __builtin_amdgcn_readfirstlane(tid >> 6), r = lane & 31, hh = lane >> 5;
    const bf16_t* PR = (const bf16_t*)(p.ws + WS_PROJ) + (size_t)(cg * 64) * NPROJ;
    ldsp graw = lds, vT = lds + 34816, kT = lds + 53248;
    stage_nat(graw, 272, PR + C_GF + h * 128, NPROJ, 64, 4, tid);
    stage_nat(graw + 17408, 272, PR + C_GB + h * 128, NPROJ, 64, 4, tid);
    stage_tr(vT, 144, PR + C_HI + h * 128, NPROJ, 64, 128, tid, [](int) { return 1.0f; });
    __syncthreads();
    if (tid < 256) {
        const int dir = tid >> 7, dk = tid & 127;
        const LAS bf16_t* g = (const LAS bf16_t*)(graw + dir * 17408) + dk;
        ldsp kd = kT + dir * 18432 + dk * 144;
        float run = 0.f;
        if (dir == 0) {
#pragma unroll 1
            for (int jg = 7; jg >= 0; --jg) {
                float v[8];
#pragma unroll
                for (int jj = 7; jj >= 0; --jj) { const float gv = bf2f(g[(8 * jg + jj) * 136]); v[jj] = (1.0f - __expf(gv)) * __expf(run); run += gv; }
                u32x4 o; o.x = pk2(v[0], v[1]); o.y = pk2(v[2], v[3]); o.z = pk2(v[4], v[5]); o.w = pk2(v[6], v[7]);
                *(LAS u32x4*)(kd + jg * 16) = o;
            }
        } else {
#pragma unroll 1
            for (int jg = 0; jg < 8; ++jg) {
                float v[8];
#pragma unroll
                for (int jj = 0; jj < 8; ++jj) { const float gv = bf2f(g[(8 * jg + jj) * 136]); v[jj] = (1.0f - __expf(gv)) * __expf(run); run += gv; }
                u32x4 o; o.x = pk2(v[0], v[1]); o.y = pk2(v[2], v[3]); o.z = pk2(v[4], v[5]); o.w = pk2(v[6], v[7]);
                *(LAS u32x4*)(kd + jg * 16) = o;
            }
        }
        ((float*)(p.ws + WS_HD))[((size_t)(cg * 8 + h) * 2 + dir) * 128 + dk] = __expf(run);
    }
    __syncthreads();
#pragma unroll 1
    for (int dir = 0; dir < 2; ++dir) {
        f32x16 acc[2]; zero_acc(acc);
        mma_nx1<2>(acc, kT + dir * 18432, 144, 64 * (w >> 2), vT, 144, 32 * (w & 3), 4, r, hh);
        bf16_t* ST = (bf16_t*)(p.ws + WS_HST) + ((size_t)(cg * 8 + h) * 2 + dir) * 16384 + (size_t)(32 * (w & 3) + r) * 128 + 64 * (w >> 2);
#pragma unroll
        for (int t = 0; t < 2; ++t)
#pragma unroll
            for (int g = 0; g < 4; ++g) *(u32x2*)(ST + 32 * t + 8 * g + 4 * hh) = pack4(acc[t], g);
    }
    __syncthreads();
}
DEVI void hg_stage_b(const P& p, int pass, int tid, int G) {
    const int nseq = pass == 0 ? 16 : 2, nc = pass == 0 ? 4 : 32;
    const int total = nseq * 16 * 2048;
    for (int idx = blockIdx.x * 512 + tid; idx < total; idx += G * 512) {
        const int dkg = idx & 15, e = (idx >> 4) & 127, hd = (idx >> 11) & 15, s = idx >> 15, dir = hd & 1, h = hd >> 1, dk0 = dkg * 8;
        float S[8];
        if (pass == 0) {
#pragma unroll
            for (int i = 0; i < 8; ++i) S[i] = 0.f;
        } else {
            const float* st = p.in[3] + ((size_t)(((pass - 1) * 2 + s) * 2 + dir) * 8 + h) * 16384;
#pragma unroll
            for (int i = 0; i < 8; ++i) S[i] = st[(dk0 + i) * 128 + e];
        }
        for (int cc = 0; cc < nc; ++cc) {
            const int c = dir ? nc - 1 - cc : cc;
            const size_t ci = (size_t)((s * nc + c) * 8 + h) * 2 + dir;
            bf16_t* q = (bf16_t*)(p.ws + WS_HST) + ci * 16384 + e * 128 + dk0;
            const float* dv = (const float*)(p.ws + WS_HD) + ci * 128 + dk0;
            const u32x4 u = *(const u32x4*)q; const f32x4 d0 = *(const f32x4*)dv, d1 = *(const f32x4*)(dv + 4);
            u32x4 o; o.x = pk2(S[0], S[1]); o.y = pk2(S[2], S[3]); o.z = pk2(S[4], S[5]); o.w = pk2(S[6], S[7]);
            *(u32x4*)q = o;
#pragma unroll
            for (int qq = 0; qq < 4; ++qq) { const float da = qq < 2 ? d0[2 * qq] : d1[2 * qq - 4], db = qq < 2 ? d0[2 * qq + 1] : d1[2 * qq - 3];
                S[2 * qq] = da * S[2 * qq] + bflo(u[qq]); S[2 * qq + 1] = db * S[2 * qq + 1] + bfhi(u[qq]); }
        }
        if (pass == 0) {
            float* ns = p.out + OUT_HG + ((size_t)(s * 2 + dir) * 8 + h) * 16384;
#pragma unroll
            for (int i = 0; i < 8; ++i) ns[(dk0 + i) * 128 + e] = S[i];
        }
    }
}
DEVI void hg_stage_c(const P& p, ldsp lds, int pass, int item, int tid) {
    const int cg = item >> 3, h = item & 7, lane = tid & 63, w = __builtin_amdgcn_readfirstlane(tid >> 6), r = lane & 31, hh = lane >> 5;
    const int nc = pass == 0 ? 4 : 32, c = cg % nc;
    const bool hasF = pass != 0 || c != 0, hasB = pass != 0 || c != nc - 1;
    const bf16_t* PR = (const bf16_t*)(p.ws + WS_PROJ) + (size_t)(cg * 64) * NPROJ;
    ldsp raw = lds, img = lds + 69632, vT = lds + 139264; LAS float* ref = (LAS float*)(lds + 157696); LAS float* red = (LAS float*)(lds + 158720);
    stage_nat(raw, 272, PR + C_GF + h * 128, NPROJ, 64, 4, tid);
    stage_nat(raw + 17408, 272, PR + C_GB + h * 128, NPROJ, 64, 4, tid);
    stage_nat(raw + 34816, 272, PR + C_HQ + h * 128, NPROJ, 64, 4, tid);
    stage_tr(vT, 144, PR + C_HI + h * 128, NPROJ, 64, 128, tid, [](int) { return 1.0f; });
    __syncthreads();
    if (tid < 256) {
        const int dir = tid >> 7, dk = tid & 127;
        const LAS bf16_t* g = (const LAS bf16_t*)(raw + dir * 17408) + dk;
        const LAS bf16_t* qr = (const LAS bf16_t*)(raw + 34816) + dk;
        LAS bf16_t* qi = (LAS bf16_t*)(img + dir * 34816) + dk; LAS bf16_t* ki = (LAS bf16_t*)(img + dir * 34816 + 17408) + dk;
        float d = 0.f;
#pragma unroll 4
        for (int t = 0; t < 32; ++t) { const int j = dir == 0 ? 31 - t : 32 + t; const float gv = bf2f(g[j * 136]);
            const float qv = bf2f(qr[j * 136]), kv = 1.0f - __expf(gv);
            qi[j * 136] = (bf16_t)f2bf(qv * __expf(d)); ki[j * 136] = (bf16_t)f2bf(kv * __expf(-d)); d -= gv; }
        ref[dir * 128 + dk] = __expf(-d);
        d = 0.f;
#pragma unroll 4
        for (int t = 0; t < 32; ++t) { const int j = dir == 0 ? 32 + t : 31 - t; const float gv = bf2f(g[j * 136]);
            d += gv;
            const float qv = bf2f(qr[j * 136]), kv = 1.0f - __expf(gv);
            qi[j * 136] = (bf16_t)f2bf(qv * __expf(d)); ki[j * 136] = (bf16_t)f2bf(kv * __expf(-d)); }
    }
    __syncthreads();
    ldsp qF = img, kF = img + 17408, qB = img + 34816, kB = img + 52224, Pm = kF;
    f32x16 af[1], ab[1];
    if (w < 4) {
        zero_acc(af); zero_acc(ab);
        mma_nx1<1>(af, kF, 272, 32 * (w >> 1), qF, 272, 32 * (w & 1), 8, r, hh);
        mma_nx1<1>(ab, kB, 272, 32 * (w >> 1), qB, 272, 32 * (w & 1), 8, r, hh);
    } else {
        const int t2 = tid - 256;
#pragma unroll 1
        for (int dir = 0; dir < 2; ++dir) {
            if (dir == 0 ? !hasF : !hasB) continue;
            const bf16_t* ST = (const bf16_t*)(p.ws + WS_HST) + ((size_t)(cg * 8 + h) * 2 + dir) * 16384;
            for (int u = t2; u < 2048; u += 256) { const int e = u >> 4, ch = u & 15;
                const u32x4 v = *(const u32x4*)(ST + e * 128 + ch * 8);
                const LAS float* rf = ref + dir * 128 + ch * 8;
                u32x4 o;
#pragma unroll
                for (int q = 0; q < 4; ++q) o[q] = pk2(bflo(v[q]) * rf[2 * q], bfhi(v[q]) * rf[2 * q + 1]);
                *(LAS u32x4*)(raw + dir * 34816 + e * 272 + ch * 16) = o; }
        }
    }
    __syncthreads();
    if (w < 4) {
        const int i = 32 * (w & 1) + r;
#pragma unroll
        for (int g = 0; g < 4; ++g) { float v[4];
#pragma unroll
            for (int e2 = 0; e2 < 4; ++e2) { const int j = 32 * (w >> 1) + 8 * g + 4 * hh + e2; v[e2] = (j <= i ? af[0][4 * g + e2] : 0.f) + (j >= i ? ab[0][4 * g + e2] : 0.f); }
            u32x2 o; o.x = pk2(v[0], v[1]); o.y = pk2(v[2], v[3]);
            *(LAS u32x2*)(Pm + i * 144 + (32 * (w >> 1) + 8 * g + 4 * hh) * 2) = o; }
    }
    __syncthreads();
    const int eb = w >> 1, ib = w & 1, i = 32 * ib + r;
    f32x16 acc[1]; zero_acc(acc);
    mma_nx1<1>(acc, vT, 144, 32 * eb, Pm, 144, 32 * ib, 4, r, hh);
    if (hasF) mma_nx1<1>(acc, raw, 272, 32 * eb, qF, 272, 32 * ib, 8, r, hh);
    if (hasB) mma_nx1<1>(acc, raw + 34816, 272, 32 * eb, qB, 272, 32 * ib, 8, r, hh);
    float ss = 0.f;
#pragma unroll
    for (int q = 0; q < 16; ++q) ss += acc[0][q] * acc[0][q];
    ss += __shfl_xor(ss, 32);
    if (hh == 0) red[eb * 64 + i] = ss;
    __syncthreads();
    const float rstd = rsqrtf((red[i] + red[64 + i] + red[128 + i] + red[192 + i]) * (1.0f / 128.0f) + EPS);
    const bf16_t* og = PR + (size_t)i * NPROJ + C_HOG + h * 128 + 32 * eb;
    const float* nw = p.in[16] + h * 128 + 32 * eb;
    bf16_t* O = (bf16_t*)(p.ws + WS_OHG) + (size_t)(pass * PASS_ROWS + cg * 64 + i) * 1024 + h * 128 + 32 * eb;
#pragma unroll
    for (int g = 0; g < 4; ++g) { const int e = 8 * g + 4 * hh; const u32x2 gv = *(const u32x2*)(og + e); const f32x4 n4 = *(const f32x4*)(nw + e);
        u32x2 o; o.x = pk2(acc[0][4 * g] * rstd * n4[0] * bflo(gv.x), acc[0][4 * g + 1] * rstd * n4[1] * bfhi(gv.x));
        o.y = pk2(acc[0][4 * g + 2] * rstd * n4[2] * bflo(gv.y), acc[0][4 * g + 3] * rstd * n4[3] * bfhi(gv.y));
        *(u32x2*)(O + e) = o; }
    __syncthreads();
}
DEVI int scan_nitems(int b, int G) { return G == 256 ? (b < 128 ? 2 : 3) : (640 - b + G - 1) / G; }
DEVI int scan_item(int b, int G, int k) { return G == 256 ? (b < 128 ? (k == 0 ? b : 128 + b) : 256 + (b - 128) * 3 + k) : b + k * G; }
#undef SCAN_A
#undef SCAN_B
#undef SCAN_C
#define SCAN_A { int tid = threadIdx.x; asm volatile("" : "+v"(tid)); const int n_ = scan_nitems(blockIdx.x, G); \
    for (int k_ = 0; k_ < n_; ++k_) { const int it_ = scan_item(blockIdx.x, G, k_); if (it_ < 128) ret_stage_a(p, lds, pass, it_, tid); else hg_stage_a(p, lds, pass, it_ - 128, tid); } }
#define SCAN_B { int tid = threadIdx.x; asm volatile("" : "+v"(tid)); ret_stage_b(p, pass, tid, G); hg_stage_b(p, pass, tid, G); }
#define SCAN_C { int tid = threadIdx.x; asm volatile("" : "+v"(tid)); const int n_ = scan_nitems(blockIdx.x, G); \
    for (int k_ = 0; k_ < n_; ++k_) { const int it_ = scan_item(blockIdx.x, G, k_); if (it_ < 128) ret_stage_c(p, lds, pass, it_, tid); else hg_stage_c(p, lds, pass, it_ - 128, tid); } }

constexpr int NWAVES = 8;
constexpr int LDS_BYTES = 163840;


DEVI float wave_sum(float v) {
#pragma unroll
    for (int o = 1; o < 64; o <<= 1) v += __shfl_xor(v, o);
    return v;
}

DEVI int map_row(int mode, int n) {
    if (mode == 1) { const int s = n >= 2816 ? 1 : 0, j = n - s * 2816; return 256 * (j >> 7) + 128 * s + (j & 127); }
    if (mode == 2) { if (n >= 1024) return n; const int t = n >> 8, q = n & 255, hh = q >> 7, part = (q >> 6) & 1, bj = (q >> 5) & 1, i = q & 31; return 256 * t + 128 * bj + 64 * hh + 32 * part + i; }
    return n;
}
DEVI void transpose_item(const float* __restrict__ W, int ldw, int n_base, bf16_t* __restrict__ WT, int Kdst, int koff, int mode, LAS float* scr, int item, int nblk, int lane) {
    const int kb = item / nblk, nb = item - kb * nblk, k0 = 64 * kb, n0 = 32 * nb;
#pragma unroll 8
    for (int i = 0; i < 32; ++i) { const int kk = 2 * i + (lane >> 5); scr[kk * 33 + (lane & 31)] = W[(size_t)(k0 + kk) * ldw + n_base + n0 + (lane & 31)]; }
    asm volatile("s_waitcnt lgkmcnt(0)" ::: "memory");
    const int c = lane & 7;
#pragma unroll
    for (int j = 0; j < 4; ++j) { const int n = (lane >> 3) + 8 * j; const LAS float* s = scr + (8 * c) * 33 + n;
        u32x4 o; o.x = pk2(s[0 * 33], s[1 * 33]); o.y = pk2(s[2 * 33], s[3 * 33]); o.z = pk2(s[4 * 33], s[5 * 33]); o.w = pk2(s[6 * 33], s[7 * 33]);
        *(u32x4*)(WT + (size_t)map_row(mode, n0 + n) * Kdst + koff + k0 + 8 * c) = o; }
    asm volatile("s_waitcnt lgkmcnt(0)" ::: "memory");
}
DEVI void phase_prologue(const P& p, ldsp lds, int tid, int lane, int wave, int G) {
    if ((int)blockIdx.x < 144) {
        LAS float* sc = (LAS float*)lds;
        LAS float* red = sc + 5 * 1024;
        for (int i = tid; i < 5 * 1024; i += 512) { const int r = i >> 10, k = i & 1023; const float v = r == 0 ? p.in[5][k] : p.in[4][(r - 1) * 1024 + k]; sc[i] = siluf_(v); }
        __syncthreads();
        const int col = blockIdx.x * 64 + lane;
        const float* W = p.in[6];
        float a0 = 0.f, a1 = 0.f, a2 = 0.f, a3 = 0.f, a4 = 0.f;
#pragma unroll 8
        for (int kk = 0; kk < 128; ++kk) { const int k = wave * 128 + kk; const float w = W[(size_t)k * NMOD + col];
            a0 += sc[k] * w; a1 += sc[1024 + k] * w; a2 += sc[2048 + k] * w; a3 += sc[3072 + k] * w; a4 += sc[4096 + k] * w; }
        red[(wave * 5 + 0) * 64 + lane] = a0; red[(wave * 5 + 1) * 64 + lane] = a1; red[(wave * 5 + 2) * 64 + lane] = a2; red[(wave * 5 + 3) * 64 + lane] = a3; red[(wave * 5 + 4) * 64 + lane] = a4;
        __syncthreads();
        if (tid < 320) { const int r = tid >> 6, l = tid & 63; float s = 0.f;
#pragma unroll
            for (int w = 0; w < 8; ++w) s += red[(w * 5 + r) * 64 + l];
            const int cc = blockIdx.x * 64 + l;
            ((float*)(p.ws + WS_MOD))[r * NMOD + cc] = s + p.in[7][cc]; }
        __syncthreads();
    }
    if ((int)blockIdx.x == G - 1) {
        for (int i = tid; i < 2048; i += 512) {
            const int d = i >> 10, k = i & 1023;
            const float l0 = p.in[15][(d * 2 + 0) * 1024 + k], l1 = p.in[15][(d * 2 + 1) * 1024 + k];
            ((float*)(p.ws + WS_LB))[i] = 1.0f / (1.0f + expf(l1 - l0));
            const int pos = i >> 5, fi = i & 31;
            const double inv = exp(-(double)fi / 32.0 * log(10000.0));
            const float angf = (float)pos * (float)inv;
            double a = (double)angf; const double twopi = 6.283185307179586476925;
            a -= twopi * rint(a / twopi);
            double s = 0.0, c = 0.0, a2 = a * a, tc = 1.0, ts = a;
            for (int n = 0; n < 14; ++n) { c += tc; s += ts; tc *= -a2 / ((2 * n + 1) * (2 * n + 2)); ts *= -a2 / ((2 * n + 2) * (2 * n + 3)); }
            float* rt = (float*)(p.ws + WS_ROPE); rt[i * 2] = (float)c; rt[i * 2 + 1] = (float)s;
        }
    }
    LAS float* scr = (LAS float*)(lds + 32768 + wave * 8704);
    const int gw = blockIdx.x * NWAVES + wave, NGW = G * NWAVES;
    constexpr int I13 = 16 * 176, I2 = 44 * 32, IWIN = 16 * 256, IWG = 16 * 64, ISQ = 16 * 32;
    constexpr int NITEMS = 2 * I13 + 2 * I2 + IWIN + IWG + 3 * ISQ;
    unsigned char* ws = p.ws;
    for (int it = gw; it < NITEMS; it += NGW) {
        int r = it;
        if (r < I13) { transpose_item(p.in[9], 5632, 0, (bf16_t*)(ws + WS_W13A), 1024, 0, 1, scr, r, 176, lane); continue; } r -= I13;
        if (r < I13) { transpose_item(p.in[11], 5632, 0, (bf16_t*)(ws + WS_W13B), 1024, 0, 1, scr, r, 176, lane); continue; } r -= I13;
        if (r < I2) { transpose_item(p.in[10], 1024, 0, (bf16_t*)(ws + WS_W2A), 2816, 0, 0, scr, r, 32, lane); continue; } r -= I2;
        if (r < I2) { transpose_item(p.in[12], 1024, 0, (bf16_t*)(ws + WS_W2B), 2816, 0, 0, scr, r, 32, lane); continue; } r -= I2;
        if (r < IWIN) { transpose_item(p.in[13], WIN_N, 0, (bf16_t*)(ws + WS_WIN), 1024, 0, 2, scr, r, 256, lane); continue; } r -= IWIN;
        if (r < IWG) { transpose_item(p.in[13], WIN_N, W_GR, (bf16_t*)(ws + WS_WG), 1024, 0, 0, scr, r, 64, lane); continue; } r -= IWG;
        if (r < ISQ) { transpose_item(p.in[17], 1024, 0, (bf16_t*)(ws + WS_WR), 1024, 0, 0, scr, r, 32, lane); continue; } r -= ISQ;
        if (r < ISQ) { transpose_item(p.in[18], 1024, 0, (bf16_t*)(ws + WS_WH), 1024, 0, 0, scr, r, 32, lane); continue; } r -= ISQ;
        transpose_item(p.in[19], 1024, 0, (bf16_t*)(ws + WS_WO), 1024, 0, 0, scr, r, 32, lane);
    }
}

DEVI void phase_modnorm(const P& p, int which, int lane, int wave, int G) {
    const int gw = blockIdx.x * NWAVES + wave, NGW = G * NWAVES;
    for (int m = gw; m < MT; m += NGW) {
        const float* xr = which == 0 ? (m < MP ? p.in[0] + (size_t)m * D : p.in[1] + (size_t)(m - MP) * D) : p.out + (size_t)m * D;
        f32x4 v[4]; float ss = 0.f;
#pragma unroll
        for (int j = 0; j < 4; ++j) { v[j] = *(const f32x4*)(xr + 4 * lane + 256 * j); ss += (v[j][0] * v[j][0] + v[j][1] * v[j][1]) + (v[j][2] * v[j][2] + v[j][3] * v[j][3]); }
        const float rstd = rsqrtf(wave_sum(ss) * (1.0f / D) + EPS);
        if (which == 3) {
            float* o = p.out + (size_t)m * D;
#pragma unroll
            for (int j = 0; j < 4; ++j) { const int c = 4 * lane + 256 * j; const f32x4 w = *(const f32x4*)(p.in[20] + c); *(f32x4*)(o + c) = v[j] * rstd * w; }
        } else {
            const float* nw = p.in[8] + which * D;
            const float* mod = (const float*)(p.ws + WS_MOD) + (size_t)mod_row(m) * NMOD;
            const float* sh = mod + (which * 3) * D; const float* sc = mod + (which * 3 + 1) * D;
            bf16_t* h = (bf16_t*)(p.ws + WS_H) + (size_t)m * D;
#pragma unroll
            for (int j = 0; j < 4; ++j) { const int c = 4 * lane + 256 * j;
                const f32x4 w = *(const f32x4*)(nw + c), s4 = *(const f32x4*)(sc + c), h4 = *(const f32x4*)(sh + c);
                const f32x4 y = v[j] * rstd * w * (s4 + 1.0f) + h4;
                u32x2 o; o.x = pk2(y[0], y[1]); o.y = pk2(y[2], y[3]); *(u32x2*)(h + c) = o; }
        }
    }
}

#ifndef PHMASK
#define PHMASK 0xffff
#endif
#define PH(k) if (p.lo <= (k) && (k) < p.hi)
#define SYNC(k) do { if (p.lo <= (k) && (k) + 1 < p.hi) { asm volatile("s_waitcnt vmcnt(0) lgkmcnt(0)" ::: "memory"); cg::this_grid().sync(); } } while (0)
#define GEMM_UP(WOFF) do { pg8::Gemm g{(const bf16_t*)(ws + WS_H), (const bf16_t*)(ws + (WOFF)), MT, 2 * FF, D}; \
    pg8::StaticOrder S; S.init(MT, 2 * FF, G, (int)blockIdx.x); pg8::EpiSwiglu E{(bf16_t*)(ws + WS_PROJ)}; \
    pg8::gemm_phase<pg8::EpiSwiglu, pg8::StaticOrder, true, true>(lds, g, S, E); } while (0)
#define GEMM_RES(AOFF, WOFF, KK, XP, XS, GIDX, SCL) do { pg8::Gemm g{(const bf16_t*)(ws + (AOFF)), (const bf16_t*)(ws + (WOFF)), MT, D, (KK)}; \
    pg8::StaticOrder S; S.init(MT, D, G, (int)blockIdx.x); pg8::EpiResid E{(XP), (XS), p.out, (const float*)(ws + WS_MOD), (GIDX), (SCL)}; \
    pg8::gemm_phase<pg8::EpiResid, pg8::StaticOrder, true, true>(lds, g, S, E); } while (0)

__global__ void __launch_bounds__(NWAVES * 64, 2) mk(P p) {
    extern __shared__ __attribute__((aligned(16))) unsigned char lds_raw[];
    ldsp lds = (ldsp)lds_raw;
    const int G = gridDim.x;
    unsigned char* ws = p.ws;
#define TIDS int tid = threadIdx.x; asm volatile("" : "+v"(tid)); const int lane = tid & 63, wave = __builtin_amdgcn_readfirstlane(tid >> 6); (void)lane; (void)wave;
    PH(0) { if (PHMASK & 1) { TIDS phase_prologue(p, lds, tid, lane, wave, G); } } SYNC(0);
    PH(1) { if (PHMASK & 2) { TIDS phase_modnorm(p, 0, lane, wave, G); } } SYNC(1);
    PH(2) { if (PHMASK & 4) GEMM_UP(WS_W13A); } SYNC(2);
    PH(3) { if (PHMASK & 8) GEMM_RES(WS_PROJ, WS_W2A, FF, p.in[0], p.in[1], 2, 0.5f); } SYNC(3);
    PH(4) { if (PHMASK & 2) { TIDS phase_modnorm(p, 1, lane, wave, G); } } SYNC(4);
    for (int pass = 0; pass < 3; ++pass) {
        const int b = 5 + 4 * pass;
        PH(b) { if (PHMASK & 16) {
            pg8::Gemm g{(const bf16_t*)(ws + WS_H) + (size_t)pass * PASS_ROWS * D, (const bf16_t*)(ws + WS_WIN), PASS_ROWS, NPROJ, D};
            pg8::StaticOrder S; S.init(PASS_ROWS, NPROJ, G, (int)blockIdx.x);
            pg8::EpiWin E{(bf16_t*)(ws + WS_PROJ), (const float*)(ws + WS_LB), (const float*)(ws + WS_ROPE), pass};
            pg8::gemm_phase<pg8::EpiWin, pg8::StaticOrder, true, true>(lds, g, S, E); } } SYNC(b);
        PH(b + 1) { SCAN_A } SYNC(b + 1);
        PH(b + 2) { SCAN_B } SYNC(b + 2);
        PH(b + 3) { SCAN_C } SYNC(b + 3);
    }
    PH(17) { if (PHMASK & 32) {
        pg8::Gemm g{(const bf16_t*)(ws + WS_H), (const bf16_t*)(ws + WS_WG), MT, 2048, D};
        pg8::StaticOrder S; S.init(MT, 2048, G, (int)blockIdx.x);
        pg8::EpiGates E{(bf16_t*)(ws + WS_PROJ)};
        pg8::gemm_phase<pg8::EpiGates, pg8::StaticOrder, true, true>(lds, g, S, E); } } SYNC(17);
    PH(18) { if (PHMASK & 64) {
        { pg8::Gemm g{(const bf16_t*)(ws + WS_ORET), (const bf16_t*)(ws + WS_WR), MT, D, D};
          pg8::StaticOrder S; S.init(MT, D, G, (int)blockIdx.x);
          pg8::EpiMergeA E{(const bf16_t*)(ws + WS_PROJ), (float*)(ws + WS_ST)};
          pg8::gemm_phase<pg8::EpiMergeA, pg8::StaticOrder, true, true>(lds, g, S, E); }
        { pg8::Gemm g{(const bf16_t*)(ws + WS_OHG), (const bf16_t*)(ws + WS_WH), MT, D, D};
          pg8::StaticOrder S; S.init(MT, D, G, (int)blockIdx.x);
          pg8::EpiMergeB E{(const bf16_t*)(ws + WS_PROJ), (const float*)(ws + WS_ST), (bf16_t*)(ws + WS_H)};
          pg8::gemm_phase<pg8::EpiMergeB, pg8::StaticOrder, true, true>(lds, g, S, E); } } } SYNC(18);
    PH(19) { if (PHMASK & 8) GEMM_RES(WS_H, WS_WO, D, p.out, p.out + (size_t)MP * D, 5, 1.0f); } SYNC(19);
    PH(20) { if (PHMASK & 2) { TIDS phase_modnorm(p, 2, lane, wave, G); } } SYNC(20);
    PH(21) { if (PHMASK & 4) GEMM_UP(WS_W13B); } SYNC(21);
    PH(22) { if (PHMASK & 8) GEMM_RES(WS_PROJ, WS_W2B, FF, p.out, p.out + (size_t)MP * D, 8, 0.5f); } SYNC(22);
    PH(23) { if (PHMASK & 2) { TIDS phase_modnorm(p, 3, lane, wave, G); } }
}

static int g_grid = 0;
static void launch_mk(const P& base, int lo, int hi, hipStream_t stream, bool coop) {
    P p = base; p.lo = lo; p.hi = hi;
    if (coop) { void* args[] = {&p}; hipError_t e = hipLaunchCooperativeKernel((void*)mk, dim3(g_grid), dim3(NWAVES * 64), args, LDS_BYTES, stream);
        if (e != hipSuccess) fprintf(stderr, "cooperative launch failed: %s (grid %d)\n", hipGetErrorString(e), g_grid); }
    else hipLaunchKernelGGL(mk, dim3(g_grid), dim3(NWAVES * 64), LDS_BYTES, stream, p);
}

extern "C" void kernel_launch(void* const* d_in, const int* in_sizes, int n_in, void* d_out, int out_size, void* d_ws, size_t ws_size, hipStream_t stream) {
    if (g_grid == 0) {
        int dev = 0, cus = 0, per_cu = 0;
        hipGetDevice(&dev);
        hipDeviceGetAttribute(&cus, hipDeviceAttributeMultiprocessorCount, dev);
        hipFuncSetAttribute((const void*)mk, hipFuncAttributeMaxDynamicSharedMemorySize, LDS_BYTES);
        hipOccupancyMaxActiveBlocksPerMultiprocessor(&per_cu, (const void*)mk, NWAVES * 64, LDS_BYTES);
        if (per_cu < 1) per_cu = 1;
        g_grid = cus * per_cu;
        (void)hipGetLastError();
    }
    P p{};
    for (int i = 0; i < 21; ++i) p.in[i] = (const float*)d_in[i];
    p.out = (float*)d_out; p.ws = (unsigned char*)d_ws;
#if HYBRID
    launch_mk(p, 0, 5, stream, true);
    for (int pass = 0; pass < 3; ++pass) {
        const int nseq = pass == 0 ? 16 : 2;
        launch_mk(p, 5 + 4 * pass, 9 + 4 * pass, stream, true);
#if HYBRID == 2 || HYBRID == 4
        k_ret_scan<<<nseq * 8, 256, 0, stream>>>(p, pass);
        k_ret_fin<<<PASS_ROWS * 4 / 4, 256, 0, stream>>>(p, pass);
#endif
#if HYBRID == 3 || HYBRID == 4
        k_hg_scan<<<nseq * 16, 128, 0, stream>>>(p, pass);
        k_hg_fin<<<PASS_ROWS * 8 / 4, 256, 0, stream>>>(p, pass);
#endif
    }
    launch_mk(p, 17, 24, stream, true);
#else
    launch_mk(p, 0, 24, stream, true);
#endif
}
```

```cpp
#include <hip/hip_runtime.h>
#include <hip/hip_cooperative_groups.h>
#include <cstdint>
#include <cstdio>
namespace cg = cooperative_groups;

#define DEVI __device__ __forceinline__
#define LAS __attribute__((address_space(3)))
#define GAS __attribute__((address_space(1)))

constexpr int D = 1024, MP = 4096, MS = 8192, MT = 12288, FF = 2816, NPROJ = 8192, NMOD = 9 * 1024;
constexpr int PASS_ROWS = 4096;
constexpr float EPS = 1e-6f;
constexpr int C_RQ = 0, C_RK = 512, C_RV = 1024, C_RG = 2048, C_HQ = 3072, C_GF = 4096, C_GB = 5120, C_HI = 6144, C_HOG = 7168;
constexpr int W_GR = 8192, WIN_N = 10240;
constexpr float QK_SCALE = 0.08838834764831845f;

constexpr size_t MiB = 1u << 20;
constexpr size_t WS_MOD = 0;
constexpr size_t WS_LB = 192 * 1024;
constexpr size_t WS_ROPE = 200 * 1024;
constexpr size_t WS_W13A = 1 * MiB, WS_W2A = 12 * MiB, WS_W13B = 18 * MiB, WS_W2B = 29 * MiB;
constexpr size_t WS_WIN = 35 * MiB, WS_WG = 51 * MiB, WS_WR = 55 * MiB, WS_WH = 57 * MiB, WS_WO = 59 * MiB;
constexpr size_t WS_H = 61 * MiB;
constexpr size_t WS_ORET = 85 * MiB, WS_OHG = 109 * MiB;
constexpr size_t WS_PROJ = 133 * MiB;
constexpr size_t WS_ST = 199 * MiB;

typedef unsigned short bf16_t;
typedef float f32x4 __attribute__((ext_vector_type(4)));
typedef float f32x2 __attribute__((ext_vector_type(2)));
typedef unsigned u32x4 __attribute__((ext_vector_type(4)));
typedef unsigned u32x2 __attribute__((ext_vector_type(2)));
typedef short bf16x8 __attribute__((ext_vector_type(8)));

struct P {
    const float* in[21];
    float* out;
    unsigned char* ws;
    int lo, hi;
};

DEVI float bf2f(bf16_t v) { return __uint_as_float(((unsigned)v) << 16); }
DEVI unsigned f2bf(float f) { unsigned u = __float_as_uint(f); return (u + 0x7fffu + ((u >> 16) & 1u)) >> 16; }
typedef __bf16 bf16x2_t __attribute__((ext_vector_type(2)));
DEVI unsigned pk2(float lo, float hi) { bf16x2_t v; v[0] = (__bf16)lo; v[1] = (__bf16)hi; return __builtin_bit_cast(unsigned, v); }
DEVI float bflo(unsigned w) { return __uint_as_float(w << 16); }
DEVI float bfhi(unsigned w) { return __uint_as_float(w & 0xffff0000u); }
DEVI float sigmoidf_(float x) { return 1.0f / (1.0f + __expf(-x)); }
DEVI float siluf_(float x) { return x / (1.0f + __expf(-x)); }
DEVI int mod_row(int m) { return m < MP ? 0 : 1 + ((m - MP) >> 11); }

typedef LAS unsigned char* ldsp;
#define HYBRID 0
namespace pg8 {
#define PG8_LAS __attribute__((address_space(3)))
typedef unsigned short bf16_t;
typedef short bf16x8 __attribute__((ext_vector_type(8)));
typedef float f32x4 __attribute__((ext_vector_type(4)));
typedef unsigned u32x4 __attribute__((ext_vector_type(4)));
constexpr int BM = 256, BK = 64, HALF = 128, HTB = HALF * BK * 2  , STAGE_BYTES = 8 * HTB, NXCD = 8, WGM = 8;

__host__ __device__ __forceinline__ int lds_byte(int r, int c) { const int st = (r >> 4) * 2 + (c >> 5), rr = r & 15, cc = c & 31, ob = rr * 64 + cc * 2; return st * 1024 + (ob ^ (((ob >> 9) & 1) << 5)); }
__host__ __device__ __forceinline__ void stage_rc(int b, int& R, int& C) { const int st = b / 1024, sb = b % 1024, swz = sb ^ (((sb >> 9) & 1) << 5); R = (st >> 1) * 16 + swz / 64; C = (st & 1) * 32 + (swz % 64) / 2; }
__host__ __device__ __forceinline__ int perm32(int rho) { const int n = rho >> 4, i = rho & 15; return 8 * (i >> 2) + 4 * n + (i & 3); }

struct Unit { int pm, pn; };
struct Gemm { const bf16_t* A; const bf16_t* Bt; int M, N, K; };

struct StaticOrder {
    int nM, nN, nwg, G, c;
    __host__ __device__ void init(int M, int N, int G_, int c_) { nM = M / BM; nN = N / BM; nwg = nM * nN; G = G_; c = c_; }
    __host__ __device__ bool next(int i, Unit& u) const {
        const long L = (long)i * G + c; if (L >= nwg) return false;
        int wgid = (int)L; { const int q = nwg / NXCD, r = nwg % NXCD, xcd = wgid % NXCD, off = wgid / NXCD; wgid = (xcd < r ? xcd * (q + 1) : r * (q + 1) + (xcd - r) * q) + off; }
        const int nig = WGM * nN, gid = wgid / nig, fm = gid * WGM, gsz = (nM - fm) < WGM ? (nM - fm) : WGM;
        u.pm = fm + ((wgid % nig) % gsz); u.pn = (wgid % nig) / gsz; return true;
    }
    __device__ __forceinline__ void a_ready(const Unit&) const {}
    __device__ __forceinline__ void done(const Unit&) const {}
};


struct EpiSwiglu {
    static constexpr bool PERM = true, AFTER_DRAIN = false, HAS_MID = false;
    bf16_t* act;
    __device__ __forceinline__ void mid(f32x4 (&)[2][2][4][2], const Unit&, int, int, int, int) const {}
    __device__ __forceinline__ void operator()(const f32x4 (&acc)[2][2][4][2], const Unit& u, int wr, int wc, int fr, int fq) const {
        const int row0 = u.pm * BM + wr * 64 + fr, col0 = u.pn * 128 + wc * 32 + 8 * fq;
#pragma unroll
        for (int ai = 0; ai < 2; ++ai)
#pragma unroll
            for (int m = 0; m < 4; ++m) {
                float v[8];
#pragma unroll
                for (int n = 0; n < 2; ++n)
#pragma unroll
                    for (int e = 0; e < 4; ++e) { const float a = acc[ai][0][m][n][e], b = acc[ai][1][m][n][e]; v[n * 4 + e] = a / (1.0f + __expf(-a)) * b; }
                u32x4 w; w.x = ::pk2(v[0], v[1]); w.y = ::pk2(v[2], v[3]); w.z = ::pk2(v[4], v[5]); w.w = ::pk2(v[6], v[7]);
                *(u32x4*)(act + (size_t)(row0 + ai * HALF + m * 16) * 2816 + col0) = w;
            }
    }
};
struct EpiResid {
    static constexpr bool PERM = false, AFTER_DRAIN = false, HAS_MID = false;
    const float* xp; const float* xs; float* out; const float* mod; int gidx; float scale;
    __device__ __forceinline__ void mid(f32x4 (&)[2][2][4][2], const Unit&, int, int, int, int) const {}
    __device__ __forceinline__ void operator()(const f32x4 (&acc)[2][2][4][2], const Unit& u, int wr, int wc, int fr, int fq) const {
        const int rowt = u.pm * BM, row0 = rowt + wr * 64 + fr, col0 = u.pn * BM + wc * 32 + 4 * fq;
        const float* gate = mod + (size_t)(rowt < 4096 ? 0 : 1 + ((rowt - 4096) >> 11)) * 9216 + gidx * 1024;
        const float* xb = rowt < 4096 ? xp : xs - (size_t)4096 * 1024;
#pragma unroll
        for (int bj = 0; bj < 2; ++bj)
#pragma unroll
            for (int n = 0; n < 2; ++n) {
                const int c = col0 + bj * HALF + n * 16;
                const f32x4 g4 = *(const f32x4*)(gate + c) * scale;
#pragma unroll
                for (int ai = 0; ai < 2; ++ai)
#pragma unroll
                    for (int m = 0; m < 4; ++m) { const size_t off = (size_t)(row0 + ai * HALF + m * 16) * 1024 + c;
                        const f32x4 xin = *(const f32x4*)(xb + off); *(f32x4*)(out + off) = xin + g4 * acc[ai][bj][m][n]; }
            }
    }
};
struct EpiWin {
    static constexpr bool PERM = true, AFTER_DRAIN = false, HAS_MID = false;
    bf16_t* PR; const float* lb; const float* rope; int pass;
    __device__ __forceinline__ void mid(f32x4 (&)[2][2][4][2], const Unit&, int, int, int, int) const {}
    __device__ __forceinline__ void operator()(const f32x4 (&acc)[2][2][4][2], const Unit& u, int wr, int wc, int fr, int fq) const {
        const int row0 = u.pm * BM + wr * 64 + fr;
        if (u.pn < 4) {
            const int hh = wc >> 1, part = wc & 1, i0 = 8 * fq;
            const float sc = u.pn >= 2 ? 0.08838834764831845f : 1.0f;
#pragma unroll
            for (int ai = 0; ai < 2; ++ai)
#pragma unroll
                for (int m = 0; m < 4; ++m) {
                    const int row = row0 + ai * HALF + m * 16;
                    float cs[8], sn[8];
                    if (pass > 0) { const int t = row & 2047; const int pos = part ? (t & 63) : (t >> 6);
                        const f32x4* rp = (const f32x4*)(rope + (size_t)(pos * 32 + i0) * 2);
#pragma unroll
                        for (int q = 0; q < 4; ++q) { const f32x4 r4 = rp[q]; cs[2 * q] = r4[0]; sn[2 * q] = r4[1]; cs[2 * q + 1] = r4[2]; sn[2 * q + 1] = r4[3]; } }
                    else {
#pragma unroll
                        for (int q = 0; q < 8; ++q) { cs[q] = 1.0f; sn[q] = 0.0f; } }
                    float y1[8], y2[8];
#pragma unroll
                    for (int e = 0; e < 8; ++e) { const float x1 = acc[ai][0][m][e >> 2][e & 3], x2 = acc[ai][1][m][e >> 2][e & 3];
                        y1[e] = (x1 * cs[e] - x2 * sn[e]) * sc; y2[e] = (x2 * cs[e] + x1 * sn[e]) * sc; }
                    bf16_t* dst = PR + (size_t)row * 8192 + u.pn * BM + 128 * hh + 64 * part + i0;
                    u32x4 w; w.x = ::pk2(y1[0], y1[1]); w.y = ::pk2(y1[2], y1[3]); w.z = ::pk2(y1[4], y1[5]); w.w = ::pk2(y1[6], y1[7]);
                    *(u32x4*)dst = w;
                    w.x = ::pk2(y2[0], y2[1]); w.y = ::pk2(y2[2], y2[3]); w.z = ::pk2(y2[4], y2[5]); w.w = ::pk2(y2[6], y2[7]);
                    *(u32x4*)(dst + 32) = w;
                }
        } else {
            const int seg = u.pn >> 2;
#pragma unroll
            for (int bj = 0; bj < 2; ++bj) {
                const int col = u.pn * BM + bj * HALF + wc * 32 + 8 * fq;
                float l[8];
                if (seg == 4 || seg == 5) {
                    const f32x4 l0 = *(const f32x4*)(lb + (col - 4096)), l1 = *(const f32x4*)(lb + (col - 4096) + 4);
#pragma unroll
                    for (int e = 0; e < 4; ++e) { l[e] = l0[e]; l[4 + e] = l1[e]; }
                } else {
#pragma unroll
                    for (int e = 0; e < 8; ++e) l[e] = 0.f;
                }
#pragma unroll
                for (int ai = 0; ai < 2; ++ai)
#pragma unroll
                    for (int m = 0; m < 4; ++m) {
                        float v[8];
#pragma unroll
                        for (int e = 0; e < 8; ++e) { float x = acc[ai][bj][m][e >> 2][e & 3];
                            if (seg == 2 || seg == 7) x = x / (1.0f + __expf(-x));
                            else if (seg == 3) x = x / (1.0f + __expf(-x)) * 0.08838834764831845f;
                            else if (seg == 4 || seg == 5) x = __logf(l[e] + (1.0f - l[e]) / (1.0f + __expf(-x)));
                            v[e] = x; }
                        u32x4 w; w.x = ::pk2(v[0], v[1]); w.y = ::pk2(v[2], v[3]); w.z = ::pk2(v[4], v[5]); w.w = ::pk2(v[6], v[7]);
                        *(u32x4*)(PR + (size_t)(row0 + ai * HALF + m * 16) * 8192 + col) = w;
                    }
            }
        }
    }
};
struct EpiGates {
    static constexpr bool PERM = true, AFTER_DRAIN = false, HAS_MID = false;
    bf16_t* G;
    __device__ __forceinline__ void mid(f32x4 (&)[2][2][4][2], const Unit&, int, int, int, int) const {}
    __device__ __forceinline__ void operator()(const f32x4 (&acc)[2][2][4][2], const Unit& u, int wr, int wc, int fr, int fq) const {
        const int row0 = u.pm * BM + wr * 64 + fr;
#pragma unroll
        for (int bj = 0; bj < 2; ++bj) {
            const int col = u.pn * BM + bj * HALF + wc * 32 + 8 * fq;
#pragma unroll
            for (int ai = 0; ai < 2; ++ai)
#pragma unroll
                for (int m = 0; m < 4; ++m) {
                    float v[8];
#pragma unroll
                    for (int e = 0; e < 8; ++e) v[e] = 1.0f / (1.0f + __expf(-acc[ai][bj][m][e >> 2][e & 3]));
                    u32x4 w; w.x = ::pk2(v[0], v[1]); w.y = ::pk2(v[2], v[3]); w.z = ::pk2(v[4], v[5]); w.w = ::pk2(v[6], v[7]);
                    *(u32x4*)(G + (size_t)(row0 + ai * HALF + m * 16) * 2048 + col) = w;
                }
        }
    }
};
struct EpiMergeA {
    static constexpr bool PERM = false, AFTER_DRAIN = false, HAS_MID = false;
    const bf16_t* G; float* T;
    __device__ __forceinline__ void mid(f32x4 (&)[2][2][4][2], const Unit&, int, int, int, int) const {}
    __device__ __forceinline__ void operator()(const f32x4 (&acc)[2][2][4][2], const Unit& u, int wr, int wc, int fr, int fq) const {
        const int row0 = u.pm * BM + wr * 64 + fr, col0 = u.pn * BM + wc * 32 + 4 * fq;
#pragma unroll
        for (int ai = 0; ai < 2; ++ai)
#pragma unroll
            for (int m = 0; m < 4; ++m) { const size_t row = (size_t)(row0 + ai * HALF + m * 16);
#pragma unroll
                for (int bj = 0; bj < 2; ++bj)
#pragma unroll
                    for (int n = 0; n < 2; ++n) { const int c = col0 + bj * HALF + n * 16;
                        const u32x2 g = *(const u32x2*)(G + row * 2048 + c);
                        f32x4 v = acc[ai][bj][m][n]; v[0] *= ::bflo(g.x); v[1] *= ::bfhi(g.x); v[2] *= ::bflo(g.y); v[3] *= ::bfhi(g.y);
                        *(f32x4*)(T + row * 1024 + c) = v; } }
    }
};
struct EpiMergeB {
    static constexpr bool PERM = false, AFTER_DRAIN = false, HAS_MID = false;
    const bf16_t* G; const float* T; bf16_t* Mg;
    __device__ __forceinline__ void mid(f32x4 (&)[2][2][4][2], const Unit&, int, int, int, int) const {}
    __device__ __forceinline__ void operator()(const f32x4 (&acc)[2][2][4][2], const Unit& u, int wr, int wc, int fr, int fq) const {
        const int row0 = u.pm * BM + wr * 64 + fr, col0 = u.pn * BM + wc * 32 + 4 * fq;
#pragma unroll
        for (int ai = 0; ai < 2; ++ai)
#pragma unroll
            for (int m = 0; m < 4; ++m) { const size_t row = (size_t)(row0 + ai * HALF + m * 16);
#pragma unroll
                for (int bj = 0; bj < 2; ++bj)
#pragma unroll
                    for (int n = 0; n < 2; ++n) { const int c = col0 + bj * HALF + n * 16;
                        const u32x2 g = *(const u32x2*)(G + row * 2048 + 1024 + c);
                        f32x4 v = acc[ai][bj][m][n]; const f32x4 t = *(const f32x4*)(T + row * 1024 + c);
                        v[0] = v[0] * ::bflo(g.x) + t[0]; v[1] = v[1] * ::bfhi(g.x) + t[1]; v[2] = v[2] * ::bflo(g.y) + t[2]; v[3] = v[3] * ::bfhi(g.y) + t[3];
                        u32x2 w; w.x = ::pk2(v[0], v[1]); w.y = ::pk2(v[2], v[3]);
                        *(u32x2*)(Mg + row * 1024 + c) = w; } }
    }
};

template <class Epi, class Sched, bool ALIGN_EPI = false, bool SP2 = false>
__device__ __forceinline__ void gemm_phase(PG8_LAS unsigned char* lds, const Gemm g, const Sched& S, const Epi& E) {
    int tid_ = threadIdx.x; asm volatile("" : "+v"(tid_)); const int tid = tid_, wid = __builtin_amdgcn_readfirstlane(tid >> 6), lane = tid & 63, wr = wid >> 2, wc = wid & 3, fr = lane & 15, fq = lane >> 4;
    const int K = g.K, nt = K / BK;
    unsigned voffA[2], voffB[2];
#pragma unroll
    for (int i = 0; i < 2; ++i) { int R, C; stage_rc(tid * 16 + i * 8192, R, C); const int Rb = Epi::PERM ? ((R & ~31) + perm32(R & 31)) : R;
        voffA[i] = (unsigned)(R * K + C) * 2u; voffB[i] = (unsigned)(Rb * K + C) * 2u; }
    const size_t kstep = (size_t)(BK * 2);
    const size_t hstep = (size_t)HALF * K * 2;
    const size_t tstep = 2 * hstep;
    const unsigned ldsw = (unsigned)wid * 1024u;
    const int aoff = lds_byte(wr * 64 + fr, fq * 8), boff = lds_byte(wc * 32 + fr, fq * 8);
#define PG8_SA(b, h) (((b) * 2 + (h)) * HTB)
#define PG8_SB(b, h) ((4 + (b) * 2 + (h)) * HTB)
#define PG8_STAGE(bufoff, gbase, voff) do { _Pragma("unroll") for (int _i = 0; _i < 2; ++_i) \
        __builtin_amdgcn_global_load_lds((const unsigned*)((const char*)(gbase) + (voff)[_i]), (PG8_LAS unsigned*)(lds + (bufoff) + ldsw + _i * 8192), 16, 0, 0); } while (0)
#define PG8_LDA(dst, b, h) do { _Pragma("unroll") for (int m = 0; m < 4; ++m) _Pragma("unroll") for (int k = 0; k < 2; ++k) dst[m][k] = *(const PG8_LAS bf16x8*)(lds + PG8_SA(b, h) + aoff + m * 2048 + k * 1024); } while (0)
#define PG8_LDB(dst, b, h) do { _Pragma("unroll") for (int n = 0; n < 2; ++n) _Pragma("unroll") for (int k = 0; k < 2; ++k) dst[n][k] = *(const PG8_LAS bf16x8*)(lds + PG8_SB(b, h) + boff + n * 2048 + k * 1024); } while (0)
#define PG8_MMA(ai, bj, At, Bt) do { __builtin_amdgcn_s_setprio(1); _Pragma("unroll") for (int m = 0; m < 4; ++m) _Pragma("unroll") for (int n = 0; n < 2; ++n) _Pragma("unroll") for (int k = 0; k < 2; ++k) \
        acc[ai][bj][m][n] = __builtin_amdgcn_mfma_f32_16x16x32_bf16(Bt[n][k], At[m][k], acc[ai][bj][m][n], 0, 0, 0); __builtin_amdgcn_s_setprio(0); } while (0)
#define PG8_WAIT_V(n) asm volatile("s_waitcnt vmcnt(" #n ")" ::: "memory")
#define PG8_WAIT_L(n) asm volatile("s_waitcnt lgkmcnt(" #n ")" ::: "memory")
#define PG8_BAR __builtin_amdgcn_s_barrier()
#define PG8_SCHED __builtin_amdgcn_sched_barrier(0)
    Unit cur, nxt; int ui = 0;
    if (!S.next(0, cur)) return;
    f32x4 acc[2][2][4][2];
#pragma unroll
    for (int a = 0; a < 2; ++a)
#pragma unroll
        for (int b = 0; b < 2; ++b)
#pragma unroll
            for (int m = 0; m < 4; ++m)
#pragma unroll
                for (int n = 0; n < 2; ++n) acc[a][b][m][n] = (f32x4){0.f, 0.f, 0.f, 0.f};
    bf16x8 At[4][2], B0[2][2], B1[2][2];
    const char* cA = (const char*)g.A + (size_t)cur.pm * tstep; const char* cB = (const char*)g.Bt + (size_t)cur.pn * tstep;
    S.a_ready(cur);
    if constexpr (SP2) {
        PG8_STAGE(PG8_SB(0, 0), cB, voffB); PG8_STAGE(PG8_SB(0, 1), cB + hstep, voffB); PG8_STAGE(PG8_SA(0, 0), cA, voffA); PG8_STAGE(PG8_SA(0, 1), cA + hstep, voffA);
        if (wr == 1) PG8_BAR;
        PG8_WAIT_V(2); PG8_BAR;
        PG8_STAGE(PG8_SB(1, 0), cB + kstep, voffB); PG8_STAGE(PG8_SA(1, 0), cA + kstep, voffA); PG8_STAGE(PG8_SB(1, 1), cB + hstep + kstep, voffB);
        PG8_WAIT_V(6); PG8_BAR;
    } else {
        PG8_STAGE(PG8_SB(0, 0), cB, voffB); PG8_STAGE(PG8_SA(0, 0), cA, voffA); PG8_STAGE(PG8_SB(0, 1), cB + hstep, voffB); PG8_STAGE(PG8_SA(0, 1), cA + hstep, voffA);
        if (wr == 1) PG8_BAR;
        PG8_WAIT_V(4); PG8_BAR;
        PG8_STAGE(PG8_SB(1, 0), cB + kstep, voffB); PG8_STAGE(PG8_SA(1, 0), cA + kstep, voffA); PG8_STAGE(PG8_SB(1, 1), cB + hstep + kstep, voffB);
        PG8_WAIT_V(6); PG8_BAR;
    }
    for (;;) {
        const bool has_next = S.next(ui + 1, nxt);
        const char* nA = has_next ? (const char*)g.A + (size_t)nxt.pm * tstep : cA; const char* nB = has_next ? (const char*)g.Bt + (size_t)nxt.pn * tstep : cB;
        for (int t = 0; t < nt; t += 2) {
            if constexpr (Epi::HAS_MID) { if (t == (nt >> 1)) E.mid(acc, cur, wr, wc, fr, fq); }
            const bool last = (t == nt - 2);
            const char* a1 = cA + (size_t)(t + 1) * kstep;
            const char* a2 = last ? nA : cA + (size_t)(t + 2) * kstep; const char* b2 = last ? nB : cB + (size_t)(t + 2) * kstep;
            const char* a3 = a2 + kstep; const char* b3 = b2 + kstep;
            if (last && has_next) S.a_ready(nxt);
            if constexpr (SP2) {
            PG8_LDB(B0, 0, 0); PG8_LDB(B1, 0, 1); PG8_SCHED; PG8_LDA(At, 0, 0); PG8_STAGE(PG8_SA(1, 1), a1 + hstep, voffA);
            PG8_WAIT_V(8); PG8_WAIT_L(0); PG8_BAR; PG8_MMA(0, 0, At, B0); PG8_MMA(0, 1, At, B1); PG8_BAR; PG8_SCHED;
            PG8_LDA(At, 0, 1); PG8_STAGE(PG8_SB(0, 0), b2, voffB); PG8_STAGE(PG8_SB(0, 1), b2 + hstep, voffB); PG8_STAGE(PG8_SA(0, 0), a2, voffA);
            PG8_WAIT_V(8); PG8_WAIT_L(0); PG8_BAR; PG8_MMA(1, 0, At, B0); PG8_MMA(1, 1, At, B1); PG8_BAR; PG8_SCHED;
            PG8_LDB(B0, 1, 0); PG8_LDB(B1, 1, 1); PG8_SCHED; PG8_LDA(At, 1, 0); PG8_STAGE(PG8_SA(0, 1), a2 + hstep, voffA);
            PG8_WAIT_V(8); PG8_WAIT_L(0); PG8_BAR; PG8_MMA(0, 0, At, B0); PG8_MMA(0, 1, At, B1); PG8_BAR; PG8_SCHED;
            PG8_LDA(At, 1, 1); PG8_STAGE(PG8_SB(1, 0), b3, voffB); PG8_STAGE(PG8_SB(1, 1), b3 + hstep, voffB); PG8_STAGE(PG8_SA(1, 0), a3, voffA);
            PG8_WAIT_V(8); PG8_WAIT_L(0); PG8_BAR; PG8_MMA(1, 0, At, B0); PG8_MMA(1, 1, At, B1); PG8_BAR; PG8_SCHED;
            } else {
            PG8_LDB(B0, 0, 0); PG8_SCHED; PG8_LDA(At, 0, 0); PG8_STAGE(PG8_SA(1, 1), a1 + hstep, voffA);
            PG8_WAIT_L(8); PG8_BAR; PG8_WAIT_L(0); PG8_MMA(0, 0, At, B0); PG8_BAR; PG8_SCHED;
            PG8_LDB(B1, 0, 1); PG8_STAGE(PG8_SB(0, 0), b2, voffB);
            PG8_BAR; PG8_WAIT_L(0); PG8_MMA(0, 1, At, B1); PG8_BAR;
            PG8_LDA(At, 0, 1); PG8_STAGE(PG8_SA(0, 0), a2, voffA);
            PG8_BAR; PG8_WAIT_L(0); PG8_MMA(1, 0, At, B0); PG8_BAR; PG8_SCHED;
            PG8_STAGE(PG8_SB(0, 1), b2 + hstep, voffB);
            PG8_WAIT_V(6); PG8_BAR; PG8_MMA(1, 1, At, B1); PG8_BAR;
            PG8_LDB(B0, 1, 0); PG8_SCHED; PG8_LDA(At, 1, 0); PG8_STAGE(PG8_SA(0, 1), a2 + hstep, voffA);
            PG8_WAIT_L(8); PG8_BAR; PG8_WAIT_L(0); PG8_MMA(0, 0, At, B0); PG8_BAR; PG8_SCHED;
            PG8_LDB(B1, 1, 1); PG8_STAGE(PG8_SB(1, 0), b3, voffB);
            PG8_BAR; PG8_WAIT_L(0); PG8_MMA(0, 1, At, B1); PG8_BAR;
            PG8_LDA(At, 1, 1); PG8_STAGE(PG8_SA(1, 0), a3, voffA);
            PG8_BAR; PG8_WAIT_L(0); PG8_MMA(1, 0, At, B0); PG8_BAR; PG8_SCHED;
            PG8_STAGE(PG8_SB(1, 1), b3 + hstep, voffB);
            PG8_WAIT_V(6); PG8_BAR; PG8_MMA(1, 1, At, B1); PG8_BAR;
            }
        }
        if constexpr (ALIGN_EPI) { if (wr == 0) PG8_BAR; }
        if constexpr (!Epi::AFTER_DRAIN) { E(acc, cur, wr, wc, fr, fq); S.done(cur); }
        if (!has_next) break;
#pragma unroll
        for (int a = 0; a < 2; ++a)
#pragma unroll
            for (int b = 0; b < 2; ++b)
#pragma unroll
                for (int m = 0; m < 4; ++m)
#pragma unroll
                    for (int n = 0; n < 2; ++n) acc[a][b][m][n] = (f32x4){0.f, 0.f, 0.f, 0.f};
        cur = nxt; cA = nA; cB = nB; ++ui;
        if constexpr (ALIGN_EPI) { if (wr == 1) PG8_BAR; }
    }
    PG8_WAIT_V(0);
    if constexpr (!ALIGN_EPI) { if (wr == 0) PG8_BAR; }
    PG8_BAR;
    if constexpr (Epi::AFTER_DRAIN) { E.fused(acc, cur, wr, wc, fr, fq, lds, wid, lane); S.done(cur); }
#undef PG8_SA
#undef PG8_SB
#undef PG8_STAGE
#undef PG8_LDA
#undef PG8_LDB
#undef PG8_MMA
#undef PG8_WAIT_V
#undef PG8_WAIT_L
#undef PG8_BAR
#undef PG8_SCHED
}
}

typedef float f32x16 __attribute__((ext_vector_type(16)));
constexpr size_t WS_RST = WS_ST;
constexpr size_t WS_HST = WS_ST + 16 * MiB;
constexpr size_t WS_HD = WS_ST + 48 * MiB;
constexpr size_t OUT_RET = (size_t)MT * D, OUT_HG = OUT_RET + (size_t)16 * 2 * 4 * 128 * 256;

DEVI bf16x8 ldfrag(ldsp base, int stride, int row, int k0, int hh) { return *(const LAS bf16x8*)(base + row * stride + (k0 + 8 * hh) * 2); }
template <int NX> DEVI void mma_nx1(f32x16 (&acc)[NX], ldsp X, int xs, int x0, ldsp Y, int ys, int y0, int ksteps, int r, int hh) {
    for (int s = 0; s < ksteps; ++s) {
        const bf16x8 b = ldfrag(Y, ys, y0 + r, 16 * s, hh);
#pragma unroll
        for (int t = 0; t < NX; ++t) { const bf16x8 a = ldfrag(X, xs, x0 + 32 * t + r, 16 * s, hh); acc[t] = __builtin_amdgcn_mfma_f32_32x32x16_bf16(a, b, acc[t], 0, 0, 0); }
    }
}
template <int NX> DEVI void zero_acc(f32x16 (&acc)[NX]) {
#pragma unroll
    for (int t = 0; t < NX; ++t)
#pragma unroll
        for (int i = 0; i < 16; ++i) acc[t][i] = 0.f;
}
DEVI void stage_nat(ldsp dst, int ls, const bf16_t* src, size_t gstride, int rows, int lc, int tid) {
    const int n = rows << lc;
    for (int u = tid; u < n; u += 512) { const int rr = u >> lc, c = u & ((1 << lc) - 1);
        const u32x4 v = *(const u32x4*)(src + (size_t)rr * gstride + c * 8);
        *(LAS u32x4*)(dst + rr * ls + c * 16) = v; }
}
template <class F> DEVI void stage_tr(ldsp dst, int ls, const bf16_t* src, size_t gstride, int T, int ncol, int tid, F scale) {
    const int lane = tid & 63, wv = tid >> 6, nbj = T >> 5, nbc = ncol >> 5;
    for (int blk = wv; blk < nbj * nbc; blk += 8) {
        const int bj = blk % nbj, bc = blk / nbj, jp = bj * 16 + (lane & 15), cc = bc * 4 + (lane >> 4);
        const u32x4 v0 = *(const u32x4*)(src + (size_t)(2 * jp) * gstride + cc * 8), v1 = *(const u32x4*)(src + (size_t)(2 * jp + 1) * gstride + cc * 8);
        const float s0 = scale(2 * jp), s1 = scale(2 * jp + 1);
#pragma unroll
        for (int q = 0; q < 4; ++q) {
            *(LAS unsigned*)(dst + (cc * 8 + 2 * q) * ls + jp * 4) = pk2(bflo(v0[q]) * s0, bflo(v1[q]) * s1);
            *(LAS unsigned*)(dst + (cc * 8 + 2 * q + 1) * ls + jp * 4) = pk2(bfhi(v0[q]) * s0, bfhi(v1[q]) * s1);
        }
    }
}
DEVI float log2_gamma(const P& p, int dir, int h) { const float rd = p.in[14][dir * 4 + h]; return -log2f(1.0f + expf(-rd)); }
DEVI u32x2 pack4(const f32x16& a, int g) { u32x2 w; w.x = pk2(a[4 * g], a[4 * g + 1]); w.y = pk2(a[4 * g + 2], a[4 * g + 3]); return w; }

DEVI void ret_stage_a(const P& p, ldsp lds, int pass, int item, int tid) {
    const int cg = item >> 2, h = item & 3, lane = tid & 63, w = __builtin_amdgcn_readfirstlane(tid >> 6), r = lane & 31, hh = lane >> 5;
    const bf16_t* PR = (const bf16_t*)(p.ws + WS_PROJ) + (size_t)(cg * 128) * NPROJ;
    const float lgf = log2_gamma(p, 0, h), lgb = log2_gamma(p, 1, h);
    ldsp vT = lds, kfT = lds + 69632, kbT = lds + 104448;
    stage_tr(vT, 272, PR + C_RV + h * 256, NPROJ, 128, 256, tid, [](int) { return 1.0f; });
    stage_tr(kfT, 272, PR + C_RK + h * 128, NPROJ, 128, 128, tid, [lgf](int j) { return exp2f(lgf * (float)(127 - j)); });
    stage_tr(kbT, 272, PR + C_RK + h * 128, NPROJ, 128, 128, tid, [lgb](int j) { return exp2f(lgb * (float)j); });
    __syncthreads();
#pragma unroll 1
    for (int dir = 0; dir < 2; ++dir) {
        f32x16 acc[4]; zero_acc(acc);
        mma_nx1<4>(acc, dir ? kbT : kfT, 272, 0, vT, 272, 32 * w, 8, r, hh);
        bf16_t* ST = (bf16_t*)(p.ws + WS_RST) + ((size_t)(cg * 4 + h) * 2 + dir) * 32768 + (size_t)(32 * w + r) * 128;
#pragma unroll
        for (int t = 0; t < 4; ++t)
#pragma unroll
            for (int g = 0; g < 4; ++g) *(u32x2*)(ST + 32 * t + 8 * g + 4 * hh) = pack4(acc[t], g);
    }
    __syncthreads();
}
DEVI void ret_stage_b(const P& p, int pass, int tid, int G) {
    const int nseq = pass == 0 ? 16 : 2, nc = pass == 0 ? 2 : 16;
    const int total = nseq * 8 * 4096;
    for (int idx = blockIdx.x * 512 + tid; idx < total; idx += G * 512) {
        const int dkg = idx & 15, e = (idx >> 4) & 255, hd = (idx >> 12) & 7, s = idx >> 15, dir = hd & 1, h = hd >> 1, dk0 = dkg * 8;
        const float cdec = exp2f(log2_gamma(p, dir, h) * 128.0f);
        float S[8];
        if (pass == 0) {
#pragma unroll
            for (int i = 0; i < 8; ++i) S[i] = 0.f;
        } else {
            const float* st = p.in[2] + ((size_t)(((pass - 1) * 2 + s) * 2 + dir) * 4 + h) * 32768;
#pragma unroll
            for (int i = 0; i < 8; ++i) S[i] = st[(dk0 + i) * 256 + e];
        }
        for (int cc = 0; cc < nc; ++cc) {
            const int c = dir ? nc - 1 - cc : cc;
            bf16_t* q = (bf16_t*)(p.ws + WS_RST) + ((size_t)((s * nc + c) * 4 + h) * 2 + dir) * 32768 + e * 128 + dk0;
            const u32x4 u = *(const u32x4*)q;
            u32x4 o; o.x = pk2(S[0], S[1]); o.y = pk2(S[2], S[3]); o.z = pk2(S[4], S[5]); o.w = pk2(S[6], S[7]);
            *(u32x4*)q = o;
#pragma unroll
            for (int qq = 0; qq < 4; ++qq) { S[2 * qq] = cdec * S[2 * qq] + bflo(u[qq]); S[2 * qq + 1] = cdec * S[2 * qq + 1] + bfhi(u[qq]); }
        }
        if (pass == 0) {
            float* ns = p.out + OUT_RET + ((size_t)(s * 2 + dir) * 4 + h) * 32768;
#pragma unroll
            for (int i = 0; i < 8; ++i) ns[(dk0 + i) * 256 + e] = S[i];
        }
    }
}
DEVI void ret_stage_c(const P& p, ldsp lds, int pass, int item, int tid) {
    const int cg = item >> 2, h = item & 3, lane = tid & 63, w = __builtin_amdgcn_readfirstlane(tid >> 6), r = lane & 31, hh = lane >> 5;
    const int nc = pass == 0 ? 2 : 16, c = cg % nc;
    const bf16_t* PR = (const bf16_t*)(p.ws + WS_PROJ) + (size_t)(cg * 128) * NPROJ;
    const float lgf = log2_gamma(p, 0, h), lgb = log2_gamma(p, 1, h);
    ldsp qL = lds, kP = lds + 34816, vS = lds + 69632; LAS float* red = (LAS float*)(lds + 139264);
    stage_nat(qL, 272, PR + C_RQ + h * 128, NPROJ, 128, 4, tid);
    stage_nat(kP, 272, PR + C_RK + h * 128, NPROJ, 128, 4, tid);
    stage_tr(vS, 272, PR + C_RV + h * 256, NPROJ, 128, 256, tid, [](int) { return 1.0f; });
    __syncthreads();
    const int ib = w & 3, wh = w >> 2, i = 32 * ib + r;
    {
        f32x16 ap[2]; zero_acc(ap);
        mma_nx1<2>(ap, kP, 272, 64 * wh, qL, 272, 32 * ib, 8, r, hh);
        __syncthreads();
#pragma unroll
        for (int t = 0; t < 2; ++t)
#pragma unroll
            for (int g = 0; g < 4; ++g) {
                float v[4];
#pragma unroll
                for (int e2 = 0; e2 < 4; ++e2) { const int j = 64 * wh + 32 * t + 8 * g + 4 * hh + e2, d = i - j;
                    const float wgt = d > 0 ? exp2f(lgf * (float)d) : (d < 0 ? exp2f(lgb * (float)(-d)) : 2.0f);
                    v[e2] = ap[t][4 * g + e2] * wgt; }
                u32x2 o; o.x = pk2(v[0], v[1]); o.y = pk2(v[2], v[3]);
                *(LAS u32x2*)(kP + i * 272 + (64 * wh + 32 * t + 8 * g + 4 * hh) * 2) = o;
            }
        __syncthreads();
    }
    f32x16 acc[4]; zero_acc(acc);
    mma_nx1<4>(acc, vS, 272, 128 * wh, kP, 272, 32 * ib, 8, r, hh);
    __syncthreads();
#pragma unroll 1
    for (int dir = 0; dir < 2; ++dir) {
        const bool has = pass != 0 || (dir == 0 ? c != 0 : c != nc - 1);
        if (has) {
            const bf16_t* ST = (const bf16_t*)(p.ws + WS_RST) + ((size_t)(cg * 4 + h) * 2 + dir) * 32768;
            stage_nat(vS, 272, ST, 128, 256, 4, tid);
            __syncthreads();
            f32x16 tmp[4]; zero_acc(tmp);
            mma_nx1<4>(tmp, vS, 272, 128 * wh, qL, 272, 32 * ib, 8, r, hh);
            const float sc = dir == 0 ? exp2f(lgf * (float)(i + 1)) : exp2f(lgb * (float)(128 - i));
#pragma unroll
            for (int t = 0; t < 4; ++t)
#pragma unroll
                for (int q = 0; q < 16; ++q) acc[t][q] += tmp[t][q] * sc;
            __syncthreads();
        }
    }
    float ss = 0.f;
#pragma unroll
    for (int t = 0; t < 4; ++t)
#pragma unroll
        for (int q = 0; q < 16; ++q) ss += acc[t][q] * acc[t][q];
    ss += __shfl_xor(ss, 32);
    if (hh == 0) red[wh * 128 + i] = ss;
    __syncthreads();
    const float rstd = rsqrtf((red[i] + red[128 + i]) * (1.0f / 256.0f) + EPS);
    const bf16_t* rg = PR + (size_t)i * NPROJ + C_RG + h * 256 + 128 * wh;
    bf16_t* O = (bf16_t*)(p.ws + WS_ORET) + (size_t)(pass * PASS_ROWS + cg * 128 + i) * 1024 + h * 256 + 128 * wh;
#pragma unroll
    for (int t = 0; t < 4; ++t)
#pragma unroll
        for (int g = 0; g < 4; ++g) { const int e = 32 * t + 8 * g + 4 * hh; const u32x2 gv = *(const u32x2*)(rg + e);
            u32x2 o; o.x = pk2(acc[t][4 * g] * rstd * bflo(gv.x), acc[t][4 * g + 1] * rstd * bfhi(gv.x)); o.y = pk2(acc[t][4 * g + 2] * rstd * bflo(gv.y), acc[t][4 * g + 3] * rstd * bfhi(gv.y));
            *(u32x2*)(O + e) = o; }
    __syncthreads();
}

DEVI void hg_stage_a(const P& p, ldsp lds, int pass, int item, int tid) {
    const int cg = item >> 3, h = item & 7, lane = tid & 63, w = __builtin_amdgcn_readfirstlane(tid >> 6), r = lane & 31, hh = lane >> 5;
    const bf16_t* PR = (const bf16_t*)(p.ws + WS_PROJ) + (size_t)(cg * 64) * NPROJ;
    ldsp graw = lds, vT = lds + 34816, kT = lds + 53248;
    stage_nat(graw, 272, PR + C_GF + h * 128, NPROJ, 64, 4, tid);
    stage_nat(graw + 17408, 272, PR + C_GB + h * 128, NPROJ, 64, 4, tid);
    stage_tr(vT, 144, PR + C_HI + h * 128, NPROJ, 64, 128, tid, [](int) { return 1.0f; });
    __syncthreads();
    if (tid < 256) {
        const int dir = tid >> 7, dk = tid & 127;
        const LAS bf16_t* g = (const LAS bf16_t*)(graw + dir * 17408) + dk;
        ldsp kd = kT + dir * 18432 + dk * 144;
        float run = 0.f;
        if (dir == 0) {
#pragma unroll 1
            for (int jg = 7; jg >= 0; --jg) {
                float v[8];
#pragma unroll
                for (int jj = 7; jj >= 0; --jj) { const float gv = bf2f(g[(8 * jg + jj) * 136]); v[jj] = (1.0f - __expf(gv)) * __expf(run); run += gv; }
                u32x4 o; o.x = pk2(v[0], v[1]); o.y = pk2(v[2], v[3]); o.z = pk2(v[4], v[5]); o.w = pk2(v[6], v[7]);
                *(LAS u32x4*)(kd + jg * 16) = o;
            }
        } else {
#pragma unroll 1
            for (int jg = 0; jg < 8; ++jg) {
                float v[8];
#pragma unroll
                for (int jj = 0; jj < 8; ++jj) { const float gv = bf2f(g[(8 * jg + jj) * 136]); v[jj] = (1.0f - __expf(gv)) * __expf(run); run += gv; }
                u32x4 o; o.x = pk2(v[0], v[1]); o.y = pk2(v[2], v[3]); o.z = pk2(v[4], v[5]); o.w = pk2(v[6], v[7]);
                *(LAS u32x4*)(kd + jg * 16) = o;
            }
        }
        ((float*)(p.ws + WS_HD))[((size_t)(cg * 8 + h) * 2 + dir) * 128 + dk] = __expf(run);
    }
    __syncthreads();
#pragma unroll 1
    for (int dir = 0; dir < 2; ++dir) {
        f32x16 acc[2]; zero_acc(acc);
        mma_nx1<2>(acc, kT + dir * 18432, 144, 64 * (w >> 2), vT, 144, 32 * (w & 3), 4, r, hh);
        bf16_t* ST = (bf16_t*)(p.ws + WS_HST) + ((size_t)(cg * 8 + h) * 2 + dir) * 16384 + (size_t)(32 * (w & 3) + r) * 128 + 64 * (w >> 2);
#pragma unroll
        for (int t = 0; t < 2; ++t)
#pragma unroll
            for (int g = 0; g < 4; ++g) *(u32x2*)(ST + 32 * t + 8 * g + 4 * hh) = pack4(acc[t], g);
    }
    __syncthreads();
}
DEVI void hg_stage_b(const P& p, int pass, int tid, int G) {
    const int nseq = pass == 0 ? 16 : 2, nc = pass == 0 ? 4 : 32;
    const int total = nseq * 16 * 2048;
    for (int idx = blockIdx.x * 512 + tid; idx < total; idx += G * 512) {
        const int dkg = idx & 15, e = (idx >> 4) & 127, hd = (idx >> 11) & 15, s = idx >> 15, dir = hd & 1, h = hd >> 1, dk0 = dkg * 8;
        float S[8];
        if (pass == 0) {
#pragma unroll
            for (int i = 0; i < 8; ++i) S[i] = 0.f;
        } else {
            const float* st = p.in[3] + ((size_t)(((pass - 1) * 2 + s) * 2 + dir) * 8 + h) * 16384;
#pragma unroll
            for (int i = 0; i < 8; ++i) S[i] = st[(dk0 + i) * 128 + e];
        }
        for (int cc = 0; cc < nc; ++cc) {
            const int c = dir ? nc - 1 - cc : cc;
            const size_t ci = (size_t)((s * nc + c) * 8 + h) * 2 + dir;
            bf16_t* q = (bf16_t*)(p.ws + WS_HST) + ci * 16384 + e * 128 + dk0;
            const float* dv = (const float*)(p.ws + WS_HD) + ci * 128 + dk0;
            const u32x4 u = *(const u32x4*)q; const f32x4 d0 = *(const f32x4*)dv, d1 = *(const f32x4*)(dv + 4);
            u32x4 o; o.x = pk2(S[0], S[1]); o.y = pk2(S[2], S[3]); o.z = pk2(S[4], S[5]); o.w = pk2(S[6], S[7]);
            *(u32x4*)q = o;
#pragma unroll
            for (int qq = 0; qq < 4; ++qq) { const float da = qq < 2 ? d0[2 * qq] : d1[2 * qq - 4], db = qq < 2 ? d0[2 * qq + 1] : d1[2 * qq - 3];
                S[2 * qq] = da * S[2 * qq] + bflo(u[qq]); S[2 * qq + 1] = db * S[2 * qq + 1] + bfhi(u[qq]); }
        }
        if (pass == 0) {
            float* ns = p.out + OUT_HG + ((size_t)(s * 2 + dir) * 8 + h) * 16384;
#pragma unroll
            for (int i = 0; i < 8; ++i) ns[(dk0 + i) * 128 + e] = S[i];
        }
    }
}
DEVI void hg_stage_c(const P& p, ldsp lds, int pass, int item, int tid) {
    const int cg = item >> 3, h = item & 7, lane = tid & 63, w = __builtin_amdgcn_readfirstlane(tid >> 6), r = lane & 31, hh = lane >> 5;
    const int nc = pass == 0 ? 4 : 32, c = cg % nc;
    const bool hasF = pass != 0 || c != 0, hasB = pass != 0 || c != nc - 1;
    const bf16_t* PR = (const bf16_t*)(p.ws + WS_PROJ) + (size_t)(cg * 64) * NPROJ;
    ldsp raw = lds, img = lds + 69632, vT = lds + 139264; LAS float* ref = (LAS float*)(lds + 157696); LAS float* red = (LAS float*)(lds + 158720);
    stage_nat(raw, 272, PR + C_GF + h * 128, NPROJ, 64, 4, tid);
    stage_nat(raw + 17408, 272, PR + C_GB + h * 128, NPROJ, 64, 4, tid);
    stage_nat(raw + 34816, 272, PR + C_HQ + h * 128, NPROJ, 64, 4, tid);
    stage_tr(vT, 144, PR + C_HI + h * 128, NPROJ, 64, 128, tid, [](int) { return 1.0f; });
    __syncthreads();
    if (tid < 256) {
        const int dir = tid >> 7, dk = tid & 127;
        const LAS bf16_t* g = (const LAS bf16_t*)(raw + dir * 17408) + dk;
        const LAS bf16_t* qr = (const LAS bf16_t*)(raw + 34816) + dk;
        LAS bf16_t* qi = (LAS bf16_t*)(img + dir * 34816) + dk; LAS bf16_t* ki = (LAS bf16_t*)(img + dir * 34816 + 17408) + dk;
        float d = 0.f;
#pragma unroll 4
        for (int t = 0; t < 32; ++t) { const int j = dir == 0 ? 31 - t : 32 + t; const float gv = bf2f(g[j * 136]);
            const float qv = bf2f(qr[j * 136]), kv = 1.0f - __expf(gv);
            qi[j * 136] = (bf16_t)f2bf(qv * __expf(d)); ki[j * 136] = (bf16_t)f2bf(kv * __expf(-d)); d -= gv; }
        ref[dir * 128 + dk] = __expf(-d);
        d = 0.f;
#pragma unroll 4
        for (int t = 0; t < 32; ++t) { const int j = dir == 0 ? 32 + t : 31 - t; const float gv = bf2f(g[j * 136]);
            d += gv;
            const float qv = bf2f(qr[j * 136]), kv = 1.0f - __expf(gv);
            qi[j * 136] = (bf16_t)f2bf(qv * __expf(d)); ki[j * 136] = (bf16_t)f2bf(kv * __expf(-d)); }
    }
    __syncthreads();
    ldsp qF = img, kF = img + 17408, qB = img + 34816, kB = img + 52224, Pm = kF;
    f32x16 af[1], ab[1];
    if (w < 4) {
        zero_acc(af); zero_acc(ab);
        mma_nx1<1>(af, kF, 272, 32 * (w >> 1), qF, 272, 32 * (w & 1), 8, r, hh);
        mma_nx1<1>(ab, kB, 272, 32 * (w >> 1), qB, 272, 32 * (w & 1), 8, r, hh);
    } else {
        const int t2 = tid - 256;
#pragma unroll 1
        for (int dir = 0; dir < 2; ++dir) {
            if (dir == 0 ? !hasF : !hasB) continue;
            const bf16_t* ST = (const bf16_t*)(p.ws + WS_HST) + ((size_t)(cg * 8 + h) * 2 + dir) * 16384;
            for (int u = t2; u < 2048; u += 256) { const int e = u >> 4, ch = u & 15;
                const u32x4 v = *(const u32x4*)(ST + e * 128 + ch * 8);
                const LAS float* rf = ref + dir * 128 + ch * 8;
                u32x4 o;
#pragma unroll
                for (int q = 0; q < 4; ++q) o[q] = pk2(bflo(v[q]) * rf[2 * q], bfhi(v[q]) * rf[2 * q + 1]);
                *(LAS u32x4*)(raw + dir * 34816 + e * 272 + ch * 16) = o; }
        }
    }
    __syncthreads();
    if (w < 4) {
        const int i = 32 * (w & 1) + r;
#pragma unroll
        for (int g = 0; g < 4; ++g) { float v[4];
#pragma unroll
            for (int e2 = 0; e2 < 4; ++e2) { const int j = 32 * (w >> 1) + 8 * g + 4 * hh + e2; v[e2] = (j <= i ? af[0][4 * g + e2] : 0.f) + (j >= i ? ab[0][4 * g + e2] : 0.f); }
            u32x2 o; o.x = pk2(v[0], v[1]); o.y = pk2(v[2], v[3]);
            *(LAS u32x2*)(Pm + i * 144 + (32 * (w >> 1) + 8 * g + 4 * hh) * 2) = o; }
    }
    __syncthreads();
    const int eb = w >> 1, ib = w & 1, i = 32 * ib + r;
    f32x16 acc[1]; zero_acc(acc);
    mma_nx1<1>(acc, vT, 144, 32 * eb, Pm, 144, 32 * ib, 4, r, hh);
    if (hasF) mma_nx1<1>(acc, raw, 272, 32 * eb, qF, 272, 32 * ib, 8, r, hh);
    if (hasB) mma_nx1<1>(acc, raw + 34816, 272, 32 * eb, qB, 272, 32 * ib, 8, r, hh);
    float ss = 0.f;
#pragma unroll
    for (int q = 0; q < 16; ++q) ss += acc[0][q] * acc[0][q];
    ss += __shfl_xor(ss, 32);
    if (hh == 0) red[eb * 64 + i] = ss;
    __syncthreads();
    const float rstd = rsqrtf((red[i] + red[64 + i] + red[128 + i] + red[192 + i]) * (1.0f / 128.0f) + EPS);
    const bf16_t* og = PR + (size_t)i * NPROJ + C_HOG + h * 128 + 32 * eb;
    const float* nw = p.in[16] + h * 128 + 32 * eb;
    bf16_t* O = (bf16_t*)(p.ws + WS_OHG) + (size_t)(pass * PASS_ROWS + cg * 64 + i) * 1024 + h * 128 + 32 * eb;
#pragma unroll
    for (int g = 0; g < 4; ++g) { const int e = 8 * g + 4 * hh; const u32x2 gv = *(const u32x2*)(og + e); const f32x4 n4 = *(const f32x4*)(nw + e);
        u32x2 o; o.x = pk2(acc[0][4 * g] * rstd * n4[0] * bflo(gv.x), acc[0][4 * g + 1] * rstd * n4[1] * bfhi(gv.x));
        o.y = pk2(acc[0][4 * g + 2] * rstd * n4[2] * bflo(gv.y), acc[0][4 * g + 3] * rstd * n4[3] * bfhi(gv.y));
        *(u32x2*)(O + e) = o; }
    __syncthreads();
}
DEVI int scan_nitems(int b, int G) { return G == 256 ? (b < 128 ? 2 : 3) : (640 - b + G - 1) / G; }
DEVI int scan_item(int b, int G, int k) { return G == 256 ? (b < 128 ? (k == 0 ? b : 128 + b) : 256 + (b - 128) * 3 + k) : b + k * G; }
#undef SCAN_A
#undef SCAN_B
#undef SCAN_C
#define SCAN_A { int tid = threadIdx.x; asm volatile("" : "+v"(tid)); const int n_ = scan_nitems(blockIdx.x, G); \
    for (int k_ = 0; k_ < n_; ++k_) { const int it_ = scan_item(blockIdx.x, G, k_); if (it_ < 128) ret_stage_a(p, lds, pass, it_, tid); else hg_stage_a(p, lds, pass, it_ - 128, tid); } }
#define SCAN_B { int tid = threadIdx.x; asm volatile("" : "+v"(tid)); ret_stage_b(p, pass, tid, G); hg_stage_b(p, pass, tid, G); }
#define SCAN_C { int tid = threadIdx.x; asm volatile("" : "+v"(tid)); const int n_ = scan_nitems(blockIdx.x, G); \
    for (int k_ = 0; k_ < n_; ++k_) { const int it_ = scan_item(blockIdx.x, G, k_); if (it_ < 128) ret_stage_c(p, lds, pass, it_, tid); else hg_stage_c(p, lds, pass, it_ - 128, tid); } }

constexpr int NWAVES = 8;
constexpr int LDS_BYTES = 163840;


DEVI float wave_sum(float v) {
#pragma unroll
    for (int o = 1; o < 64; o <<= 1) v += __shfl_xor(v, o);
    return v;
}

DEVI int map_row(int mode, int n) {
    if (mode == 1) { const int s = n >= 2816 ? 1 : 0, j = n - s * 2816; return 256 * (j >> 7) + 128 * s + (j & 127); }
    if (mode == 2) { if (n >= 1024) return n; const int t = n >> 8, q = n & 255, hh = q >> 7, part = (q >> 6) & 1, bj = (q >> 5) & 1, i = q & 31; return 256 * t + 128 * bj + 64 * hh + 32 * part + i; }
    return n;
}
DEVI void transpose_item(const float* __restrict__ W, int ldw, int n_base, bf16_t* __restrict__ WT, int Kdst, int koff, int mode, LAS float* scr, int item, int nblk, int lane) {
    const int kb = item / nblk, nb = item - kb * nblk, k0 = 64 * kb, n0 = 32 * nb;
#pragma unroll 8
    for (int i = 0; i < 32; ++i) { const int kk = 2 * i + (lane >> 5); scr[kk * 33 + (lane & 31)] = W[(size_t)(k0 + kk) * ldw + n_base + n0 + (lane & 31)]; }
    asm volatile("s_waitcnt lgkmcnt(0)" ::: "memory");
    const int c = lane & 7;
#pragma unroll
    for (int j = 0; j < 4; ++j) { const int n = (lane >> 3) + 8 * j; const LAS float* s = scr + (8 * c) * 33 + n;
        u32x4 o; o.x = pk2(s[0 * 33], s[1 * 33]); o.y = pk2(s[2 * 33], s[3 * 33]); o.z = pk2(s[4 * 33], s[5 * 33]); o.w = pk2(s[6 * 33], s[7 * 33]);
        *(u32x4*)(WT + (size_t)map_row(mode, n0 + n) * Kdst + koff + k0 + 8 * c) = o; }
    asm volatile("s_waitcnt lgkmcnt(0)" ::: "memory");
}
DEVI void phase_prologue(const P& p, ldsp lds, int tid, int lane, int wave, int G) {
    if ((int)blockIdx.x < 144) {
        LAS float* sc = (LAS float*)lds;
        LAS float* red = sc + 5 * 1024;
        for (int i = tid; i < 5 * 1024; i += 512) { const int r = i >> 10, k = i & 1023; const float v = r == 0 ? p.in[5][k] : p.in[4][(r - 1) * 1024 + k]; sc[i] = siluf_(v); }
        __syncthreads();
        const int col = blockIdx.x * 64 + lane;
        const float* W = p.in[6];
        float a0 = 0.f, a1 = 0.f, a2 = 0.f, a3 = 0.f, a4 = 0.f;
#pragma unroll 8
        for (int kk = 0; kk < 128; ++kk) { const int k = wave * 128 + kk; const float w = W[(size_t)k * NMOD + col];
            a0 += sc[k] * w; a1 += sc[1024 + k] * w; a2 += sc[2048 + k] * w; a3 += sc[3072 + k] * w; a4 += sc[4096 + k] * w; }
        red[(wave * 5 + 0) * 64 + lane] = a0; red[(wave * 5 + 1) * 64 + lane] = a1; red[(wave * 5 + 2) * 64 + lane] = a2; red[(wave * 5 + 3) * 64 + lane] = a3; red[(wave * 5 + 4) * 64 + lane] = a4;
        __syncthreads();
        if (tid < 320) { const int r = tid >> 6, l = tid & 63; float s = 0.f;
#pragma unroll
            for (int w = 0; w < 8; ++w) s += red[(w * 5 + r) * 64 + l];
            const int cc = blockIdx.x * 64 + l;
            ((float*)(p.ws + WS_MOD))[r * NMOD + cc] = s + p.in[7][cc]; }
        __syncthreads();
    }
    if ((int)blockIdx.x == G - 1) {
        for (int i = tid; i < 2048; i += 512) {
            const int d = i >> 10, k = i & 1023;
            const float l0 = p.in[15][(d * 2 + 0) * 1024 + k], l1 = p.in[15][(d * 2 + 1) * 1024 + k];
            ((float*)(p.ws + WS_LB))[i] = 1.0f / (1.0f + expf(l1 - l0));
            const int pos = i >> 5, fi = i & 31;
            const double inv = exp(-(double)fi / 32.0 * log(10000.0));
            const float angf = (float)pos * (float)inv;
            double a = (double)angf; const double twopi = 6.283185307179586476925;
            a -= twopi * rint(a / twopi);
            double s = 0.0, c = 0.0, a2 = a * a, tc = 1.0, ts = a;
            for (int n = 0; n < 14; ++n) { c += tc; s += ts; tc *= -a2 / ((2 * n + 1) * (2 * n + 2)); ts *= -a2 / ((2 * n + 2) * (2 * n + 3)); }
            float* rt = (float*)(p.ws + WS_ROPE); rt[i * 2] = (float)c; rt[i * 2 + 1] = (float)s;
        }
    }
    LAS float* scr = (LAS float*)(lds + 32768 + wave * 8704);
    const int gw = blockIdx.x * NWAVES + wave, NGW = G * NWAVES;
    constexpr int I13 = 16 * 176, I2 = 44 * 32, IWIN = 16 * 256, IWG = 16 * 64, ISQ = 16 * 32;
    constexpr int NITEMS = 2 * I13 + 2 * I2 + IWIN + IWG + 3 * ISQ;
    unsigned char* ws = p.ws;
    for (int it = gw; it < NITEMS; it += NGW) {
        int r = it;
        if (r < I13) { transpose_item(p.in[9], 5632, 0, (bf16_t*)(ws + WS_W13A), 1024, 0, 1, scr, r, 176, lane); continue; } r -= I13;
        if (r < I13) { transpose_item(p.in[11], 5632, 0, (bf16_t*)(ws + WS_W13B), 1024, 0, 1, scr, r, 176, lane); continue; } r -= I13;
        if (r < I2) { transpose_item(p.in[10], 1024, 0, (bf16_t*)(ws + WS_W2A), 2816, 0, 0, scr, r, 32, lane); continue; } r -= I2;
        if (r < I2) { transpose_item(p.in[12], 1024, 0, (bf16_t*)(ws + WS_W2B), 2816, 0, 0, scr, r, 32, lane); continue; } r -= I2;
        if (r < IWIN) { transpose_item(p.in[13], WIN_N, 0, (bf16_t*)(ws + WS_WIN), 1024, 0, 2, scr, r, 256, lane); continue; } r -= IWIN;
        if (r < IWG) { transpose_item(p.in[13], WIN_N, W_GR, (bf16_t*)(ws + WS_WG), 1024, 0, 0, scr, r, 64, lane); continue; } r -= IWG;
        if (r < ISQ) { transpose_item(p.in[17], 1024, 0, (bf16_t*)(ws + WS_WR), 1024, 0, 0, scr, r, 32, lane); continue; } r -= ISQ;
        if (r < ISQ) { transpose_item(p.in[18], 1024, 0, (bf16_t*)(ws + WS_WH), 1024, 0, 0, scr, r, 32, lane); continue; } r -= ISQ;
        transpose_item(p.in[19], 1024, 0, (bf16_t*)(ws + WS_WO), 1024, 0, 0, scr, r, 32, lane);
    }
}

DEVI void phase_modnorm(const P& p, int which, int lane, int wave, int G) {
    const int gw = blockIdx.x * NWAVES + wave, NGW = G * NWAVES;
    for (int m = gw; m < MT; m += NGW) {
        const float* xr = which == 0 ? (m < MP ? p.in[0] + (size_t)m * D : p.in[1] + (size_t)(m - MP) * D) : p.out + (size_t)m * D;
        f32x4 v[4]; float ss = 0.f;
#pragma unroll
        for (int j = 0; j < 4; ++j) { v[j] = *(const f32x4*)(xr + 4 * lane + 256 * j); ss += (v[j][0] * v[j][0] + v[j][1] * v[j][1]) + (v[j][2] * v[j][2] + v[j][3] * v[j][3]); }
        const float rstd = rsqrtf(wave_sum(ss) * (1.0f / D) + EPS);
        if (which == 3) {
            float* o = p.out + (size_t)m * D;
#pragma unroll
            for (int j = 0; j < 4; ++j) { const int c = 4 * lane + 256 * j; const f32x4 w = *(const f32x4*)(p.in[20] + c); *(f32x4*)(o + c) = v[j] * rstd * w; }
        } else {
            const float* nw = p.in[8] + which * D;
            const float* mod = (const float*)(p.ws + WS_MOD) + (size_t)mod_row(m) * NMOD;
            const float* sh = mod + (which * 3) * D; const float* sc = mod + (which * 3 + 1) * D;
            bf16_t* h = (bf16_t*)(p.ws + WS_H) + (size_t)m * D;
#pragma unroll
            for (int j = 0; j < 4; ++j) { const int c = 4 * lane + 256 * j;
                const f32x4 w = *(const f32x4*)(nw + c), s4 = *(const f32x4*)(sc + c), h4 = *(const f32x4*)(sh + c);
                const f32x4 y = v[j] * rstd * w * (s4 + 1.0f) + h4;
                u32x2 o; o.x = pk2(y[0], y[1]); o.y = pk2(y[2], y[3]); *(u32x2*)(h + c) = o; }
        }
    }
}

typedef GAS unsigned gu32;
#define RLX_AGENT __ATOMIC_RELAXED, __HIP_MEMORY_SCOPE_AGENT
constexpr size_t WS_BAR = 256 * 1024;
#define XB_TMO      128
#define XB_XCNT(j)  (256  + 64 * (j))
#define XB_XSUB(j)  (1280 + 64 * (j))
#define XB_XGEN(j)  (2304 + 64 * (j))
#define XB_TOP      3328
#define XB_TOPGEN   3392
#define XCD_BAR_WORDS 3456
#define XB_SPIN_CAP (1u << 18)

__device__ __forceinline__ unsigned xb_ld(unsigned* p)              { return __hip_atomic_load(p, __ATOMIC_RELAXED, __HIP_MEMORY_SCOPE_AGENT); }
__device__ __forceinline__ unsigned xb_add(unsigned* p, unsigned v) { return __hip_atomic_fetch_add(p, v, __ATOMIC_RELAXED, __HIP_MEMORY_SCOPE_AGENT); }
__device__ __forceinline__ unsigned xb_xcc_id() { return (unsigned)__builtin_amdgcn_s_getreg((3 << 11) | 20) & 0xFu; }
#define XB_SPIN(cond, bar) do { unsigned _sp = 0; while (cond) { __builtin_amdgcn_s_sleep(1); \
    if ((++_sp & 255u) == 0u) { if (xb_ld(&(bar)[XB_TMO])) break; if (_sp > XB_SPIN_CAP) { atomicAdd(&(bar)[XB_TMO], 1u); break; } } } } while (0)

struct XcdBarrier {
    unsigned* bar; unsigned x;
    volatile LAS unsigned* st;
};

__device__ __forceinline__ XcdBarrier xcd_barrier_post(unsigned* bar, volatile LAS unsigned* st) {
    XcdBarrier b; b.bar = bar; b.x = xb_xcc_id(); b.st = st;
    if (threadIdx.x == 0) (void)xb_add(&bar[XB_XCNT(b.x)], 1u);
    return b;
}
__device__ __forceinline__ void xcd_barrier_complete(unsigned* bar, unsigned x, unsigned& nloc, unsigned& nx) {
    const unsigned G = gridDim.x * gridDim.y * gridDim.z;
    unsigned sum, cnt, mine, sp = 0u;
    for (;;) {
        sum = 0u; cnt = 0u; mine = 0u;
#pragma unroll
        for (unsigned j = 0; j < 16; ++j) { const unsigned c = xb_ld(&bar[XB_XCNT(j)]); sum += c; cnt += (c > 0u) ? 1u : 0u; mine = (j == x) ? c : mine; }
        if (sum == G) break;
        __builtin_amdgcn_s_sleep(1);
        if ((++sp & 255u) == 0u) { if (xb_ld(&bar[XB_TMO])) break; if (sp > XB_SPIN_CAP) { atomicAdd(&bar[XB_TMO], 1u); break; } }
    }
    nloc = mine > 0u ? mine : 1u; nx = cnt > 0u ? cnt : 1u;
}

__device__ __forceinline__ void xcd_barrier(const XcdBarrier& b) {
    asm volatile("s_waitcnt vmcnt(0)" ::: "memory");
    __syncthreads();
    if (threadIdx.x == 0) {
        unsigned* bar = b.bar;
        __builtin_amdgcn_s_waitcnt(0);
        unsigned nloc = b.st[0], nx = b.st[1];
        if (nloc == 0u) { xcd_barrier_complete(bar, b.x, nloc, nx); b.st[0] = nloc; b.st[1] = nx; }
        const unsigned old = xb_add(&bar[XB_XSUB(b.x)], 1u);
        const unsigned gen = old / nloc;
        if (old + 1u == (gen + 1u) * nloc) {
            __builtin_amdgcn_fence(__ATOMIC_RELEASE, "agent");
            asm volatile("s_waitcnt vmcnt(0)" ::: "memory");
            const unsigned og = xb_add(&bar[XB_TOP], 1u);
            const unsigned tg = og / nx;
            if (og + 1u == (tg + 1u) * nx) xb_add(&bar[XB_TOPGEN], 1u);
            else XB_SPIN(xb_ld(&bar[XB_TOPGEN]) == tg, bar);
            __builtin_amdgcn_fence(__ATOMIC_ACQUIRE, "agent");
            xb_add(&bar[XB_XGEN(b.x)], 1u);
            asm volatile("s_waitcnt vmcnt(0)" ::: "memory");
        } else {
            XB_SPIN(xb_ld(&bar[XB_XGEN(b.x)]) == gen, bar);
            __builtin_amdgcn_fence(__ATOMIC_ACQUIRE, "agent");
            asm volatile("s_waitcnt vmcnt(0)" ::: "memory");
        }
    }
    __syncthreads();
}

#ifndef PHMASK
#define PHMASK 0xffff
#endif
#define PH(k) if (p.lo <= (k) && (k) < p.hi)
#define SYNC(k) do { if (p.lo <= (k) && (k) + 1 < p.hi) { if ((k) == 0) { asm volatile("s_waitcnt vmcnt(0) lgkmcnt(0)" ::: "memory"); cg::this_grid().sync(); } else xcd_barrier(bar); } } while (0)
#define GEMM_UP(WOFF) do { pg8::Gemm g{(const bf16_t*)(ws + WS_H), (const bf16_t*)(ws + (WOFF)), MT, 2 * FF, D}; \
    pg8::StaticOrder S; S.init(MT, 2 * FF, G, (int)blockIdx.x); pg8::EpiSwiglu E{(bf16_t*)(ws + WS_PROJ)}; \
    pg8::gemm_phase<pg8::EpiSwiglu, pg8::StaticOrder, true, true>(lds, g, S, E); } while (0)
#define GEMM_RES(AOFF, WOFF, KK, XP, XS, GIDX, SCL) do { pg8::Gemm g{(const bf16_t*)(ws + (AOFF)), (const bf16_t*)(ws + (WOFF)), MT, D, (KK)}; \
    pg8::StaticOrder S; S.init(MT, D, G, (int)blockIdx.x); pg8::EpiResid E{(XP), (XS), p.out, (const float*)(ws + WS_MOD), (GIDX), (SCL)}; \
    pg8::gemm_phase<pg8::EpiResid, pg8::StaticOrder, true, true>(lds, g, S, E); } while (0)

__global__ void __launch_bounds__(NWAVES * 64, 2) mk(P p) {
    extern __shared__ __attribute__((aligned(16))) unsigned char lds_raw[];
    ldsp lds = (ldsp)lds_raw;
    const int G = gridDim.x;
    unsigned char* ws = p.ws;
    volatile LAS unsigned* bst = (volatile LAS unsigned*)(lds + LDS_BYTES - 16);
    if (threadIdx.x < 2) bst[threadIdx.x] = 0u;
    __syncthreads();
    const XcdBarrier bar = xcd_barrier_post((unsigned*)(ws + WS_BAR), bst);
#define TIDS int tid = threadIdx.x; asm volatile("" : "+v"(tid)); const int lane = tid & 63, wave = __builtin_amdgcn_readfirstlane(tid >> 6); (void)lane; (void)wave;
    PH(0) { if (PHMASK & 1) { TIDS phase_prologue(p, lds, tid, lane, wave, G); } } SYNC(0);
    PH(1) { if (PHMASK & 2) { TIDS phase_modnorm(p, 0, lane, wave, G); } } SYNC(1);
    PH(2) { if (PHMASK & 4) GEMM_UP(WS_W13A); } SYNC(2);
    PH(3) { if (PHMASK & 8) GEMM_RES(WS_PROJ, WS_W2A, FF, p.in[0], p.in[1], 2, 0.5f); } SYNC(3);
    PH(4) { if (PHMASK & 2) { TIDS phase_modnorm(p, 1, lane, wave, G); } } SYNC(4);
    for (int pass = 0; pass < 3; ++pass) {
        const int b = 5 + 4 * pass;
        PH(b) { if (PHMASK & 16) {
            pg8::Gemm g{(const bf16_t*)(ws + WS_H) + (size_t)pass * PASS_ROWS * D, (const bf16_t*)(ws + WS_WIN), PASS_ROWS, NPROJ, D};
            pg8::StaticOrder S; S.init(PASS_ROWS, NPROJ, G, (int)blockIdx.x);
            pg8::EpiWin E{(bf16_t*)(ws + WS_PROJ), (const float*)(ws + WS_LB), (const float*)(ws + WS_ROPE), pass};
            pg8::gemm_phase<pg8::EpiWin, pg8::StaticOrder, true, true>(lds, g, S, E); } } SYNC(b);
        PH(b + 1) { SCAN_A } SYNC(b + 1);
        PH(b + 2) { SCAN_B } SYNC(b + 2);
        PH(b + 3) { SCAN_C } SYNC(b + 3);
    }
    PH(17) { if (PHMASK & 32) {
        pg8::Gemm g{(const bf16_t*)(ws + WS_H), (const bf16_t*)(ws + WS_WG), MT, 2048, D};
        pg8::StaticOrder S; S.init(MT, 2048, G, (int)blockIdx.x);
        pg8::EpiGates E{(bf16_t*)(ws + WS_PROJ)};
        pg8::gemm_phase<pg8::EpiGates, pg8::StaticOrder, true, true>(lds, g, S, E); } } SYNC(17);
    PH(18) { if (PHMASK & 64) {
        { pg8::Gemm g{(const bf16_t*)(ws + WS_ORET), (const bf16_t*)(ws + WS_WR), MT, D, D};
          pg8::StaticOrder S; S.init(MT, D, G, (int)blockIdx.x);
          pg8::EpiMergeA E{(const bf16_t*)(ws + WS_PROJ), (float*)(ws + WS_ST)};
          pg8::gemm_phase<pg8::EpiMergeA, pg8::StaticOrder, true, true>(lds, g, S, E); }
        { pg8::Gemm g{(const bf16_t*)(ws + WS_OHG), (const bf16_t*)(ws + WS_WH), MT, D, D};
          pg8::StaticOrder S; S.init(MT, D, G, (int)blockIdx.x);
          pg8::EpiMergeB E{(const bf16_t*)(ws + WS_PROJ), (const float*)(ws + WS_ST), (bf16_t*)(ws + WS_H)};
          pg8::gemm_phase<pg8::EpiMergeB, pg8::StaticOrder, true, true>(lds, g, S, E); } } } SYNC(18);
    PH(19) { if (PHMASK & 8) GEMM_RES(WS_H, WS_WO, D, p.out, p.out + (size_t)MP * D, 5, 1.0f); } SYNC(19);
    PH(20) { if (PHMASK & 2) { TIDS phase_modnorm(p, 2, lane, wave, G); } } SYNC(20);
    PH(21) { if (PHMASK & 4) GEMM_UP(WS_W13B); } SYNC(21);
    PH(22) { if (PHMASK & 8) GEMM_RES(WS_PROJ, WS_W2B, FF, p.out, p.out + (size_t)MP * D, 8, 0.5f); } SYNC(22);
    PH(23) { if (PHMASK & 2) { TIDS phase_modnorm(p, 3, lane, wave, G); } }
}

static int g_grid = 0;
static void launch_mk(const P& base, int lo, int hi, hipStream_t stream, bool coop) {
    P p = base; p.lo = lo; p.hi = hi;
    if (coop) { void* args[] = {&p}; hipError_t e = hipLaunchCooperativeKernel((void*)mk, dim3(g_grid), dim3(NWAVES * 64), args, LDS_BYTES, stream);
        if (e != hipSuccess) fprintf(stderr, "cooperative launch failed: %s (grid %d)\n", hipGetErrorString(e), g_grid); }
    else hipLaunchKernelGGL(mk, dim3(g_grid), dim3(NWAVES * 64), LDS_BYTES, stream, p);
}

extern "C" void kernel_launch(void* const* d_in, const int* in_sizes, int n_in, void* d_out, int out_size, void* d_ws, size_t ws_size, hipStream_t stream) {
    if (g_grid == 0) {
        int dev = 0, cus = 0, per_cu = 0;
        hipGetDevice(&dev);
        hipDeviceGetAttribute(&cus, hipDeviceAttributeMultiprocessorCount, dev);
        hipFuncSetAttribute((const void*)mk, hipFuncAttributeMaxDynamicSharedMemorySize, LDS_BYTES);
        hipOccupancyMaxActiveBlocksPerMultiprocessor(&per_cu, (const void*)mk, NWAVES * 64, LDS_BYTES);
        if (per_cu < 1) per_cu = 1;
        g_grid = cus * per_cu;
        (void)hipGetLastError();
    }
    P p{};
    for (int i = 0; i < 21; ++i) p.in[i] = (const float*)d_in[i];
    p.out = (float*)d_out; p.ws = (unsigned char*)d_ws;
#if HYBRID
    launch_mk(p, 0, 5, stream, true);
    for (int pass = 0; pass < 3; ++pass) {
        const int nseq = pass == 0 ? 16 : 2;
        launch_mk(p, 5 + 4 * pass, 9 + 4 * pass, stream, true);
#if HYBRID == 2 || HYBRID == 4
        k_ret_scan<<<nseq * 8, 256, 0, stream>>>(p, pass);
        k_ret_fin<<<PASS_ROWS * 4 / 4, 256, 0, stream>>>(p, pass);
#endif
#if HYBRID == 3 || HYBRID == 4
        k_hg_scan<<<nseq * 16, 128, 0, stream>>>(p, pass);
        k_hg_fin<<<PASS_ROWS * 8 / 4, 256, 0, stream>>>(p, pass);
#endif
    }
    launch_mk(p, 17, 24, stream, true);
#else
    (void)hipMemsetAsync((char*)d_ws + WS_BAR, 0, 16384, stream);
    launch_mk(p, 0, 24, stream, true);
#endif
}
```

```cpp
#include <hip/hip_runtime.h>
#include <hip/hip_cooperative_groups.h>
#include <cstdint>
#include <cstdio>
namespace cg = cooperative_groups;

#define DEVI __device__ __forceinline__
#define LAS __attribute__((address_space(3)))
#define GAS __attribute__((address_space(1)))

constexpr int D = 1024, MP = 4096, MS = 8192, MT = 12288, FF = 2816, NPROJ = 8192, NMOD = 9 * 1024;
constexpr int PASS_ROWS = 4096;
constexpr float EPS = 1e-6f;
constexpr int C_RQ = 0, C_RK = 512, C_RV = 1024, C_RG = 2048, C_HQ = 3072, C_GF = 4096, C_GB = 5120, C_HI = 6144, C_HOG = 7168;
constexpr int W_GR = 8192, WIN_N = 10240;
constexpr float QK_SCALE = 0.08838834764831845f;

constexpr size_t MiB = 1u << 20;
constexpr size_t WS_MOD = 0;
constexpr size_t WS_LB = 192 * 1024;
constexpr size_t WS_ROPE = 200 * 1024;
constexpr size_t WS_W13A = 1 * MiB, WS_W2A = 12 * MiB, WS_W13B = 18 * MiB, WS_W2B = 29 * MiB;
constexpr size_t WS_WIN = 35 * MiB, WS_WG = 51 * MiB, WS_WR = 55 * MiB, WS_WH = 57 * MiB, WS_WO = 59 * MiB;
constexpr size_t WS_H = 61 * MiB;
constexpr size_t WS_ORET = 85 * MiB, WS_OHG = 109 * MiB;
constexpr size_t WS_PROJ = 133 * MiB;
constexpr size_t WS_ST = 199 * MiB;

typedef unsigned short bf16_t;
typedef float f32x4 __attribute__((ext_vector_type(4)));
typedef float f32x2 __attribute__((ext_vector_type(2)));
typedef unsigned u32x4 __attribute__((ext_vector_type(4)));
typedef unsigned u32x2 __attribute__((ext_vector_type(2)));
typedef short bf16x8 __attribute__((ext_vector_type(8)));

struct P {
    const float* in[21];
    float* out;
    unsigned char* ws;
    int lo, hi;
};

DEVI float bf2f(bf16_t v) { return __uint_as_float(((unsigned)v) << 16); }
DEVI unsigned f2bf(float f) { unsigned u = __float_as_uint(f); return (u + 0x7fffu + ((u >> 16) & 1u)) >> 16; }
typedef __bf16 bf16x2_t __attribute__((ext_vector_type(2)));
DEVI unsigned pk2(float lo, float hi) { bf16x2_t v; v[0] = (__bf16)lo; v[1] = (__bf16)hi; return __builtin_bit_cast(unsigned, v); }
DEVI float bflo(unsigned w) { return __uint_as_float(w << 16); }
DEVI float bfhi(unsigned w) { return __uint_as_float(w & 0xffff0000u); }
DEVI float sigmoidf_(float x) { return 1.0f / (1.0f + __expf(-x)); }
DEVI float siluf_(float x) { return x / (1.0f + __expf(-x)); }
DEVI int mod_row(int m) { return m < MP ? 0 : 1 + ((m - MP) >> 11); }

typedef LAS unsigned char* ldsp;
#define HYBRID 0
namespace pg8 {
#define PG8_LAS __attribute__((address_space(3)))
typedef unsigned short bf16_t;
typedef short bf16x8 __attribute__((ext_vector_type(8)));
typedef float f32x4 __attribute__((ext_vector_type(4)));
typedef unsigned u32x4 __attribute__((ext_vector_type(4)));
constexpr int BM = 256, BK = 64, HALF = 128, HTB = HALF * BK * 2  , STAGE_BYTES = 8 * HTB, NXCD = 8, WGM = 8;

__host__ __device__ __forceinline__ int lds_byte(int r, int c) { const int st = (r >> 4) * 2 + (c >> 5), rr = r & 15, cc = c & 31, ob = rr * 64 + cc * 2; return st * 1024 + (ob ^ (((ob >> 9) & 1) << 5)); }
__host__ __device__ __forceinline__ void stage_rc(int b, int& R, int& C) { const int st = b / 1024, sb = b % 1024, swz = sb ^ (((sb >> 9) & 1) << 5); R = (st >> 1) * 16 + swz / 64; C = (st & 1) * 32 + (swz % 64) / 2; }
__host__ __device__ __forceinline__ int perm32(int rho) { const int n = rho >> 4, i = rho & 15; return 8 * (i >> 2) + 4 * n + (i & 3); }

struct Unit { int pm, pn; };
struct Gemm { const bf16_t* A; const bf16_t* Bt; int M, N, K; };

struct StaticOrder {
    int nM, nN, nwg, G, c;
    __host__ __device__ void init(int M, int N, int G_, int c_) { nM = M / BM; nN = N / BM; nwg = nM * nN; G = G_; c = c_; }
    __host__ __device__ bool next(int i, Unit& u) const {
        const long L = (long)i * G + c; if (L >= nwg) return false;
        int wgid = (int)L; { const int q = nwg / NXCD, r = nwg % NXCD, xcd = wgid % NXCD, off = wgid / NXCD; wgid = (xcd < r ? xcd * (q + 1) : r * (q + 1) + (xcd - r) * q) + off; }
        const int nig = WGM * nN, gid = wgid / nig, fm = gid * WGM, gsz = (nM - fm) < WGM ? (nM - fm) : WGM;
        u.pm = fm + ((wgid % nig) % gsz); u.pn = (wgid % nig) / gsz; return true;
    }
    __device__ __forceinline__ void a_ready(const Unit&) const {}
    __device__ __forceinline__ void done(const Unit&) const {}
};


struct EpiSwiglu {
    static constexpr bool PERM = true, AFTER_DRAIN = false, HAS_MID = false;
    bf16_t* act;
    __device__ __forceinline__ void mid(f32x4 (&)[2][2][4][2], const Unit&, int, int, int, int) const {}
    __device__ __forceinline__ void operator()(const f32x4 (&acc)[2][2][4][2], const Unit& u, int wr, int wc, int fr, int fq) const {
        const int row0 = u.pm * BM + wr * 64 + fr, col0 = u.pn * 128 + wc * 32 + 8 * fq;
#pragma unroll
        for (int ai = 0; ai < 2; ++ai)
#pragma unroll
            for (int m = 0; m < 4; ++m) {
                float v[8];
#pragma unroll
                for (int n = 0; n < 2; ++n)
#pragma unroll
                    for (int e = 0; e < 4; ++e) { const float a = acc[ai][0][m][n][e], b = acc[ai][1][m][n][e]; v[n * 4 + e] = a / (1.0f + __expf(-a)) * b; }
                u32x4 w; w.x = ::pk2(v[0], v[1]); w.y = ::pk2(v[2], v[3]); w.z = ::pk2(v[4], v[5]); w.w = ::pk2(v[6], v[7]);
                *(u32x4*)(act + (size_t)(row0 + ai * HALF + m * 16) * 2816 + col0) = w;
            }
    }
};
struct EpiResid {
    static constexpr bool PERM = false, AFTER_DRAIN = false, HAS_MID = false;
    const float* xp; const float* xs; float* out; const float* mod; int gidx; float scale;
    __device__ __forceinline__ void mid(f32x4 (&)[2][2][4][2], const Unit&, int, int, int, int) const {}
    __device__ __forceinline__ void operator()(const f32x4 (&acc)[2][2][4][2], const Unit& u, int wr, int wc, int fr, int fq) const {
        const int rowt = u.pm * BM, row0 = rowt + wr * 64 + fr, col0 = u.pn * BM + wc * 32 + 4 * fq;
        const float* gate = mod + (size_t)(rowt < 4096 ? 0 : 1 + ((rowt - 4096) >> 11)) * 9216 + gidx * 1024;
        const float* xb = rowt < 4096 ? xp : xs - (size_t)4096 * 1024;
#pragma unroll
        for (int bj = 0; bj < 2; ++bj)
#pragma unroll
            for (int n = 0; n < 2; ++n) {
                const int c = col0 + bj * HALF + n * 16;
                const f32x4 g4 = *(const f32x4*)(gate + c) * scale;
#pragma unroll
                for (int ai = 0; ai < 2; ++ai)
#pragma unroll
                    for (int m = 0; m < 4; ++m) { const size_t off = (size_t)(row0 + ai * HALF + m * 16) * 1024 + c;
                        const f32x4 xin = *(const f32x4*)(xb + off); *(f32x4*)(out + off) = xin + g4 * acc[ai][bj][m][n]; }
            }
    }
};
struct EpiWin {
    static constexpr bool PERM = true, AFTER_DRAIN = false, HAS_MID = false;
    bf16_t* PR; const float* lb; const float* rope; int pass;
    __device__ __forceinline__ void mid(f32x4 (&)[2][2][4][2], const Unit&, int, int, int, int) const {}
    __device__ __forceinline__ void operator()(const f32x4 (&acc)[2][2][4][2], const Unit& u, int wr, int wc, int fr, int fq) const {
        const int row0 = u.pm * BM + wr * 64 + fr;
        if (u.pn < 4) {
            const int hh = wc >> 1, part = wc & 1, i0 = 8 * fq;
            const float sc = u.pn >= 2 ? 0.08838834764831845f : 1.0f;
#pragma unroll
            for (int ai = 0; ai < 2; ++ai)
#pragma unroll
                for (int m = 0; m < 4; ++m) {
                    const int row = row0 + ai * HALF + m * 16;
                    float cs[8], sn[8];
                    if (pass > 0) { const int t = row & 2047; const int pos = part ? (t & 63) : (t >> 6);
                        const f32x4* rp = (const f32x4*)(rope + (size_t)(pos * 32 + i0) * 2);
#pragma unroll
                        for (int q = 0; q < 4; ++q) { const f32x4 r4 = rp[q]; cs[2 * q] = r4[0]; sn[2 * q] = r4[1]; cs[2 * q + 1] = r4[2]; sn[2 * q + 1] = r4[3]; } }
                    else {
#pragma unroll
                        for (int q = 0; q < 8; ++q) { cs[q] = 1.0f; sn[q] = 0.0f; } }
                    float y1[8], y2[8];
#pragma unroll
                    for (int e = 0; e < 8; ++e) { const float x1 = acc[ai][0][m][e >> 2][e & 3], x2 = acc[ai][1][m][e >> 2][e & 3];
                        y1[e] = (x1 * cs[e] - x2 * sn[e]) * sc; y2[e] = (x2 * cs[e] + x1 * sn[e]) * sc; }
                    bf16_t* dst = PR + (size_t)row * 8192 + u.pn * BM + 128 * hh + 64 * part + i0;
                    u32x4 w; w.x = ::pk2(y1[0], y1[1]); w.y = ::pk2(y1[2], y1[3]); w.z = ::pk2(y1[4], y1[5]); w.w = ::pk2(y1[6], y1[7]);
                    *(u32x4*)dst = w;
                    w.x = ::pk2(y2[0], y2[1]); w.y = ::pk2(y2[2], y2[3]); w.z = ::pk2(y2[4], y2[5]); w.w = ::pk2(y2[6], y2[7]);
                    *(u32x4*)(dst + 32) = w;
                }
        } else {
            const int seg = u.pn >> 2;
#pragma unroll
            for (int bj = 0; bj < 2; ++bj) {
                const int col = u.pn * BM + bj * HALF + wc * 32 + 8 * fq;
                float l[8];
                if (seg == 4 || seg == 5) {
                    const f32x4 l0 = *(const f32x4*)(lb + (col - 4096)), l1 = *(const f32x4*)(lb + (col - 4096) + 4);
#pragma unroll
                    for (int e = 0; e < 4; ++e) { l[e] = l0[e]; l[4 + e] = l1[e]; }
                } else {
#pragma unroll
                    for (int e = 0; e < 8; ++e) l[e] = 0.f;
                }
#pragma unroll
                for (int ai = 0; ai < 2; ++ai)
#pragma unroll
                    for (int m = 0; m < 4; ++m) {
                        float v[8];
#pragma unroll
                        for (int e = 0; e < 8; ++e) { float x = acc[ai][bj][m][e >> 2][e & 3];
                            if (seg == 2 || seg == 7) x = x / (1.0f + __expf(-x));
                            else if (seg == 3) x = x / (1.0f + __expf(-x)) * 0.08838834764831845f;
                            else if (seg == 4 || seg == 5) x = __logf(l[e] + (1.0f - l[e]) / (1.0f + __expf(-x)));
                            v[e] = x; }
                        u32x4 w; w.x = ::pk2(v[0], v[1]); w.y = ::pk2(v[2], v[3]); w.z = ::pk2(v[4], v[5]); w.w = ::pk2(v[6], v[7]);
                        *(u32x4*)(PR + (size_t)(row0 + ai * HALF + m * 16) * 8192 + col) = w;
                    }
            }
        }
    }
};
struct EpiGates {
    static constexpr bool PERM = true, AFTER_DRAIN = false, HAS_MID = false;
    bf16_t* G;
    __device__ __forceinline__ void mid(f32x4 (&)[2][2][4][2], const Unit&, int, int, int, int) const {}
    __device__ __forceinline__ void operator()(const f32x4 (&acc)[2][2][4][2], const Unit& u, int wr, int wc, int fr, int fq) const {
        const int row0 = u.pm * BM + wr * 64 + fr;
#pragma unroll
        for (int bj = 0; bj < 2; ++bj) {
            const int col = u.pn * BM + bj * HALF + wc * 32 + 8 * fq;
#pragma unroll
            for (int ai = 0; ai < 2; ++ai)
#pragma unroll
                for (int m = 0; m < 4; ++m) {
                    float v[8];
#pragma unroll
                    for (int e = 0; e < 8; ++e) v[e] = 1.0f / (1.0f + __expf(-acc[ai][bj][m][e >> 2][e & 3]));
                    u32x4 w; w.x = ::pk2(v[0], v[1]); w.y = ::pk2(v[2], v[3]); w.z = ::pk2(v[4], v[5]); w.w = ::pk2(v[6], v[7]);
                    *(u32x4*)(G + (size_t)(row0 + ai * HALF + m * 16) * 2048 + col) = w;
                }
        }
    }
};
struct EpiMergeA {
    static constexpr bool PERM = false, AFTER_DRAIN = false, HAS_MID = false;
    const bf16_t* G; float* T;
    __device__ __forceinline__ void mid(f32x4 (&)[2][2][4][2], const Unit&, int, int, int, int) const {}
    __device__ __forceinline__ void operator()(const f32x4 (&acc)[2][2][4][2], const Unit& u, int wr, int wc, int fr, int fq) const {
        const int row0 = u.pm * BM + wr * 64 + fr, col0 = u.pn * BM + wc * 32 + 4 * fq;
#pragma unroll
        for (int ai = 0; ai < 2; ++ai)
#pragma unroll
            for (int m = 0; m < 4; ++m) { const size_t row = (size_t)(row0 + ai * HALF + m * 16);
#pragma unroll
                for (int bj = 0; bj < 2; ++bj)
#pragma unroll
                    for (int n = 0; n < 2; ++n) { const int c = col0 + bj * HALF + n * 16;
                        const u32x2 g = *(const u32x2*)(G + row * 2048 + c);
                        f32x4 v = acc[ai][bj][m][n]; v[0] *= ::bflo(g.x); v[1] *= ::bfhi(g.x); v[2] *= ::bflo(g.y); v[3] *= ::bfhi(g.y);
                        *(f32x4*)(T + row * 1024 + c) = v; } }
    }
};
struct EpiMergeB {
    static constexpr bool PERM = false, AFTER_DRAIN = false, HAS_MID = false;
    const bf16_t* G; const float* T; bf16_t* Mg;
    __device__ __forceinline__ void mid(f32x4 (&)[2][2][4][2], const Unit&, int, int, int, int) const {}
    __device__ __forceinline__ void operator()(const f32x4 (&acc)[2][2][4][2], const Unit& u, int wr, int wc, int fr, int fq) const {
        const int row0 = u.pm * BM + wr * 64 + fr, col0 = u.pn * BM + wc * 32 + 4 * fq;
#pragma unroll
        for (int ai = 0; ai < 2; ++ai)
#pragma unroll
            for (int m = 0; m < 4; ++m) { const size_t row = (size_t)(row0 + ai * HALF + m * 16);
#pragma unroll
                for (int bj = 0; bj < 2; ++bj)
#pragma unroll
                    for (int n = 0; n < 2; ++n) { const int c = col0 + bj * HALF + n * 16;
                        const u32x2 g = *(const u32x2*)(G + row * 2048 + 1024 + c);
                        f32x4 v = acc[ai][bj][m][n]; const f32x4 t = *(const f32x4*)(T + row * 1024 + c);
                        v[0] = v[0] * ::bflo(g.x) + t[0]; v[1] = v[1] * ::bfhi(g.x) + t[1]; v[2] = v[2] * ::bflo(g.y) + t[2]; v[3] = v[3] * ::bfhi(g.y) + t[3];
                        u32x2 w; w.x = ::pk2(v[0], v[1]); w.y = ::pk2(v[2], v[3]);
                        *(u32x2*)(Mg + row * 1024 + c) = w; } }
    }
};

template <class Epi, class Sched, bool ALIGN_EPI = false, bool SP2 = false>
__device__ __forceinline__ void gemm_phase(PG8_LAS unsigned char* lds, const Gemm g, const Sched& S, const Epi& E) {
    int tid_ = threadIdx.x; asm volatile("" : "+v"(tid_)); const int tid = tid_, wid = __builtin_amdgcn_readfirstlane(tid >> 6), lane = tid & 63, wr = wid >> 2, wc = wid & 3, fr = lane & 15, fq = lane >> 4;
    const int K = g.K, nt = K / BK;
    unsigned voffA[2], voffB[2];
#pragma unroll
    for (int i = 0; i < 2; ++i) { int R, C; stage_rc(tid * 16 + i * 8192, R, C); const int Rb = Epi::PERM ? ((R & ~31) + perm32(R & 31)) : R;
        voffA[i] = (unsigned)(R * K + C) * 2u; voffB[i] = (unsigned)(Rb * K + C) * 2u; }
    const size_t kstep = (size_t)(BK * 2);
    const size_t hstep = (size_t)HALF * K * 2;
    const size_t tstep = 2 * hstep;
    const unsigned ldsw = (unsigned)wid * 1024u;
    const int aoff = lds_byte(wr * 64 + fr, fq * 8), boff = lds_byte(wc * 32 + fr, fq * 8);
#define PG8_SA(b, h) (((b) * 2 + (h)) * HTB)
#define PG8_SB(b, h) ((4 + (b) * 2 + (h)) * HTB)
#define PG8_STAGE(bufoff, gbase, voff) do { _Pragma("unroll") for (int _i = 0; _i < 2; ++_i) \
        __builtin_amdgcn_global_load_lds((const unsigned*)((const char*)(gbase) + (voff)[_i]), (PG8_LAS unsigned*)(lds + (bufoff) + ldsw + _i * 8192), 16, 0, 0); } while (0)
#define PG8_LDA(dst, b, h) do { _Pragma("unroll") for (int m = 0; m < 4; ++m) _Pragma("unroll") for (int k = 0; k < 2; ++k) dst[m][k] = *(const PG8_LAS bf16x8*)(lds + PG8_SA(b, h) + aoff + m * 2048 + k * 1024); } while (0)
#define PG8_LDB(dst, b, h) do { _Pragma("unroll") for (int n = 0; n < 2; ++n) _Pragma("unroll") for (int k = 0; k < 2; ++k) dst[n][k] = *(const PG8_LAS bf16x8*)(lds + PG8_SB(b, h) + boff + n * 2048 + k * 1024); } while (0)
#define PG8_MMA(ai, bj, At, Bt) do { __builtin_amdgcn_s_setprio(1); _Pragma("unroll") for (int m = 0; m < 4; ++m) _Pragma("unroll") for (int n = 0; n < 2; ++n) _Pragma("unroll") for (int k = 0; k < 2; ++k) \
        acc[ai][bj][m][n] = __builtin_amdgcn_mfma_f32_16x16x32_bf16(Bt[n][k], At[m][k], acc[ai][bj][m][n], 0, 0, 0); __builtin_amdgcn_s_setprio(0); } while (0)
#define PG8_WAIT_V(n) asm volatile("s_waitcnt vmcnt(" #n ")" ::: "memory")
#define PG8_WAIT_L(n) asm volatile("s_waitcnt lgkmcnt(" #n ")" ::: "memory")
#define PG8_BAR __builtin_amdgcn_s_barrier()
#define PG8_SCHED __builtin_amdgcn_sched_barrier(0)
    Unit cur, nxt; int ui = 0;
    if (!S.next(0, cur)) return;
    f32x4 acc[2][2][4][2];
#pragma unroll
    for (int a = 0; a < 2; ++a)
#pragma unroll
        for (int b = 0; b < 2; ++b)
#pragma unroll
            for (int m = 0; m < 4; ++m)
#pragma unroll
                for (int n = 0; n < 2; ++n) acc[a][b][m][n] = (f32x4){0.f, 0.f, 0.f, 0.f};
    bf16x8 At[4][2], B0[2][2], B1[2][2];
    const char* cA = (const char*)g.A + (size_t)cur.pm * tstep; const char* cB = (const char*)g.Bt + (size_t)cur.pn * tstep;
    S.a_ready(cur);
    if constexpr (SP2) {
        PG8_STAGE(PG8_SB(0, 0), cB, voffB); PG8_STAGE(PG8_SB(0, 1), cB + hstep, voffB); PG8_STAGE(PG8_SA(0, 0), cA, voffA); PG8_STAGE(PG8_SA(0, 1), cA + hstep, voffA);
        if (wr == 1) PG8_BAR;
        PG8_WAIT_V(2); PG8_BAR;
        PG8_STAGE(PG8_SB(1, 0), cB + kstep, voffB); PG8_STAGE(PG8_SA(1, 0), cA + kstep, voffA); PG8_STAGE(PG8_SB(1, 1), cB + hstep + kstep, voffB);
        PG8_WAIT_V(6); PG8_BAR;
    } else {
        PG8_STAGE(PG8_SB(0, 0), cB, voffB); PG8_STAGE(PG8_SA(0, 0), cA, voffA); PG8_STAGE(PG8_SB(0, 1), cB + hstep, voffB); PG8_STAGE(PG8_SA(0, 1), cA + hstep, voffA);
        if (wr == 1) PG8_BAR;
        PG8_WAIT_V(4); PG8_BAR;
        PG8_STAGE(PG8_SB(1, 0), cB + kstep, voffB); PG8_STAGE(PG8_SA(1, 0), cA + kstep, voffA); PG8_STAGE(PG8_SB(1, 1), cB + hstep + kstep, voffB);
        PG8_WAIT_V(6); PG8_BAR;
    }
    for (;;) {
        const bool has_next = S.next(ui + 1, nxt);
        const char* nA = has_next ? (const char*)g.A + (size_t)nxt.pm * tstep : cA; const char* nB = has_next ? (const char*)g.Bt + (size_t)nxt.pn * tstep : cB;
        for (int t = 0; t < nt; t += 2) {
            if constexpr (Epi::HAS_MID) { if (t == (nt >> 1)) E.mid(acc, cur, wr, wc, fr, fq); }
            const bool last = (t == nt - 2);
            const char* a1 = cA + (size_t)(t + 1) * kstep;
            const char* a2 = last ? nA : cA + (size_t)(t + 2) * kstep; const char* b2 = last ? nB : cB + (size_t)(t + 2) * kstep;
            const char* a3 = a2 + kstep; const char* b3 = b2 + kstep;
            if (last && has_next) S.a_ready(nxt);
            if constexpr (SP2) {
            PG8_LDB(B0, 0, 0); PG8_LDB(B1, 0, 1); PG8_SCHED; PG8_LDA(At, 0, 0); PG8_STAGE(PG8_SA(1, 1), a1 + hstep, voffA);
            PG8_WAIT_V(8); PG8_WAIT_L(0); PG8_BAR; PG8_MMA(0, 0, At, B0); PG8_MMA(0, 1, At, B1); PG8_BAR; PG8_SCHED;
            PG8_LDA(At, 0, 1); PG8_STAGE(PG8_SB(0, 0), b2, voffB); PG8_STAGE(PG8_SB(0, 1), b2 + hstep, voffB); PG8_STAGE(PG8_SA(0, 0), a2, voffA);
            PG8_WAIT_V(8); PG8_WAIT_L(0); PG8_BAR; PG8_MMA(1, 0, At, B0); PG8_MMA(1, 1, At, B1); PG8_BAR; PG8_SCHED;
            PG8_LDB(B0, 1, 0); PG8_LDB(B1, 1, 1); PG8_SCHED; PG8_LDA(At, 1, 0); PG8_STAGE(PG8_SA(0, 1), a2 + hstep, voffA);
            PG8_WAIT_V(8); PG8_WAIT_L(0); PG8_BAR; PG8_MMA(0, 0, At, B0); PG8_MMA(0, 1, At, B1); PG8_BAR; PG8_SCHED;
            PG8_LDA(At, 1, 1); PG8_STAGE(PG8_SB(1, 0), b3, voffB); PG8_STAGE(PG8_SB(1, 1), b3 + hstep, voffB); PG8_STAGE(PG8_SA(1, 0), a3, voffA);
            PG8_WAIT_V(8); PG8_WAIT_L(0); PG8_BAR; PG8_MMA(1, 0, At, B0); PG8_MMA(1, 1, At, B1); PG8_BAR; PG8_SCHED;
            } else {
            PG8_LDB(B0, 0, 0); PG8_SCHED; PG8_LDA(At, 0, 0); PG8_STAGE(PG8_SA(1, 1), a1 + hstep, voffA);
            PG8_WAIT_L(8); PG8_BAR; PG8_WAIT_L(0); PG8_MMA(0, 0, At, B0); PG8_BAR; PG8_SCHED;
            PG8_LDB(B1, 0, 1); PG8_STAGE(PG8_SB(0, 0), b2, voffB);
            PG8_BAR; PG8_WAIT_L(0); PG8_MMA(0, 1, At, B1); PG8_BAR;
            PG8_LDA(At, 0, 1); PG8_STAGE(PG8_SA(0, 0), a2, voffA);
            PG8_BAR; PG8_WAIT_L(0); PG8_MMA(1, 0, At, B0); PG8_BAR; PG8_SCHED;
            PG8_STAGE(PG8_SB(0, 1), b2 + hstep, voffB);
            PG8_WAIT_V(6); PG8_BAR; PG8_MMA(1, 1, At, B1); PG8_BAR;
            PG8_LDB(B0, 1, 0); PG8_SCHED; PG8_LDA(At, 1, 0); PG8_STAGE(PG8_SA(0, 1), a2 + hstep, voffA);
            PG8_WAIT_L(8); PG8_BAR; PG8_WAIT_L(0); PG8_MMA(0, 0, At, B0); PG8_BAR; PG8_SCHED;
            PG8_LDB(B1, 1, 1); PG8_STAGE(PG8_SB(1, 0), b3, voffB);
            PG8_BAR; PG8_WAIT_L(0); PG8_MMA(0, 1, At, B1); PG8_BAR;
            PG8_LDA(At, 1, 1); PG8_STAGE(PG8_SA(1, 0), a3, voffA);
            PG8_BAR; PG8_WAIT_L(0); PG8_MMA(1, 0, At, B0); PG8_BAR; PG8_SCHED;
            PG8_STAGE(PG8_SB(1, 1), b3 + hstep, voffB);
            PG8_WAIT_V(6); PG8_BAR; PG8_MMA(1, 1, At, B1); PG8_BAR;
            }
        }
        if constexpr (ALIGN_EPI) { if (wr == 0) PG8_BAR; }
        if constexpr (!Epi::AFTER_DRAIN) { E(acc, cur, wr, wc, fr, fq); S.done(cur); }
        if (!has_next) break;
#pragma unroll
        for (int a = 0; a < 2; ++a)
#pragma unroll
            for (int b = 0; b < 2; ++b)
#pragma unroll
                for (int m = 0; m < 4; ++m)
#pragma unroll
                    for (int n = 0; n < 2; ++n) acc[a][b][m][n] = (f32x4){0.f, 0.f, 0.f, 0.f};
        cur = nxt; cA = nA; cB = nB; ++ui;
        if constexpr (ALIGN_EPI) { if (wr == 1) PG8_BAR; }
    }
    PG8_WAIT_V(0);
    if constexpr (!ALIGN_EPI) { if (wr == 0) PG8_BAR; }
    PG8_BAR;
    if constexpr (Epi::AFTER_DRAIN) { E.fused(acc, cur, wr, wc, fr, fq, lds, wid, lane); S.done(cur); }
#undef PG8_SA
#undef PG8_SB
#undef PG8_STAGE
#undef PG8_LDA
#undef PG8_LDB
#undef PG8_MMA
#undef PG8_WAIT_V
#undef PG8_WAIT_L
#undef PG8_BAR
#undef PG8_SCHED
}
}

typedef float f32x16 __attribute__((ext_vector_type(16)));
constexpr size_t WS_RST = WS_ST;
constexpr size_t WS_HST = WS_ST + 16 * MiB;
constexpr size_t WS_HD = WS_ST + 48 * MiB;
constexpr size_t OUT_RET = (size_t)MT * D, OUT_HG = OUT_RET + (size_t)16 * 2 * 4 * 128 * 256;

DEVI bf16x8 ldfrag(ldsp base, int stride, int row, int k0, int hh) { return *(const LAS bf16x8*)(base + row * stride + (k0 + 8 * hh) * 2); }
template <int NX> DEVI void mma_nx1(f32x16 (&acc)[NX], ldsp X, int xs, int x0, ldsp Y, int ys, int y0, int ksteps, int r, int hh) {

    for (int s = 0; s < ksteps; ++s) {
        const bf16x8 b = ldfrag(Y, ys, y0 + r, 16 * s, hh);
#pragma unroll
        for (int t = 0; t < NX; ++t) { const bf16x8 a = ldfrag(X, xs, x0 + 32 * t + r, 16 * s, hh); acc[t] = __builtin_amdgcn_mfma_f32_32x32x16_bf16(a, b, acc[t], 0, 0, 0); }
    }
}
template <int NX> DEVI void zero_acc(f32x16 (&acc)[NX]) {
#pragma unroll
    for (int t = 0; t < NX; ++t)
#pragma unroll
        for (int i = 0; i < 16; ++i) acc[t][i] = 0.f;
}
template <int ROWS, int LC> struct NatBuf { u32x4 v[(ROWS << LC) / 512]; };
template <int ROWS, int LC> DEVI void nat_load(NatBuf<ROWS, LC>& b, const bf16_t* src, size_t gstride, int tid) {
#pragma unroll
    for (int k = 0; k < (ROWS << LC) / 512; ++k) { const int u = tid + 512 * k, rr = u >> LC, c = u & ((1 << LC) - 1); b.v[k] = *(const u32x4*)(src + (size_t)rr * gstride + c * 8); }
}
template <int ROWS, int LC> DEVI void nat_store(const NatBuf<ROWS, LC>& b, ldsp dst, int ls, int tid) {
#pragma unroll
    for (int k = 0; k < (ROWS << LC) / 512; ++k) { const int u = tid + 512 * k, rr = u >> LC, c = u & ((1 << LC) - 1); *(LAS u32x4*)(dst + rr * ls + c * 16) = b.v[k]; }
}
template <int T, int NCOL> struct TrBuf { u32x4 v0[(T >> 5) * (NCOL >> 5) / 8], v1[(T >> 5) * (NCOL >> 5) / 8]; };
template <int T, int NCOL> DEVI void tr_load(TrBuf<T, NCOL>& b, const bf16_t* src, size_t gstride, int tid) {
    const int lane = tid & 63, wv = tid >> 6; constexpr int nbj = T >> 5;
#pragma unroll
    for (int k = 0; k < (T >> 5) * (NCOL >> 5) / 8; ++k) { const int blk = wv + 8 * k, bj = blk % nbj, bc = blk / nbj, jp = bj * 16 + (lane & 15), cc = bc * 4 + (lane >> 4);
        b.v0[k] = *(const u32x4*)(src + (size_t)(2 * jp) * gstride + cc * 8); b.v1[k] = *(const u32x4*)(src + (size_t)(2 * jp + 1) * gstride + cc * 8); }
}
template <int T, int NCOL, class F> DEVI void tr_store(const TrBuf<T, NCOL>& b, ldsp dst, int ls, int tid, F scale) {
    const int lane = tid & 63, wv = tid >> 6; constexpr int nbj = T >> 5;
#pragma unroll
    for (int k = 0; k < (T >> 5) * (NCOL >> 5) / 8; ++k) { const int blk = wv + 8 * k, bj = blk % nbj, bc = blk / nbj, jp = bj * 16 + (lane & 15), cc = bc * 4 + (lane >> 4);
        const float s0 = scale(2 * jp), s1 = scale(2 * jp + 1);
#pragma unroll
        for (int q = 0; q < 4; ++q) {
            *(LAS unsigned*)(dst + (cc * 8 + 2 * q) * ls + jp * 4) = pk2(bflo(b.v0[k][q]) * s0, bflo(b.v1[k][q]) * s1);
            *(LAS unsigned*)(dst + (cc * 8 + 2 * q + 1) * ls + jp * 4) = pk2(bfhi(b.v0[k][q]) * s0, bfhi(b.v1[k][q]) * s1);
        } }
}
DEVI float log2_gamma(const P& p, int dir, int h) { const float rd = p.in[14][dir * 4 + h]; return -log2f(1.0f + expf(-rd)); }
DEVI u32x2 pack4(const f32x16& a, int g) { u32x2 w; w.x = pk2(a[4 * g], a[4 * g + 1]); w.y = pk2(a[4 * g + 2], a[4 * g + 3]); return w; }

DEVI void ret_stage_a(const P& p, ldsp lds, int pass, int item, int tid) {
    const int cg = item >> 2, h = item & 3, lane = tid & 63, w = __builtin_amdgcn_readfirstlane(tid >> 6), r = lane & 31, hh = lane >> 5;
    const bf16_t* PR = (const bf16_t*)(p.ws + WS_PROJ) + (size_t)(cg * 128) * NPROJ;
    const float lgf = log2_gamma(p, 0, h), lgb = log2_gamma(p, 1, h);
    ldsp vT = lds, kfT = lds + 69632, kbT = lds + 104448;
    { TrBuf<128, 256> bv; TrBuf<128, 128> bk;
      tr_load(bv, PR + C_RV + h * 256, NPROJ, tid); tr_load(bk, PR + C_RK + h * 128, NPROJ, tid);
      tr_store(bv, vT, 272, tid, [](int) { return 1.0f; });
      tr_store(bk, kfT, 272, tid, [lgf](int j) { return exp2f(lgf * (float)(127 - j)); });
      tr_store(bk, kbT, 272, tid, [lgb](int j) { return exp2f(lgb * (float)j); }); }
    __syncthreads();
#pragma unroll 1
    for (int dir = 0; dir < 2; ++dir) {
        f32x16 acc[4]; zero_acc(acc);
        mma_nx1<4>(acc, dir ? kbT : kfT, 272, 0, vT, 272, 32 * w, 8, r, hh);
        bf16_t* ST = (bf16_t*)(p.ws + WS_RST) + ((size_t)(cg * 4 + h) * 2 + dir) * 32768 + (size_t)(32 * w + r) * 128;
#pragma unroll
        for (int t = 0; t < 4; ++t)
#pragma unroll
            for (int g = 0; g < 4; ++g) *(u32x2*)(ST + 32 * t + 8 * g + 4 * hh) = pack4(acc[t], g);
    }
    __syncthreads();
}
template <int NB> DEVI void ret_b_item(const P& p, int pass, int idx, int nc) {
    const int dkg = idx & 15, e = (idx >> 4) & 255, hd = (idx >> 12) & 7, s = idx >> 15, dir = hd & 1, h = hd >> 1, dk0 = dkg * 8;
    const float cdec = exp2f(log2_gamma(p, dir, h) * 128.0f);
    float S[8];
    if (pass == 0) {
#pragma unroll
        for (int i = 0; i < 8; ++i) S[i] = 0.f;
    } else {
        const float* st = p.in[2] + ((size_t)(((pass - 1) * 2 + s) * 2 + dir) * 4 + h) * 32768;
#pragma unroll
        for (int i = 0; i < 8; ++i) S[i] = st[(dk0 + i) * 256 + e];
    }
    const long cstride = dir ? -(long)(4 * 2 * 32768) : (long)(4 * 2 * 32768);
    bf16_t* q = (bf16_t*)(p.ws + WS_RST) + ((size_t)((s * nc + (dir ? nc - 1 : 0)) * 4 + h) * 2 + dir) * 32768 + e * 128 + dk0;
    for (int c0 = 0; c0 < nc; c0 += NB) {
        u32x4 u[NB];
#pragma unroll
        for (int k = 0; k < NB; ++k) u[k] = *(const u32x4*)(q + (long)k * cstride);
#pragma unroll
        for (int k = 0; k < NB; ++k) {
            u32x4 o; o.x = pk2(S[0], S[1]); o.y = pk2(S[2], S[3]); o.z = pk2(S[4], S[5]); o.w = pk2(S[6], S[7]);
            *(u32x4*)(q + (long)k * cstride) = o;
#pragma unroll
            for (int qq = 0; qq < 4; ++qq) { S[2 * qq] = cdec * S[2 * qq] + bflo(u[k][qq]); S[2 * qq + 1] = cdec * S[2 * qq + 1] + bfhi(u[k][qq]); }
        }
        q += (long)NB * cstride;
    }
    if (pass == 0) {
        float* ns = p.out + OUT_RET + ((size_t)(s * 2 + dir) * 4 + h) * 32768;
#pragma unroll
        for (int i = 0; i < 8; ++i) ns[(dk0 + i) * 256 + e] = S[i];
    }
}
template <int NB> DEVI void hg_b_item(const P& p, int pass, int idx, int nc) {
    const int dkg = idx & 15, e = (idx >> 4) & 127, hd = (idx >> 11) & 15, s = idx >> 15, dir = hd & 1, h = hd >> 1, dk0 = dkg * 8;
    float S[8];
    if (pass == 0) {
#pragma unroll
        for (int i = 0; i < 8; ++i) S[i] = 0.f;
    } else {
        const float* st = p.in[3] + ((size_t)(((pass - 1) * 2 + s) * 2 + dir) * 8 + h) * 16384;
#pragma unroll
        for (int i = 0; i < 8; ++i) S[i] = st[(dk0 + i) * 128 + e];
    }
    const long cs = dir ? -16L : 16L;
    size_t ci = (size_t)((s * nc + (dir ? nc - 1 : 0)) * 8 + h) * 2 + dir;
    for (int c0 = 0; c0 < nc; c0 += NB) {
        u32x4 u[NB]; f32x4 d0[NB], d1[NB];
#pragma unroll
        for (int k = 0; k < NB; ++k) { const size_t cik = ci + (long)k * cs;
            u[k] = *(const u32x4*)((const bf16_t*)(p.ws + WS_HST) + cik * 16384 + e * 128 + dk0);
            const float* dv = (const float*)(p.ws + WS_HD) + cik * 128 + dk0; d0[k] = *(const f32x4*)dv; d1[k] = *(const f32x4*)(dv + 4); }
#pragma unroll
        for (int k = 0; k < NB; ++k) { const size_t cik = ci + (long)k * cs;
            u32x4 o; o.x = pk2(S[0], S[1]); o.y = pk2(S[2], S[3]); o.z = pk2(S[4], S[5]); o.w = pk2(S[6], S[7]);
            *(u32x4*)((bf16_t*)(p.ws + WS_HST) + cik * 16384 + e * 128 + dk0) = o;
#pragma unroll
            for (int qq = 0; qq < 4; ++qq) { const float da = qq < 2 ? d0[k][2 * qq] : d1[k][2 * qq - 4], db = qq < 2 ? d0[k][2 * qq + 1] : d1[k][2 * qq - 3];
                S[2 * qq] = da * S[2 * qq] + bflo(u[k][qq]); S[2 * qq + 1] = db * S[2 * qq + 1] + bfhi(u[k][qq]); }
        }
        ci += (long)NB * cs;
    }
    if (pass == 0) {
        float* ns = p.out + OUT_HG + ((size_t)(s * 2 + dir) * 8 + h) * 16384;
#pragma unroll
        for (int i = 0; i < 8; ++i) ns[(dk0 + i) * 128 + e] = S[i];
    }
}
DEVI void scan_stage_b(const P& p, int pass, int tid, int G) {
    const int nseq = pass == 0 ? 16 : 2, tot_r = nseq * 32768;
    for (int idx = blockIdx.x * 512 + tid; idx < 2 * tot_r; idx += G * 512) {
        if (idx < tot_r) { if (pass == 0) ret_b_item<2>(p, pass, idx, 2); else ret_b_item<8>(p, pass, idx, 16); }
        else { if (pass == 0) hg_b_item<4>(p, pass, idx - tot_r, 4); else hg_b_item<4>(p, pass, idx - tot_r, 32); }
    }
}
DEVI void ret_stage_c(const P& p, ldsp lds, int pass, int item, int tid) {
    const int cg = item >> 2, h = item & 3, lane = tid & 63, w = __builtin_amdgcn_readfirstlane(tid >> 6), r = lane & 31, hh = lane >> 5;
    const int nc = pass == 0 ? 2 : 16, c = cg % nc;
    const bf16_t* PR = (const bf16_t*)(p.ws + WS_PROJ) + (size_t)(cg * 128) * NPROJ;
    const float lgf = log2_gamma(p, 0, h), lgb = log2_gamma(p, 1, h);
    ldsp qL = lds, kP = lds + 34816, vS = lds + 69632; LAS float* red = (LAS float*)(lds + 139264);
    { NatBuf<128, 4> bq, bk; TrBuf<128, 256> bv;
      nat_load(bq, PR + C_RQ + h * 128, NPROJ, tid); nat_load(bk, PR + C_RK + h * 128, NPROJ, tid); tr_load(bv, PR + C_RV + h * 256, NPROJ, tid);
      nat_store(bq, qL, 272, tid); nat_store(bk, kP, 272, tid); tr_store(bv, vS, 272, tid, [](int) { return 1.0f; }); }
    __syncthreads();
    const int ib = w & 3, wh = w >> 2, i = 32 * ib + r;
    {
        f32x16 ap[2]; zero_acc(ap);
        mma_nx1<2>(ap, kP, 272, 64 * wh, qL, 272, 32 * ib, 8, r, hh);
        __syncthreads();
#pragma unroll
        for (int t = 0; t < 2; ++t)
#pragma unroll
            for (int g = 0; g < 4; ++g) {
                float v[4];
#pragma unroll
                for (int e2 = 0; e2 < 4; ++e2) { const int j = 64 * wh + 32 * t + 8 * g + 4 * hh + e2, d = i - j;
                    const float wgt = d > 0 ? exp2f(lgf * (float)d) : (d < 0 ? exp2f(lgb * (float)(-d)) : 2.0f);
                    v[e2] = ap[t][4 * g + e2] * wgt; }
                u32x2 o; o.x = pk2(v[0], v[1]); o.y = pk2(v[2], v[3]);
                *(LAS u32x2*)(kP + i * 272 + (64 * wh + 32 * t + 8 * g + 4 * hh) * 2) = o;
            }
        __syncthreads();
    }
    const bool has0 = pass != 0 || c != 0, has1 = pass != 0 || c != nc - 1;
    const bf16_t* ST0 = (const bf16_t*)(p.ws + WS_RST) + ((size_t)(cg * 4 + h) * 2) * 32768;
    NatBuf<256, 4> bs;
    f32x16 acc[4]; zero_acc(acc);
    mma_nx1<4>(acc, vS, 272, 128 * wh, kP, 272, 32 * ib, 8, r, hh);
    __syncthreads();
    if (has0 || has1) { nat_load(bs, has0 ? ST0 : ST0 + 32768, 128, tid); nat_store(bs, vS, 272, tid); }
    __syncthreads();
    if (has0 || has1) {
        f32x16 tmp[4]; zero_acc(tmp);
        mma_nx1<4>(tmp, vS, 272, 128 * wh, qL, 272, 32 * ib, 8, r, hh);
        const float sc = has0 ? exp2f(lgf * (float)(i + 1)) : exp2f(lgb * (float)(128 - i));
#pragma unroll
        for (int t = 0; t < 4; ++t)
#pragma unroll
            for (int q = 0; q < 16; ++q) acc[t][q] += tmp[t][q] * sc;
    }
    if (has0 && has1) {
        __syncthreads();
        nat_load(bs, ST0 + 32768, 128, tid);
        nat_store(bs, vS, 272, tid);
        __syncthreads();
        f32x16 tmp[4]; zero_acc(tmp);
        mma_nx1<4>(tmp, vS, 272, 128 * wh, qL, 272, 32 * ib, 8, r, hh);
        const float sc = exp2f(lgb * (float)(128 - i));
#pragma unroll
        for (int t = 0; t < 4; ++t)
#pragma unroll
            for (int q = 0; q < 16; ++q) acc[t][q] += tmp[t][q] * sc;
    }
    float ss = 0.f;
#pragma unroll
    for (int t = 0; t < 4; ++t)
#pragma unroll
        for (int q = 0; q < 16; ++q) ss += acc[t][q] * acc[t][q];
    ss += __shfl_xor(ss, 32);
    if (hh == 0) red[wh * 128 + i] = ss;
    __syncthreads();
    const float rstd = rsqrtf((red[i] + red[128 + i]) * (1.0f / 256.0f) + EPS);
    const bf16_t* rg = PR + (size_t)i * NPROJ + C_RG + h * 256 + 128 * wh;
    bf16_t* O = (bf16_t*)(p.ws + WS_ORET) + (size_t)(pass * PASS_ROWS + cg * 128 + i) * 1024 + h * 256 + 128 * wh;
#pragma unroll
    for (int t = 0; t < 4; ++t)
#pragma unroll
        for (int g = 0; g < 4; ++g) { const int e = 32 * t + 8 * g + 4 * hh; const u32x2 gv = *(const u32x2*)(rg + e);
            u32x2 o; o.x = pk2(acc[t][4 * g] * rstd * bflo(gv.x), acc[t][4 * g + 1] * rstd * bfhi(gv.x)); o.y = pk2(acc[t][4 * g + 2] * rstd * bflo(gv.y), acc[t][4 * g + 3] * rstd * bfhi(gv.y));
            *(u32x2*)(O + e) = o; }
    __syncthreads();
}

DEVI void hg_stage_a(const P& p, ldsp lds, int pass, int item, int tid) {
    const int cg = item >> 3, h = item & 7, lane = tid & 63, w = __builtin_amdgcn_readfirstlane(tid >> 6), r = lane & 31, hh = lane >> 5;
    const bf16_t* PR = (const bf16_t*)(p.ws + WS_PROJ) + (size_t)(cg * 64) * NPROJ;
    ldsp graw = lds, vT = lds + 34816, kT = lds + 53248;
    { NatBuf<64, 4> bf, bb; TrBuf<64, 128> bv;
      nat_load(bf, PR + C_GF + h * 128, NPROJ, tid); nat_load(bb, PR + C_GB + h * 128, NPROJ, tid); tr_load(bv, PR + C_HI + h * 128, NPROJ, tid);
      nat_store(bf, graw, 272, tid); nat_store(bb, graw + 17408, 272, tid); tr_store(bv, vT, 144, tid, [](int) { return 1.0f; }); }
    __syncthreads();
    if (tid < 256) {
        const int dir = tid >> 7, dk = tid & 127;
        const LAS bf16_t* g = (const LAS bf16_t*)(graw + dir * 17408) + dk;
        ldsp kd = kT + dir * 18432 + dk * 144;
        float run = 0.f;
        if (dir == 0) {
#pragma unroll 1
            for (int jg = 7; jg >= 0; --jg) {
                float v[8];
#pragma unroll
                for (int jj = 7; jj >= 0; --jj) { const float gv = bf2f(g[(8 * jg + jj) * 136]); v[jj] = (1.0f - __expf(gv)) * __expf(run); run += gv; }
                u32x4 o; o.x = pk2(v[0], v[1]); o.y = pk2(v[2], v[3]); o.z = pk2(v[4], v[5]); o.w = pk2(v[6], v[7]);
                *(LAS u32x4*)(kd + jg * 16) = o;
            }
        } else {
#pragma unroll 1
            for (int jg = 0; jg < 8; ++jg) {
                float v[8];
#pragma unroll
                for (int jj = 0; jj < 8; ++jj) { const float gv = bf2f(g[(8 * jg + jj) * 136]); v[jj] = (1.0f - __expf(gv)) * __expf(run); run += gv; }
                u32x4 o; o.x = pk2(v[0], v[1]); o.y = pk2(v[2], v[3]); o.z = pk2(v[4], v[5]); o.w = pk2(v[6], v[7]);
                *(LAS u32x4*)(kd + jg * 16) = o;
            }
        }
        ((float*)(p.ws + WS_HD))[((size_t)(cg * 8 + h) * 2 + dir) * 128 + dk] = __expf(run);
    }
    __syncthreads();
#pragma unroll 1
    for (int dir = 0; dir < 2; ++dir) {
        f32x16 acc[2]; zero_acc(acc);
        mma_nx1<2>(acc, kT + dir * 18432, 144, 64 * (w >> 2), vT, 144, 32 * (w & 3), 4, r, hh);
        bf16_t* ST = (bf16_t*)(p.ws + WS_HST) + ((size_t)(cg * 8 + h) * 2 + dir) * 16384 + (size_t)(32 * (w & 3) + r) * 128 + 64 * (w >> 2);
#pragma unroll
        for (int t = 0; t < 2; ++t)
#pragma unroll
            for (int g = 0; g < 4; ++g) *(u32x2*)(ST + 32 * t + 8 * g + 4 * hh) = pack4(acc[t], g);
    }
    __syncthreads();
}
DEVI void hg_stage_c(const P& p, ldsp lds, int pass, int item, int tid) {
    const int cg = item >> 3, h = item & 7, lane = tid & 63, w = __builtin_amdgcn_readfirstlane(tid >> 6), r = lane & 31, hh = lane >> 5;
    const int nc = pass == 0 ? 4 : 32, c = cg % nc;
    const bool hasF = pass != 0 || c != 0, hasB = pass != 0 || c != nc - 1;
    const bf16_t* PR = (const bf16_t*)(p.ws + WS_PROJ) + (size_t)(cg * 64) * NPROJ;
    ldsp raw = lds, img = lds + 69632, vT = lds + 139264; LAS float* ref = (LAS float*)(lds + 157696); LAS float* red = (LAS float*)(lds + 158720);
    { NatBuf<64, 4> bf, bb, bq; TrBuf<64, 128> bv;
      nat_load(bf, PR + C_GF + h * 128, NPROJ, tid); nat_load(bb, PR + C_GB + h * 128, NPROJ, tid); nat_load(bq, PR + C_HQ + h * 128, NPROJ, tid); tr_load(bv, PR + C_HI + h * 128, NPROJ, tid);
      nat_store(bf, raw, 272, tid); nat_store(bb, raw + 17408, 272, tid); nat_store(bq, raw + 34816, 272, tid); tr_store(bv, vT, 144, tid, [](int) { return 1.0f; }); }
    __syncthreads();
    if (tid < 256) {
        const int dir = tid >> 7, dk = tid & 127;
        const LAS bf16_t* g = (const LAS bf16_t*)(raw + dir * 17408) + dk;
        const LAS bf16_t* qr = (const LAS bf16_t*)(raw + 34816) + dk;
        LAS bf16_t* qi = (LAS bf16_t*)(img + dir * 34816) + dk; LAS bf16_t* ki = (LAS bf16_t*)(img + dir * 34816 + 17408) + dk;
        float d = 0.f;
#pragma unroll 4
        for (int t = 0; t < 32; ++t) { const int j = dir == 0 ? 31 - t : 32 + t; const float gv = bf2f(g[j * 136]);
            const float qv = bf2f(qr[j * 136]), kv = 1.0f - __expf(gv);
            qi[j * 136] = (bf16_t)f2bf(qv * __expf(d)); ki[j * 136] = (bf16_t)f2bf(kv * __expf(-d)); d -= gv; }
        ref[dir * 128 + dk] = __expf(-d);
        d = 0.f;
#pragma unroll 4
        for (int t = 0; t < 32; ++t) { const int j = dir == 0 ? 32 + t : 31 - t; const float gv = bf2f(g[j * 136]);
            d += gv;
            const float qv = bf2f(qr[j * 136]), kv = 1.0f - __expf(gv);
            qi[j * 136] = (bf16_t)f2bf(qv * __expf(d)); ki[j * 136] = (bf16_t)f2bf(kv * __expf(-d)); }
    }
    __syncthreads();
    ldsp qF = img, kF = img + 17408, qB = img + 34816, kB = img + 52224, Pm = kF;
    f32x16 af[1], ab[1];
    if (w < 4) {
        zero_acc(af); zero_acc(ab);
        mma_nx1<1>(af, kF, 272, 32 * (w >> 1), qF, 272, 32 * (w & 1), 8, r, hh);
        mma_nx1<1>(ab, kB, 272, 32 * (w >> 1), qB, 272, 32 * (w & 1), 8, r, hh);
    } else {
        const int t2 = tid - 256;
#pragma unroll 1
        for (int dir = 0; dir < 2; ++dir) {
            if (dir == 0 ? !hasF : !hasB) continue;
            const bf16_t* ST = (const bf16_t*)(p.ws + WS_HST) + ((size_t)(cg * 8 + h) * 2 + dir) * 16384;
            for (int u = t2; u < 2048; u += 256) { const int e = u >> 4, ch = u & 15;
                const u32x4 v = *(const u32x4*)(ST + e * 128 + ch * 8);
                const LAS float* rf = ref + dir * 128 + ch * 8;
                u32x4 o;
#pragma unroll
                for (int q = 0; q < 4; ++q) o[q] = pk2(bflo(v[q]) * rf[2 * q], bfhi(v[q]) * rf[2 * q + 1]);
                *(LAS u32x4*)(raw + dir * 34816 + e * 272 + ch * 16) = o; }
        }
    }
    __syncthreads();
    if (w < 4) {
        const int i = 32 * (w & 1) + r;
#pragma unroll
        for (int g = 0; g < 4; ++g) { float v[4];
#pragma unroll
            for (int e2 = 0; e2 < 4; ++e2) { const int j = 32 * (w >> 1) + 8 * g + 4 * hh + e2; v[e2] = (j <= i ? af[0][4 * g + e2] : 0.f) + (j >= i ? ab[0][4 * g + e2] : 0.f); }
            u32x2 o; o.x = pk2(v[0], v[1]); o.y = pk2(v[2], v[3]);
            *(LAS u32x2*)(Pm + i * 144 + (32 * (w >> 1) + 8 * g + 4 * hh) * 2) = o; }
    }
    __syncthreads();
    const int eb = w >> 1, ib = w & 1, i = 32 * ib + r;
    f32x16 acc[1]; zero_acc(acc);
    mma_nx1<1>(acc, vT, 144, 32 * eb, Pm, 144, 32 * ib, 4, r, hh);
    if (hasF) mma_nx1<1>(acc, raw, 272, 32 * eb, qF, 272, 32 * ib, 8, r, hh);
    if (hasB) mma_nx1<1>(acc, raw + 34816, 272, 32 * eb, qB, 272, 32 * ib, 8, r, hh);
    float ss = 0.f;
#pragma unroll
    for (int q = 0; q < 16; ++q) ss += acc[0][q] * acc[0][q];
    ss += __shfl_xor(ss, 32);
    if (hh == 0) red[eb * 64 + i] = ss;
    __syncthreads();
    const float rstd = rsqrtf((red[i] + red[64 + i] + red[128 + i] + red[192 + i]) * (1.0f / 128.0f) + EPS);
    const bf16_t* og = PR + (size_t)i * NPROJ + C_HOG + h * 128 + 32 * eb;
    const float* nw = p.in[16] + h * 128 + 32 * eb;
    bf16_t* O = (bf16_t*)(p.ws + WS_OHG) + (size_t)(pass * PASS_ROWS + cg * 64 + i) * 1024 + h * 128 + 32 * eb;
#pragma unroll
    for (int g = 0; g < 4; ++g) { const int e = 8 * g + 4 * hh; const u32x2 gv = *(const u32x2*)(og + e); const f32x4 n4 = *(const f32x4*)(nw + e);
        u32x2 o; o.x = pk2(acc[0][4 * g] * rstd * n4[0] * bflo(gv.x), acc[0][4 * g + 1] * rstd * n4[1] * bfhi(gv.x));
        o.y = pk2(acc[0][4 * g + 2] * rstd * n4[2] * bflo(gv.y), acc[0][4 * g + 3] * rstd * n4[3] * bfhi(gv.y));
        *(u32x2*)(O + e) = o; }
    __syncthreads();
}
DEVI int scan_nitems(int b, int G) { return G == 256 ? (b < 128 ? 2 : 3) : (640 - b + G - 1) / G; }
DEVI int scan_item(int b, int G, int k) { return G == 256 ? (b < 128 ? (k == 0 ? b : 128 + b) : 256 + (b - 128) * 3 + k) : b + k * G; }
#undef SCAN_A
#undef SCAN_B
#undef SCAN_C
#define SCAN_A { int tid = threadIdx.x; asm volatile("" : "+v"(tid)); const int n_ = scan_nitems(blockIdx.x, G); \
    for (int k_ = 0; k_ < n_; ++k_) { const int it_ = scan_item(blockIdx.x, G, k_); int t2_ = tid; asm volatile("" : "+v"(t2_)); if (it_ < 128) ret_stage_a(p, lds, pass, it_, t2_); else hg_stage_a(p, lds, pass, it_ - 128, t2_); } }
#define SCAN_B { int tid = threadIdx.x; asm volatile("" : "+v"(tid)); scan_stage_b(p, pass, tid, G); }
#define SCAN_C { int tid = threadIdx.x; asm volatile("" : "+v"(tid)); const int n_ = scan_nitems(blockIdx.x, G); \
    for (int k_ = 0; k_ < n_; ++k_) { const int it_ = scan_item(blockIdx.x, G, k_); int t2_ = tid; asm volatile("" : "+v"(t2_)); if (it_ < 128) ret_stage_c(p, lds, pass, it_, t2_); else hg_stage_c(p, lds, pass, it_ - 128, t2_); } }

constexpr int NWAVES = 8;
constexpr int LDS_BYTES = 163840;


DEVI float wave_sum(float v) {
#pragma unroll
    for (int o = 1; o < 64; o <<= 1) v += __shfl_xor(v, o);
    return v;
}

DEVI int map_row(int mode, int n) {
    if (mode == 1) { const int s = n >= 2816 ? 1 : 0, j = n - s * 2816; return 256 * (j >> 7) + 128 * s + (j & 127); }
    if (mode == 2) { if (n >= 1024) return n; const int t = n >> 8, q = n & 255, hh = q >> 7, part = (q >> 6) & 1, bj = (q >> 5) & 1, i = q & 31; return 256 * t + 128 * bj + 64 * hh + 32 * part + i; }
    return n;
}
DEVI void transpose_item(const float* __restrict__ W, int ldw, int n_base, bf16_t* __restrict__ WT, int Kdst, int koff, int mode, LAS float* scr, int item, int nblk, int lane) {
    const int kb = item / nblk, nb = item - kb * nblk, k0 = 64 * kb, n0 = 32 * nb;
#pragma unroll 8
    for (int i = 0; i < 32; ++i) { const int kk = 2 * i + (lane >> 5); scr[kk * 33 + (lane & 31)] = W[(size_t)(k0 + kk) * ldw + n_base + n0 + (lane & 31)]; }
    asm volatile("s_waitcnt lgkmcnt(0)" ::: "memory");
    const int c = lane & 7;
#pragma unroll
    for (int j = 0; j < 4; ++j) { const int n = (lane >> 3) + 8 * j; const LAS float* s = scr + (8 * c) * 33 + n;
        u32x4 o; o.x = pk2(s[0 * 33], s[1 * 33]); o.y = pk2(s[2 * 33], s[3 * 33]); o.z = pk2(s[4 * 33], s[5 * 33]); o.w = pk2(s[6 * 33], s[7 * 33]);
        *(u32x4*)(WT + (size_t)map_row(mode, n0 + n) * Kdst + koff + k0 + 8 * c) = o; }
    asm volatile("s_waitcnt lgkmcnt(0)" ::: "memory");
}
constexpr int I13 = 16 * 176, I2 = 44 * 32, IWIN = 16 * 256, IWG = 16 * 64, ISQ = 16 * 32;
constexpr int CV_G0 = I13, CV_G1 = I13 + I2 + I13 + I2, CV_ALL = 2 * I13 + 2 * I2 + IWIN + IWG + 3 * ISQ;
DEVI void convert_items(const P& p, ldsp lds, int lane, int wave, int first, int last, int worker, int nworkers) {
    LAS float* scr = (LAS float*)(lds + 32768 + wave * 8704);
    unsigned char* ws = p.ws;
    for (int it = first + worker * NWAVES + wave; it < last; it += nworkers * NWAVES) {
        int r = it;
        if (r < I13) { transpose_item(p.in[9], 5632, 0, (bf16_t*)(ws + WS_W13A), 1024, 0, 1, scr, r, 176, lane); continue; } r -= I13;
        if (r < I2) { transpose_item(p.in[10], 1024, 0, (bf16_t*)(ws + WS_W2A), 2816, 0, 0, scr, r, 32, lane); continue; } r -= I2;
        if (r < I13) { transpose_item(p.in[11], 5632, 0, (bf16_t*)(ws + WS_W13B), 1024, 0, 1, scr, r, 176, lane); continue; } r -= I13;
        if (r < I2) { transpose_item(p.in[12], 1024, 0, (bf16_t*)(ws + WS_W2B), 2816, 0, 0, scr, r, 32, lane); continue; } r -= I2;
        if (r < IWIN) { transpose_item(p.in[13], WIN_N, 0, (bf16_t*)(ws + WS_WIN), 1024, 0, 2, scr, r, 256, lane); continue; } r -= IWIN;
        if (r < IWG) { transpose_item(p.in[13], WIN_N, W_GR, (bf16_t*)(ws + WS_WG), 1024, 0, 0, scr, r, 64, lane); continue; } r -= IWG;
        if (r < ISQ) { transpose_item(p.in[17], 1024, 0, (bf16_t*)(ws + WS_WR), 1024, 0, 0, scr, r, 32, lane); continue; } r -= ISQ;
        if (r < ISQ) { transpose_item(p.in[18], 1024, 0, (bf16_t*)(ws + WS_WH), 1024, 0, 0, scr, r, 32, lane); continue; } r -= ISQ;
        transpose_item(p.in[19], 1024, 0, (bf16_t*)(ws + WS_WO), 1024, 0, 0, scr, r, 32, lane);
    }
}
DEVI void phase_prologue(const P& p, ldsp lds, int tid, int lane, int wave, int G) {
    if ((int)blockIdx.x < 144) {
        LAS float* sc = (LAS float*)lds;
        LAS float* red = sc + 5 * 1024;
        for (int i = tid; i < 5 * 1024; i += 512) { const int r = i >> 10, k = i & 1023; const float v = r == 0 ? p.in[5][k] : p.in[4][(r - 1) * 1024 + k]; sc[i] = siluf_(v); }
        __syncthreads();
        const int col = blockIdx.x * 64 + lane;
        const float* W = p.in[6];
        float a0 = 0.f, a1 = 0.f, a2 = 0.f, a3 = 0.f, a4 = 0.f;
#pragma unroll 8
        for (int kk = 0; kk < 128; ++kk) { const int k = wave * 128 + kk; const float w = W[(size_t)k * NMOD + col];
            a0 += sc[k] * w; a1 += sc[1024 + k] * w; a2 += sc[2048 + k] * w; a3 += sc[3072 + k] * w; a4 += sc[4096 + k] * w; }
        red[(wave * 5 + 0) * 64 + lane] = a0; red[(wave * 5 + 1) * 64 + lane] = a1; red[(wave * 5 + 2) * 64 + lane] = a2; red[(wave * 5 + 3) * 64 + lane] = a3; red[(wave * 5 + 4) * 64 + lane] = a4;
        __syncthreads();
        if (tid < 320) { const int r = tid >> 6, l = tid & 63; float s = 0.f;
#pragma unroll
            for (int w = 0; w < 8; ++w) s += red[(w * 5 + r) * 64 + l];
            const int cc = blockIdx.x * 64 + l;
            ((float*)(p.ws + WS_MOD))[r * NMOD + cc] = s + p.in[7][cc]; }
        __syncthreads();
    }
    if ((int)blockIdx.x == G - 1) {
        for (int i = tid; i < 2048; i += 512) {
            const int d = i >> 10, k = i & 1023;
            const float l0 = p.in[15][(d * 2 + 0) * 1024 + k], l1 = p.in[15][(d * 2 + 1) * 1024 + k];
            ((float*)(p.ws + WS_LB))[i] = 1.0f / (1.0f + expf(l1 - l0));
            const int pos = i >> 5, fi = i & 31;
            const double inv = exp(-(double)fi / 32.0 * log(10000.0));
            const float angf = (float)pos * (float)inv;
            double a = (double)angf; const double twopi = 6.283185307179586476925;
            a -= twopi * rint(a / twopi);
            double s = 0.0, c = 0.0, a2 = a * a, tc = 1.0, ts = a;
            for (int n = 0; n < 14; ++n) { c += tc; s += ts; tc *= -a2 / ((2 * n + 1) * (2 * n + 2)); ts *= -a2 / ((2 * n + 2) * (2 * n + 3)); }
            float* rt = (float*)(p.ws + WS_ROPE); rt[i * 2] = (float)c; rt[i * 2 + 1] = (float)s;
        }
    }
    convert_items(p, lds, lane, wave, 0, CV_G0, blockIdx.x, G);
}

DEVI void phase_modnorm(const P& p, int which, int lane, int wave, int G) {
    const int gw = blockIdx.x * NWAVES + wave, NGW = G * NWAVES;
    for (int m = gw; m < MT; m += NGW) {
        const float* xr = which == 0 ? (m < MP ? p.in[0] + (size_t)m * D : p.in[1] + (size_t)(m - MP) * D) : p.out + (size_t)m * D;
        f32x4 v[4]; float ss = 0.f;
#pragma unroll
        for (int j = 0; j < 4; ++j) { v[j] = *(const f32x4*)(xr + 4 * lane + 256 * j); ss += (v[j][0] * v[j][0] + v[j][1] * v[j][1]) + (v[j][2] * v[j][2] + v[j][3] * v[j][3]); }
        const float rstd = rsqrtf(wave_sum(ss) * (1.0f / D) + EPS);
        if (which == 3) {
            float* o = p.out + (size_t)m * D;
#pragma unroll
            for (int j = 0; j < 4; ++j) { const int c = 4 * lane + 256 * j; const f32x4 w = *(const f32x4*)(p.in[20] + c); *(f32x4*)(o + c) = v[j] * rstd * w; }
        } else {
            const float* nw = p.in[8] + which * D;
            const float* mod = (const float*)(p.ws + WS_MOD) + (size_t)mod_row(m) * NMOD;
            const float* sh = mod + (which * 3) * D; const float* sc = mod + (which * 3 + 1) * D;
            bf16_t* h = (bf16_t*)(p.ws + WS_H) + (size_t)m * D;
#pragma unroll
            for (int j = 0; j < 4; ++j) { const int c = 4 * lane + 256 * j;
                const f32x4 w = *(const f32x4*)(nw + c), s4 = *(const f32x4*)(sc + c), h4 = *(const f32x4*)(sh + c);
                const f32x4 y = v[j] * rstd * w * (s4 + 1.0f) + h4;
                u32x2 o; o.x = pk2(y[0], y[1]); o.y = pk2(y[2], y[3]); *(u32x2*)(h + c) = o; }
        }
    }
}

typedef GAS unsigned gu32;
#define RLX_AGENT __ATOMIC_RELAXED, __HIP_MEMORY_SCOPE_AGENT
constexpr size_t WS_BAR = 256 * 1024;
#define XB_TMO      128
#define XB_XCNT(j)  (256  + 64 * (j))
#define XB_XSUB(j)  (1280 + 64 * (j))
#define XB_XGEN(j)  (2304 + 64 * (j))
#define XB_TOP      3328
#define XB_TOPGEN   3392
#define XCD_BAR_WORDS 3456
#define XB_SPIN_CAP (1u << 18)

__device__ __forceinline__ unsigned xb_ld(unsigned* p)              { return __hip_atomic_load(p, __ATOMIC_RELAXED, __HIP_MEMORY_SCOPE_AGENT); }
__device__ __forceinline__ unsigned xb_add(unsigned* p, unsigned v) { return __hip_atomic_fetch_add(p, v, __ATOMIC_RELAXED, __HIP_MEMORY_SCOPE_AGENT); }
__device__ __forceinline__ unsigned xb_xcc_id() { return (unsigned)__builtin_amdgcn_s_getreg((3 << 11) | 20) & 0xFu; }
#define XB_SPIN(cond, bar) do { unsigned _sp = 0; while (cond) { __builtin_amdgcn_s_sleep(1); \
    if ((++_sp & 255u) == 0u) { if (xb_ld(&(bar)[XB_TMO])) break; if (_sp > XB_SPIN_CAP) { atomicAdd(&(bar)[XB_TMO], 1u); break; } } } } while (0)

struct XcdBarrier {
    unsigned* bar; unsigned x;
    volatile LAS unsigned* st;
};

__device__ __forceinline__ XcdBarrier xcd_barrier_post(unsigned* bar, volatile LAS unsigned* st) {
    XcdBarrier b; b.bar = bar; b.x = xb_xcc_id(); b.st = st;
    if (threadIdx.x == 0) (void)xb_add(&bar[XB_XCNT(b.x)], 1u);
    return b;
}
__device__ __forceinline__ void xcd_barrier_complete(unsigned* bar, unsigned x, unsigned& nloc, unsigned& nx) {
    const unsigned G = gridDim.x * gridDim.y * gridDim.z;
    unsigned sum, cnt, mine, sp = 0u;
    for (;;) {
        sum = 0u; cnt = 0u; mine = 0u;
#pragma unroll
        for (unsigned j = 0; j < 16; ++j) { const unsigned c = xb_ld(&bar[XB_XCNT(j)]); sum += c; cnt += (c > 0u) ? 1u : 0u; mine = (j == x) ? c : mine; }
        if (sum == G) break;
        __builtin_amdgcn_s_sleep(1);
        if ((++sp & 255u) == 0u) { if (xb_ld(&bar[XB_TMO])) break; if (sp > XB_SPIN_CAP) { atomicAdd(&bar[XB_TMO], 1u); break; } }
    }
    nloc = mine > 0u ? mine : 1u; nx = cnt > 0u ? cnt : 1u;
}

__device__ __forceinline__ void xcd_barrier(const XcdBarrier& b) {
    asm volatile("s_waitcnt vmcnt(0)" ::: "memory");
    __syncthreads();
    if (threadIdx.x == 0) {
        unsigned* bar = b.bar;
        __builtin_amdgcn_s_waitcnt(0);
        unsigned nloc = b.st[0], nx = b.st[1];
        if (nloc == 0u) { xcd_barrier_complete(bar, b.x, nloc, nx); b.st[0] = nloc; b.st[1] = nx; }
        const unsigned old = xb_add(&bar[XB_XSUB(b.x)], 1u);
        const unsigned gen = old / nloc;
        if (old + 1u == (gen + 1u) * nloc) {
            __builtin_amdgcn_fence(__ATOMIC_RELEASE, "agent");
            asm volatile("s_waitcnt vmcnt(0)" ::: "memory");
            const unsigned og = xb_add(&bar[XB_TOP], 1u);
            const unsigned tg = og / nx;
            if (og + 1u == (tg + 1u) * nx) xb_add(&bar[XB_TOPGEN], 1u);
            else XB_SPIN(xb_ld(&bar[XB_TOPGEN]) == tg, bar);
            __builtin_amdgcn_fence(__ATOMIC_ACQUIRE, "agent");
            xb_add(&bar[XB_XGEN(b.x)], 1u);
            asm volatile("s_waitcnt vmcnt(0)" ::: "memory");
        } else {
            XB_SPIN(xb_ld(&bar[XB_XGEN(b.x)]) == gen, bar);
            __builtin_amdgcn_fence(__ATOMIC_ACQUIRE, "agent");
            asm volatile("s_waitcnt vmcnt(0)" ::: "memory");
        }
    }
    __syncthreads();
}

#ifndef PHMASK
#define PHMASK 0xffff
#endif
#define PH(k) if (p.lo <= (k) && (k) < p.hi)
#define SYNC(k) do { if (p.lo <= (k) && (k) + 1 < p.hi) { if ((k) == 0) { asm volatile("s_waitcnt vmcnt(0) lgkmcnt(0)" ::: "memory"); cg::this_grid().sync(); } else xcd_barrier(bar); } } while (0)
#define GEMM_UP(WOFF) do { pg8::Gemm g{(const bf16_t*)(ws + WS_H), (const bf16_t*)(ws + (WOFF)), MT, 2 * FF, D}; \
    pg8::StaticOrder S; S.init(MT, 2 * FF, G, (int)blockIdx.x); pg8::EpiSwiglu E{(bf16_t*)(ws + WS_PROJ)}; \
    pg8::gemm_phase<pg8::EpiSwiglu, pg8::StaticOrder, true, true>(lds, g, S, E); } while (0)
#define GEMM_RES(AOFF, WOFF, KK, XP, XS, GIDX, SCL) do { pg8::Gemm g{(const bf16_t*)(ws + (AOFF)), (const bf16_t*)(ws + (WOFF)), MT, D, (KK)}; \
    pg8::StaticOrder S; S.init(MT, D, G, (int)blockIdx.x); pg8::EpiResid E{(XP), (XS), p.out, (const float*)(ws + WS_MOD), (GIDX), (SCL)}; \
    pg8::gemm_phase<pg8::EpiResid, pg8::StaticOrder, true, true>(lds, g, S, E); } while (0)

__global__ void __launch_bounds__(NWAVES * 64, 2) mk(P p) {
    extern __shared__ __attribute__((aligned(16))) unsigned char lds_raw[];
    ldsp lds = (ldsp)lds_raw;
    const int G = gridDim.x;
    unsigned char* ws = p.ws;
    volatile LAS unsigned* bst = (volatile LAS unsigned*)(lds + LDS_BYTES - 16);
    if (threadIdx.x < 2) bst[threadIdx.x] = 0u;
    __syncthreads();
    const XcdBarrier bar = xcd_barrier_post((unsigned*)(ws + WS_BAR), bst);
#define TIDS int tid = threadIdx.x; asm volatile("" : "+v"(tid)); const int lane = tid & 63, wave = __builtin_amdgcn_readfirstlane(tid >> 6); (void)lane; (void)wave;
    PH(0) { if (PHMASK & 1) { TIDS phase_prologue(p, lds, tid, lane, wave, G); } } SYNC(0);
    PH(1) { if (PHMASK & 2) { TIDS phase_modnorm(p, 0, lane, wave, G); } } SYNC(1);
    PH(2) { if (PHMASK & 4) GEMM_UP(WS_W13A);
        { const int idle0 = (MT / 256) * (2 * FF / 256) - 4 * G;
          if (G == 256 && (int)blockIdx.x >= idle0) { TIDS convert_items(p, lds, lane, wave, CV_G0, CV_G1, blockIdx.x - idle0, G - idle0); }
          else if (G != 256) { TIDS convert_items(p, lds, lane, wave, CV_G0, CV_G1, blockIdx.x, G); } } } SYNC(2);
    PH(3) { if (PHMASK & 8) GEMM_RES(WS_PROJ, WS_W2A, FF, p.in[0], p.in[1], 2, 0.5f);
        { const int idle0 = (MT / 256) * (D / 256);
          if (G == 256 && (int)blockIdx.x >= idle0) { TIDS convert_items(p, lds, lane, wave, CV_G1, CV_ALL, blockIdx.x - idle0, G - idle0); }
          else if (G != 256) { TIDS convert_items(p, lds, lane, wave, CV_G1, CV_ALL, blockIdx.x, G); } } } SYNC(3);
    PH(4) { if (PHMASK & 2) { TIDS phase_modnorm(p, 1, lane, wave, G); } } SYNC(4);
    for (int pass = 0; pass < 3; ++pass) {
        const int b = 5 + 4 * pass;
        PH(b) { if (PHMASK & 16) {
            pg8::Gemm g{(const bf16_t*)(ws + WS_H) + (size_t)pass * PASS_ROWS * D, (const bf16_t*)(ws + WS_WIN), PASS_ROWS, NPROJ, D};
            pg8::StaticOrder S; S.init(PASS_ROWS, NPROJ, G, (int)blockIdx.x);
            pg8::EpiWin E{(bf16_t*)(ws + WS_PROJ), (const float*)(ws + WS_LB), (const float*)(ws + WS_ROPE), pass};
            pg8::gemm_phase<pg8::EpiWin, pg8::StaticOrder, true, true>(lds, g, S, E); } } SYNC(b);
        PH(b + 1) { SCAN_A } SYNC(b + 1);
        PH(b + 2) { SCAN_B } SYNC(b + 2);
        PH(b + 3) { SCAN_C } SYNC(b + 3);
    }
    PH(17) { if (PHMASK & 32) {
        pg8::Gemm g{(const bf16_t*)(ws + WS_H), (const bf16_t*)(ws + WS_WG), MT, 2048, D};
        pg8::StaticOrder S; S.init(MT, 2048, G, (int)blockIdx.x);
        pg8::EpiGates E{(bf16_t*)(ws + WS_PROJ)};
        pg8::gemm_phase<pg8::EpiGates, pg8::StaticOrder, true, true>(lds, g, S, E); } } SYNC(17);
    PH(18) { if (PHMASK & 64) {
        { pg8::Gemm g{(const bf16_t*)(ws + WS_ORET), (const bf16_t*)(ws + WS_WR), MT, D, D};
          pg8::StaticOrder S; S.init(MT, D, G, (int)blockIdx.x);
          pg8::EpiMergeA E{(const bf16_t*)(ws + WS_PROJ), (float*)(ws + WS_ST)};
          pg8::gemm_phase<pg8::EpiMergeA, pg8::StaticOrder, true, true>(lds, g, S, E); }
        { pg8::Gemm g{(const bf16_t*)(ws + WS_OHG), (const bf16_t*)(ws + WS_WH), MT, D, D};
          pg8::StaticOrder S; S.init(MT, D, G, (int)blockIdx.x);
          pg8::EpiMergeB E{(const bf16_t*)(ws + WS_PROJ), (const float*)(ws + WS_ST), (bf16_t*)(ws + WS_H)};
          pg8::gemm_phase<pg8::EpiMergeB, pg8::StaticOrder, true, true>(lds, g, S, E); } } } SYNC(18);
    PH(19) { if (PHMASK & 8) GEMM_RES(WS_H, WS_WO, D, p.out, p.out + (size_t)MP * D, 5, 1.0f); } SYNC(19);
    PH(20) { if (PHMASK & 2) { TIDS phase_modnorm(p, 2, lane, wave, G); } } SYNC(20);
    PH(21) { if (PHMASK & 4) GEMM_UP(WS_W13B); } SYNC(21);
    PH(22) { if (PHMASK & 8) GEMM_RES(WS_PROJ, WS_W2B, FF, p.out, p.out + (size_t)MP * D, 8, 0.5f); } SYNC(22);
    PH(23) { if (PHMASK & 2) { TIDS phase_modnorm(p, 3, lane, wave, G); } }
}

static int g_grid = 0;
static void launch_mk(const P& base, int lo, int hi, hipStream_t stream, bool coop) {
    P p = base; p.lo = lo; p.hi = hi;
    if (coop) { void* args[] = {&p}; hipError_t e = hipLaunchCooperativeKernel((void*)mk, dim3(g_grid), dim3(NWAVES * 64), args, LDS_BYTES, stream);
        if (e != hipSuccess) fprintf(stderr, "cooperative launch failed: %s (grid %d)\n", hipGetErrorString(e), g_grid); }
    else hipLaunchKernelGGL(mk, dim3(g_grid), dim3(NWAVES * 64), LDS_BYTES, stream, p);
}

extern "C" void kernel_launch(void* const* d_in, const int* in_sizes, int n_in, void* d_out, int out_size, void* d_ws, size_t ws_size, hipStream_t stream) {
    if (g_grid == 0) {
        int dev = 0, cus = 0, per_cu = 0;
        hipGetDevice(&dev);
        hipDeviceGetAttribute(&cus, hipDeviceAttributeMultiprocessorCount, dev);
        hipFuncSetAttribute((const void*)mk, hipFuncAttributeMaxDynamicSharedMemorySize, LDS_BYTES);
        hipOccupancyMaxActiveBlocksPerMultiprocessor(&per_cu, (const void*)mk, NWAVES * 64, LDS_BYTES);
        if (per_cu < 1) per_cu = 1;
        g_grid = cus * per_cu;
        (void)hipGetLastError();
    }
    P p{};
    for (int i = 0; i < 21; ++i) p.in[i] = (const float*)d_in[i];
    p.out = (float*)d_out; p.ws = (unsigned char*)d_ws;
#if HYBRID
    launch_mk(p, 0, 5, stream, true);
    for (int pass = 0; pass < 3; ++pass) {
        const int nseq = pass == 0 ? 16 : 2;
        launch_mk(p, 5 + 4 * pass, 9 + 4 * pass, stream, true);
#if HYBRID == 2 || HYBRID == 4
        k_ret_scan<<<nseq * 8, 256, 0, stream>>>(p, pass);
        k_ret_fin<<<PASS_ROWS * 4 / 4, 256, 0, stream>>>(p, pass);
#endif
#if HYBRID == 3 || HYBRID == 4
        k_hg_scan<<<nseq * 16, 128, 0, stream>>>(p, pass);
        k_hg_fin<<<PASS_ROWS * 8 / 4, 256, 0, stream>>>(p, pass);
#endif
    }
    launch_mk(p, 17, 24, stream, true);
#else
    (void)hipMemsetAsync((char*)d_ws + WS_BAR, 0, 16384, stream);
    launch_mk(p, 0, 24, stream, true);
#endif
}
```

```cpp
#include <hip/hip_runtime.h>
#include <hip/hip_cooperative_groups.h>
#include <cstdint>
#include <cstdio>
namespace cg = cooperative_groups;

#define DEVI __device__ __forceinline__
#define LAS __attribute__((address_space(3)))
#define GAS __attribute__((address_space(1)))

constexpr int D = 1024, MP = 4096, MS = 8192, MT = 12288, FF = 2816, NPROJ = 8192, NMOD = 9 * 1024;
constexpr int PASS_ROWS = 4096;
constexpr int PROJ_LD = 8192 + 64;
constexpr float EPS = 1e-6f;
constexpr int C_RQ = 0, C_RK = 512, C_RV = 1024, C_RG = 2048, C_HQ = 3072, C_GF = 4096, C_GB = 5120, C_HI = 6144, C_HOG = 7168;
constexpr int W_GR = 8192, WIN_N = 10240;
constexpr float QK_SCALE = 0.08838834764831845f;

constexpr size_t MiB = 1u << 20;
constexpr size_t WS_MOD = 0;
constexpr size_t WS_LB = 192 * 1024;
constexpr size_t WS_ROPE = 200 * 1024;
constexpr size_t WS_W13A = 1 * MiB, WS_W2A = 12 * MiB, WS_W13B = 18 * MiB, WS_W2B = 29 * MiB;
constexpr size_t WS_WIN = 35 * MiB, WS_WG = 51 * MiB, WS_WR = 55 * MiB, WS_WH = 57 * MiB, WS_WO = 59 * MiB;
constexpr size_t WS_H = 61 * MiB;
constexpr size_t WS_ORET = 85 * MiB, WS_OHG = 109 * MiB;
constexpr size_t WS_PROJ = 133 * MiB;
constexpr size_t WS_ST = 199 * MiB;

typedef unsigned short bf16_t;
typedef float f32x4 __attribute__((ext_vector_type(4)));
typedef float f32x2 __attribute__((ext_vector_type(2)));
typedef unsigned u32x4 __attribute__((ext_vector_type(4)));
typedef unsigned u32x2 __attribute__((ext_vector_type(2)));
typedef short bf16x8 __attribute__((ext_vector_type(8)));

struct P {
    const float* in[21];
    float* out;
    unsigned char* ws;
    int lo, hi;
};

DEVI float bf2f(bf16_t v) { return __uint_as_float(((unsigned)v) << 16); }
DEVI unsigned f2bf(float f) { unsigned u = __float_as_uint(f); return (u + 0x7fffu + ((u >> 16) & 1u)) >> 16; }
typedef __bf16 bf16x2_t __attribute__((ext_vector_type(2)));
DEVI unsigned pk2(float lo, float hi) { bf16x2_t v; v[0] = (__bf16)lo; v[1] = (__bf16)hi; return __builtin_bit_cast(unsigned, v); }
DEVI float bflo(unsigned w) { return __uint_as_float(w << 16); }
DEVI float bfhi(unsigned w) { return __uint_as_float(w & 0xffff0000u); }
DEVI float sigmoidf_(float x) { return 1.0f / (1.0f + __expf(-x)); }
DEVI float siluf_(float x) { return x / (1.0f + __expf(-x)); }
DEVI int mod_row(int m) { return m < MP ? 0 : 1 + ((m - MP) >> 11); }

typedef LAS unsigned char* ldsp;
#define HYBRID 0
namespace pg8 {
#define PG8_LAS __attribute__((address_space(3)))
typedef unsigned short bf16_t;
typedef short bf16x8 __attribute__((ext_vector_type(8)));
typedef float f32x4 __attribute__((ext_vector_type(4)));
typedef unsigned u32x4 __attribute__((ext_vector_type(4)));
constexpr int BM = 256, BK = 64, HALF = 128, HTB = HALF * BK * 2  , STAGE_BYTES = 8 * HTB, NXCD = 8, WGM = 8;

__host__ __device__ __forceinline__ int lds_byte(int r, int c) { const int st = (r >> 4) * 2 + (c >> 5), rr = r & 15, cc = c & 31, ob = rr * 64 + cc * 2; return st * 1024 + (ob ^ (((ob >> 9) & 1) << 5)); }
__host__ __device__ __forceinline__ void stage_rc(int b, int& R, int& C) { const int st = b / 1024, sb = b % 1024, swz = sb ^ (((sb >> 9) & 1) << 5); R = (st >> 1) * 16 + swz / 64; C = (st & 1) * 32 + (swz % 64) / 2; }
__host__ __device__ __forceinline__ int perm32(int rho) { const int n = rho >> 4, i = rho & 15; return 8 * (i >> 2) + 4 * n + (i & 3); }

struct Unit { int pm, pn; };
struct Gemm { const bf16_t* A; const bf16_t* Bt; int M, N, K; };

struct StaticOrder {
    int nM, nN, nwg, G, c;
    __host__ __device__ void init(int M, int N, int G_, int c_) { nM = M / BM; nN = N / BM; nwg = nM * nN; G = G_; c = c_; }
    __host__ __device__ bool next(int i, Unit& u) const {
        const long L = (long)i * G + c; if (L >= nwg) return false;
        int wgid = (int)L; { const int q = nwg / NXCD, r = nwg % NXCD, xcd = wgid % NXCD, off = wgid / NXCD; wgid = (xcd < r ? xcd * (q + 1) : r * (q + 1) + (xcd - r) * q) + off; }
        const int nig = WGM * nN, gid = wgid / nig, fm = gid * WGM, gsz = (nM - fm) < WGM ? (nM - fm) : WGM;
        u.pm = fm + ((wgid % nig) % gsz); u.pn = (wgid % nig) / gsz; return true;
    }
    __device__ __forceinline__ void a_ready(const Unit&) const {}
    __device__ __forceinline__ void done(const Unit&) const {}
};


struct EpiSwiglu {
    static constexpr bool PERM = true, AFTER_DRAIN = false, HAS_MID = false;
    bf16_t* act;
    __device__ __forceinline__ void mid(f32x4 (&)[2][2][4][2], const Unit&, int, int, int, int) const {}
    __device__ __forceinline__ void operator()(const f32x4 (&acc)[2][2][4][2], const Unit& u, int wr, int wc, int fr, int fq) const {
        const int row0 = u.pm * BM + wr * 64 + fr, col0 = u.pn * 128 + wc * 32 + 8 * fq;
#pragma unroll
        for (int ai = 0; ai < 2; ++ai)
#pragma unroll
            for (int m = 0; m < 4; ++m) {
                float v[8];
#pragma unroll
                for (int n = 0; n < 2; ++n)
#pragma unroll
                    for (int e = 0; e < 4; ++e) { const float a = acc[ai][0][m][n][e], b = acc[ai][1][m][n][e]; v[n * 4 + e] = a * __builtin_amdgcn_rcpf(1.0f + __expf(-a)) * b; }
                u32x4 w; w.x = ::pk2(v[0], v[1]); w.y = ::pk2(v[2], v[3]); w.z = ::pk2(v[4], v[5]); w.w = ::pk2(v[6], v[7]);
                *(u32x4*)(act + (size_t)(row0 + ai * HALF + m * 16) * 2816 + col0) = w;
            }
    }
};
struct EpiResid {
    static constexpr bool PERM = false, AFTER_DRAIN = false, HAS_MID = false;
    const float* xp; const float* xs; float* out; const float* mod; int gidx; float scale;
    __device__ __forceinline__ void mid(f32x4 (&)[2][2][4][2], const Unit&, int, int, int, int) const {}
    __device__ __forceinline__ void operator()(const f32x4 (&acc)[2][2][4][2], const Unit& u, int wr, int wc, int fr, int fq) const {
        const int rowt = u.pm * BM, row0 = rowt + wr * 64 + fr, col0 = u.pn * BM + wc * 32 + 4 * fq;
        const float* gate = mod + (size_t)(rowt < 4096 ? 0 : 1 + ((rowt - 4096) >> 11)) * 9216 + gidx * 1024;
        const float* xb = rowt < 4096 ? xp : xs - (size_t)4096 * 1024;
#pragma unroll
        for (int bj = 0; bj < 2; ++bj)
#pragma unroll
            for (int n = 0; n < 2; ++n) {
                const int c = col0 + bj * HALF + n * 16;
                const f32x4 g4 = *(const f32x4*)(gate + c) * scale;
#pragma unroll
                for (int ai = 0; ai < 2; ++ai)
#pragma unroll
                    for (int m = 0; m < 4; ++m) { const size_t off = (size_t)(row0 + ai * HALF + m * 16) * 1024 + c;
                        const f32x4 xin = *(const f32x4*)(xb + off); *(f32x4*)(out + off) = xin + g4 * acc[ai][bj][m][n]; }
            }
    }
};
struct EpiWin {
    static constexpr bool PERM = true, AFTER_DRAIN = false, HAS_MID = false;
    bf16_t* PR; const float* lb; const float* rope; int pass;
    __device__ __forceinline__ void mid(f32x4 (&)[2][2][4][2], const Unit&, int, int, int, int) const {}
    __device__ __forceinline__ void operator()(const f32x4 (&acc)[2][2][4][2], const Unit& u, int wr, int wc, int fr, int fq) const {
        const int row0 = u.pm * BM + wr * 64 + fr;
        if (u.pn < 4) {
            const int hh = wc >> 1, part = wc & 1, i0 = 8 * fq;
            const float sc = u.pn >= 2 ? 0.08838834764831845f : 1.0f;
#pragma unroll
            for (int ai = 0; ai < 2; ++ai)
#pragma unroll
                for (int m = 0; m < 4; ++m) {
                    const int row = row0 + ai * HALF + m * 16;
                    float cs[8], sn[8];
                    if (pass > 0) { const int t = row & 2047; const int pos = part ? (t & 63) : (t >> 6);
                        const f32x4* rp = (const f32x4*)(rope + (size_t)(pos * 32 + i0) * 2);
#pragma unroll
                        for (int q = 0; q < 4; ++q) { const f32x4 r4 = rp[q]; cs[2 * q] = r4[0]; sn[2 * q] = r4[1]; cs[2 * q + 1] = r4[2]; sn[2 * q + 1] = r4[3]; } }
                    else {
#pragma unroll
                        for (int q = 0; q < 8; ++q) { cs[q] = 1.0f; sn[q] = 0.0f; } }
                    float y1[8], y2[8];
#pragma unroll
                    for (int e = 0; e < 8; ++e) { const float x1 = acc[ai][0][m][e >> 2][e & 3], x2 = acc[ai][1][m][e >> 2][e & 3];
                        y1[e] = (x1 * cs[e] - x2 * sn[e]) * sc; y2[e] = (x2 * cs[e] + x1 * sn[e]) * sc; }
                    bf16_t* dst = PR + (size_t)row * PROJ_LD + u.pn * BM + 128 * hh + 64 * part + i0;
                    u32x4 w; w.x = ::pk2(y1[0], y1[1]); w.y = ::pk2(y1[2], y1[3]); w.z = ::pk2(y1[4], y1[5]); w.w = ::pk2(y1[6], y1[7]);
                    *(u32x4*)dst = w;
                    w.x = ::pk2(y2[0], y2[1]); w.y = ::pk2(y2[2], y2[3]); w.z = ::pk2(y2[4], y2[5]); w.w = ::pk2(y2[6], y2[7]);
                    *(u32x4*)(dst + 32) = w;
                }
        } else {
            const int seg = u.pn >> 2;
            if (seg == 1 || seg == 6) plain<0>(acc, u, wr, wc, fr, fq);
            else if (seg == 2 || seg == 7) plain<1>(acc, u, wr, wc, fr, fq);
            else if (seg == 3) plain<2>(acc, u, wr, wc, fr, fq);
            else plain<3>(acc, u, wr, wc, fr, fq);
        }
    }
    template <int MODE> __device__ __forceinline__ void plain(const f32x4 (&acc)[2][2][4][2], const Unit& u, int wr, int wc, int fr, int fq) const {
        const int row0 = u.pm * BM + wr * 64 + fr;
#pragma unroll
        for (int bj = 0; bj < 2; ++bj) {
            const int col = u.pn * BM + bj * HALF + wc * 32 + 8 * fq;
            float l[8];
            if (MODE == 3) {
                const f32x4 l0 = *(const f32x4*)(lb + (col - 4096)), l1 = *(const f32x4*)(lb + (col - 4096) + 4);
#pragma unroll
                for (int e = 0; e < 4; ++e) { l[e] = l0[e]; l[4 + e] = l1[e]; }
            }
#pragma unroll
            for (int ai = 0; ai < 2; ++ai)
#pragma unroll
                for (int m = 0; m < 4; ++m) {
                    float v[8];
#pragma unroll
                    for (int e = 0; e < 8; ++e) { float x = acc[ai][bj][m][e >> 2][e & 3];
                        if (MODE == 1) x = x * __builtin_amdgcn_rcpf(1.0f + __expf(-x));
                        else if (MODE == 2) x = x * 0.08838834764831845f * __builtin_amdgcn_rcpf(1.0f + __expf(-x));
                        else if (MODE == 3) x = __logf(l[e] + (1.0f - l[e]) * __builtin_amdgcn_rcpf(1.0f + __expf(-x)));
                        v[e] = x; }
                    u32x4 w; w.x = ::pk2(v[0], v[1]); w.y = ::pk2(v[2], v[3]); w.z = ::pk2(v[4], v[5]); w.w = ::pk2(v[6], v[7]);
                    *(u32x4*)(PR + (size_t)(row0 + ai * HALF + m * 16) * PROJ_LD + col) = w;
                }
        }
    }
};
struct EpiGates {
    static constexpr bool PERM = true, AFTER_DRAIN = false, HAS_MID = false;
    bf16_t* G;
    __device__ __forceinline__ void mid(f32x4 (&)[2][2][4][2], const Unit&, int, int, int, int) const {}
    __device__ __forceinline__ void operator()(const f32x4 (&acc)[2][2][4][2], const Unit& u, int wr, int wc, int fr, int fq) const {
        const int row0 = u.pm * BM + wr * 64 + fr;
#pragma unroll
        for (int bj = 0; bj < 2; ++bj) {
            const int col = u.pn * BM + bj * HALF + wc * 32 + 8 * fq;
#pragma unroll
            for (int ai = 0; ai < 2; ++ai)
#pragma unroll
                for (int m = 0; m < 4; ++m) {
                    float v[8];
#pragma unroll
                    for (int e = 0; e < 8; ++e) v[e] = __builtin_amdgcn_rcpf(1.0f + __expf(-acc[ai][bj][m][e >> 2][e & 3]));
                    u32x4 w; w.x = ::pk2(v[0], v[1]); w.y = ::pk2(v[2], v[3]); w.z = ::pk2(v[4], v[5]); w.w = ::pk2(v[6], v[7]);
                    *(u32x4*)(G + (size_t)(row0 + ai * HALF + m * 16) * 2048 + col) = w;
                }
        }
    }
};
struct EpiMergeA {
    static constexpr bool PERM = false, AFTER_DRAIN = false, HAS_MID = false;
    const bf16_t* G; float* T;
    __device__ __forceinline__ void mid(f32x4 (&)[2][2][4][2], const Unit&, int, int, int, int) const {}
    __device__ __forceinline__ void operator()(const f32x4 (&acc)[2][2][4][2], const Unit& u, int wr, int wc, int fr, int fq) const {
        const int row0 = u.pm * BM + wr * 64 + fr, col0 = u.pn * BM + wc * 32 + 4 * fq;
#pragma unroll
        for (int ai = 0; ai < 2; ++ai)
#pragma unroll
            for (int m = 0; m < 4; ++m) { const size_t row = (size_t)(row0 + ai * HALF + m * 16);
#pragma unroll
                for (int bj = 0; bj < 2; ++bj)
#pragma unroll
                    for (int n = 0; n < 2; ++n) { const int c = col0 + bj * HALF + n * 16;
                        const u32x2 g = *(const u32x2*)(G + row * 2048 + c);
                        f32x4 v = acc[ai][bj][m][n]; v[0] *= ::bflo(g.x); v[1] *= ::bfhi(g.x); v[2] *= ::bflo(g.y); v[3] *= ::bfhi(g.y);
                        *(f32x4*)(T + row * 1024 + c) = v; } }
    }
};
struct EpiMergeB {
    static constexpr bool PERM = false, AFTER_DRAIN = false, HAS_MID = false;
    const bf16_t* G; const float* T; bf16_t* Mg;
    __device__ __forceinline__ void mid(f32x4 (&)[2][2][4][2], const Unit&, int, int, int, int) const {}
    __device__ __forceinline__ void operator()(const f32x4 (&acc)[2][2][4][2], const Unit& u, int wr, int wc, int fr, int fq) const {
        const int row0 = u.pm * BM + wr * 64 + fr, col0 = u.pn * BM + wc * 32 + 4 * fq;
#pragma unroll
        for (int ai = 0; ai < 2; ++ai)
#pragma unroll
            for (int m = 0; m < 4; ++m) { const size_t row = (size_t)(row0 + ai * HALF + m * 16);
#pragma unroll
                for (int bj = 0; bj < 2; ++bj)
#pragma unroll
                    for (int n = 0; n < 2; ++n) { const int c = col0 + bj * HALF + n * 16;
                        const u32x2 g = *(const u32x2*)(G + row * 2048 + 1024 + c);
                        f32x4 v = acc[ai][bj][m][n]; const f32x4 t = *(const f32x4*)(T + row * 1024 + c);
                        v[0] = v[0] * ::bflo(g.x) + t[0]; v[1] = v[1] * ::bfhi(g.x) + t[1]; v[2] = v[2] * ::bflo(g.y) + t[2]; v[3] = v[3] * ::bfhi(g.y) + t[3];
                        u32x2 w; w.x = ::pk2(v[0], v[1]); w.y = ::pk2(v[2], v[3]);
                        *(u32x2*)(Mg + row * 1024 + c) = w; } }
    }
};

template <class Epi, class Sched, bool ALIGN_EPI = false, bool SP2 = false>
__device__ __forceinline__ void gemm_phase(PG8_LAS unsigned char* lds, const Gemm g, const Sched& S, const Epi& E) {
    int tid_ = threadIdx.x; asm volatile("" : "+v"(tid_)); const int tid = tid_, wid = __builtin_amdgcn_readfirstlane(tid >> 6), lane = tid & 63, wr = wid >> 2, wc = wid & 3, fr = lane & 15, fq = lane >> 4;
    const int K = g.K, nt = K / BK;
    unsigned voffA[2], voffB[2];
#pragma unroll
    for (int i = 0; i < 2; ++i) { int R, C; stage_rc(tid * 16 + i * 8192, R, C); const int Rb = Epi::PERM ? ((R & ~31) + perm32(R & 31)) : R;
        voffA[i] = (unsigned)(R * K + C) * 2u; voffB[i] = (unsigned)(Rb * K + C) * 2u; }
    const size_t kstep = (size_t)(BK * 2);
    const size_t hstep = (size_t)HALF * K * 2;
    const size_t tstep = 2 * hstep;
    const unsigned ldsw = (unsigned)wid * 1024u;
    const int aoff = lds_byte(wr * 64 + fr, fq * 8), boff = lds_byte(wc * 32 + fr, fq * 8);
#define PG8_SA(b, h) (((b) * 2 + (h)) * HTB)
#define PG8_SB(b, h) ((4 + (b) * 2 + (h)) * HTB)
#define PG8_STAGE(bufoff, gbase, voff) do { _Pragma("unroll") for (int _i = 0; _i < 2; ++_i) \
        __builtin_amdgcn_global_load_lds((const unsigned*)((const char*)(gbase) + (voff)[_i]), (PG8_LAS unsigned*)(lds + (bufoff) + ldsw + _i * 8192), 16, 0, 0); } while (0)
#define PG8_LDA(dst, b, h) do { _Pragma("unroll") for (int m = 0; m < 4; ++m) _Pragma("unroll") for (int k = 0; k < 2; ++k) dst[m][k] = *(const PG8_LAS bf16x8*)(lds + PG8_SA(b, h) + aoff + m * 2048 + k * 1024); } while (0)
#define PG8_LDB(dst, b, h) do { _Pragma("unroll") for (int n = 0; n < 2; ++n) _Pragma("unroll") for (int k = 0; k < 2; ++k) dst[n][k] = *(const PG8_LAS bf16x8*)(lds + PG8_SB(b, h) + boff + n * 2048 + k * 1024); } while (0)
#define PG8_MMA(ai, bj, At, Bt) do { __builtin_amdgcn_s_setprio(1); _Pragma("unroll") for (int m = 0; m < 4; ++m) _Pragma("unroll") for (int n = 0; n < 2; ++n) _Pragma("unroll") for (int k = 0; k < 2; ++k) \
        acc[ai][bj][m][n] = __builtin_amdgcn_mfma_f32_16x16x32_bf16(Bt[n][k], At[m][k], acc[ai][bj][m][n], 0, 0, 0); __builtin_amdgcn_s_setprio(0); } while (0)
#define PG8_WAIT_V(n) asm volatile("s_waitcnt vmcnt(" #n ")" ::: "memory")
#define PG8_WAIT_L(n) asm volatile("s_waitcnt lgkmcnt(" #n ")" ::: "memory")
#define PG8_BAR __builtin_amdgcn_s_barrier()
#define PG8_SCHED __builtin_amdgcn_sched_barrier(0)
    Unit cur, nxt; int ui = 0;
    if (!S.next(0, cur)) return;
    f32x4 acc[2][2][4][2];
#pragma unroll
    for (int a = 0; a < 2; ++a)
#pragma unroll
        for (int b = 0; b < 2; ++b)
#pragma unroll
            for (int m = 0; m < 4; ++m)
#pragma unroll
                for (int n = 0; n < 2; ++n) acc[a][b][m][n] = (f32x4){0.f, 0.f, 0.f, 0.f};
    bf16x8 At[4][2], B0[2][2], B1[2][2];
    const char* cA = (const char*)g.A + (size_t)cur.pm * tstep; const char* cB = (const char*)g.Bt + (size_t)cur.pn * tstep;
    S.a_ready(cur);
    if constexpr (SP2) {
        PG8_STAGE(PG8_SB(0, 0), cB, voffB); PG8_STAGE(PG8_SB(0, 1), cB + hstep, voffB); PG8_STAGE(PG8_SA(0, 0), cA, voffA); PG8_STAGE(PG8_SA(0, 1), cA + hstep, voffA);
        if (wr == 1) PG8_BAR;
        PG8_WAIT_V(2); PG8_BAR;
        PG8_STAGE(PG8_SB(1, 0), cB + kstep, voffB); PG8_STAGE(PG8_SA(1, 0), cA + kstep, voffA); PG8_STAGE(PG8_SB(1, 1), cB + hstep + kstep, voffB);
        PG8_WAIT_V(6); PG8_BAR;
    } else {
        PG8_STAGE(PG8_SB(0, 0), cB, voffB); PG8_STAGE(PG8_SA(0, 0), cA, voffA); PG8_STAGE(PG8_SB(0, 1), cB + hstep, voffB); PG8_STAGE(PG8_SA(0, 1), cA + hstep, voffA);
        if (wr == 1) PG8_BAR;
        PG8_WAIT_V(4); PG8_BAR;
        PG8_STAGE(PG8_SB(1, 0), cB + kstep, voffB); PG8_STAGE(PG8_SA(1, 0), cA + kstep, voffA); PG8_STAGE(PG8_SB(1, 1), cB + hstep + kstep, voffB);
        PG8_WAIT_V(6); PG8_BAR;
    }
    for (;;) {
        const bool has_next = S.next(ui + 1, nxt);
        const char* nA = has_next ? (const char*)g.A + (size_t)nxt.pm * tstep : cA; const char* nB = has_next ? (const char*)g.Bt + (size_t)nxt.pn * tstep : cB;
        for (int t = 0; t < nt; t += 2) {
            if constexpr (Epi::HAS_MID) { if (t == (nt >> 1)) E.mid(acc, cur, wr, wc, fr, fq); }
            const bool last = (t == nt - 2);
            const char* a1 = cA + (size_t)(t + 1) * kstep;
            const char* a2 = last ? nA : cA + (size_t)(t + 2) * kstep; const char* b2 = last ? nB : cB + (size_t)(t + 2) * kstep;
            const char* a3 = a2 + kstep; const char* b3 = b2 + kstep;
            if (last && has_next) S.a_ready(nxt);
            if constexpr (SP2) {
            PG8_LDB(B0, 0, 0); PG8_LDB(B1, 0, 1); PG8_SCHED; PG8_LDA(At, 0, 0); PG8_STAGE(PG8_SA(1, 1), a1 + hstep, voffA);
            PG8_WAIT_V(8); PG8_WAIT_L(0); PG8_BAR; PG8_MMA(0, 0, At, B0); PG8_MMA(0, 1, At, B1); PG8_BAR; PG8_SCHED;
            PG8_LDA(At, 0, 1); PG8_STAGE(PG8_SB(0, 0), b2, voffB); PG8_STAGE(PG8_SB(0, 1), b2 + hstep, voffB); PG8_STAGE(PG8_SA(0, 0), a2, voffA);
            PG8_WAIT_V(8); PG8_WAIT_L(0); PG8_BAR; PG8_MMA(1, 0, At, B0); PG8_MMA(1, 1, At, B1); PG8_BAR; PG8_SCHED;
            PG8_LDB(B0, 1, 0); PG8_LDB(B1, 1, 1); PG8_SCHED; PG8_LDA(At, 1, 0); PG8_STAGE(PG8_SA(0, 1), a2 + hstep, voffA);
            PG8_WAIT_V(8); PG8_WAIT_L(0); PG8_BAR; PG8_MMA(0, 0, At, B0); PG8_MMA(0, 1, At, B1); PG8_BAR; PG8_SCHED;
            PG8_LDA(At, 1, 1); PG8_STAGE(PG8_SB(1, 0), b3, voffB); PG8_STAGE(PG8_SB(1, 1), b3 + hstep, voffB); PG8_STAGE(PG8_SA(1, 0), a3, voffA);
            PG8_WAIT_V(8); PG8_WAIT_L(0); PG8_BAR; PG8_MMA(1, 0, At, B0); PG8_MMA(1, 1, At, B1); PG8_BAR; PG8_SCHED;
            } else {
            PG8_LDB(B0, 0, 0); PG8_SCHED; PG8_LDA(At, 0, 0); PG8_STAGE(PG8_SA(1, 1), a1 + hstep, voffA);
            PG8_WAIT_L(8); PG8_BAR; PG8_WAIT_L(0); PG8_MMA(0, 0, At, B0); PG8_BAR; PG8_SCHED;
            PG8_LDB(B1, 0, 1); PG8_STAGE(PG8_SB(0, 0), b2, voffB);
            PG8_BAR; PG8_WAIT_L(0); PG8_MMA(0, 1, At, B1); PG8_BAR;
            PG8_LDA(At, 0, 1); PG8_STAGE(PG8_SA(0, 0), a2, voffA);
            PG8_BAR; PG8_WAIT_L(0); PG8_MMA(1, 0, At, B0); PG8_BAR; PG8_SCHED;
            PG8_STAGE(PG8_SB(0, 1), b2 + hstep, voffB);
            PG8_WAIT_V(6); PG8_BAR; PG8_MMA(1, 1, At, B1); PG8_BAR;
            PG8_LDB(B0, 1, 0); PG8_SCHED; PG8_LDA(At, 1, 0); PG8_STAGE(PG8_SA(0, 1), a2 + hstep, voffA);
            PG8_WAIT_L(8); PG8_BAR; PG8_WAIT_L(0); PG8_MMA(0, 0, At, B0); PG8_BAR; PG8_SCHED;
            PG8_LDB(B1, 1, 1); PG8_STAGE(PG8_SB(1, 0), b3, voffB);
            PG8_BAR; PG8_WAIT_L(0); PG8_MMA(0, 1, At, B1); PG8_BAR;
            PG8_LDA(At, 1, 1); PG8_STAGE(PG8_SA(1, 0), a3, voffA);
            PG8_BAR; PG8_WAIT_L(0); PG8_MMA(1, 0, At, B0); PG8_BAR; PG8_SCHED;
            PG8_STAGE(PG8_SB(1, 1), b3 + hstep, voffB);
            PG8_WAIT_V(6); PG8_BAR; PG8_MMA(1, 1, At, B1); PG8_BAR;
            }
        }
        if constexpr (ALIGN_EPI) { if (wr == 0) PG8_BAR; }
        if constexpr (!Epi::AFTER_DRAIN) { E(acc, cur, wr, wc, fr, fq); S.done(cur); }
        if (!has_next) break;
#pragma unroll
        for (int a = 0; a < 2; ++a)
#pragma unroll
            for (int b = 0; b < 2; ++b)
#pragma unroll
                for (int m = 0; m < 4; ++m)
#pragma unroll
                    for (int n = 0; n < 2; ++n) acc[a][b][m][n] = (f32x4){0.f, 0.f, 0.f, 0.f};
        cur = nxt; cA = nA; cB = nB; ++ui;
        if constexpr (ALIGN_EPI) { if (wr == 1) PG8_BAR; }
    }
    PG8_WAIT_V(0);
    if constexpr (!ALIGN_EPI) { if (wr == 0) PG8_BAR; }
    PG8_BAR;
    if constexpr (Epi::AFTER_DRAIN) { E.fused(acc, cur, wr, wc, fr, fq, lds, wid, lane); S.done(cur); }
#undef PG8_SA
#undef PG8_SB
#undef PG8_STAGE
#undef PG8_LDA
#undef PG8_LDB
#undef PG8_MMA
#undef PG8_WAIT_V
#undef PG8_WAIT_L
#undef PG8_BAR
#undef PG8_SCHED
}
}

typedef float f32x16 __attribute__((ext_vector_type(16)));
constexpr size_t WS_RST = WS_ST;
constexpr size_t WS_HST = WS_ST + 16 * MiB;
constexpr size_t WS_HD = WS_ST + 48 * MiB;
constexpr size_t OUT_RET = (size_t)MT * D, OUT_HG = OUT_RET + (size_t)16 * 2 * 4 * 128 * 256;

DEVI bf16x8 ldfrag(ldsp base, int stride, int row, int k0, int hh) { return *(const LAS bf16x8*)(base + row * stride + (k0 + 8 * hh) * 2); }
template <int NX> DEVI void mma_nx1(f32x16 (&acc)[NX], ldsp X, int xs, int x0, ldsp Y, int ys, int y0, int ksteps, int r, int hh) {

    for (int s = 0; s < ksteps; ++s) {
        const bf16x8 b = ldfrag(Y, ys, y0 + r, 16 * s, hh);
#pragma unroll
        for (int t = 0; t < NX; ++t) { const bf16x8 a = ldfrag(X, xs, x0 + 32 * t + r, 16 * s, hh); acc[t] = __builtin_amdgcn_mfma_f32_32x32x16_bf16(a, b, acc[t], 0, 0, 0); }
    }
}
template <int NX> DEVI void zero_acc(f32x16 (&acc)[NX]) {
#pragma unroll
    for (int t = 0; t < NX; ++t)
#pragma unroll
        for (int i = 0; i < 16; ++i) acc[t][i] = 0.f;
}
template <int ROWS, int LC> struct NatBuf { u32x4 v[(ROWS << LC) / 512]; };
template <int ROWS, int LC> DEVI void nat_load(NatBuf<ROWS, LC>& b, const bf16_t* src, size_t gstride, int tid) {
#pragma unroll
    for (int k = 0; k < (ROWS << LC) / 512; ++k) { const int u = tid + 512 * k, rr = u >> LC, c = u & ((1 << LC) - 1); b.v[k] = *(const u32x4*)(src + (size_t)rr * gstride + c * 8); }
}
template <int ROWS, int LC> DEVI void nat_store(const NatBuf<ROWS, LC>& b, ldsp dst, int ls, int tid) {
#pragma unroll
    for (int k = 0; k < (ROWS << LC) / 512; ++k) { const int u = tid + 512 * k, rr = u >> LC, c = u & ((1 << LC) - 1); *(LAS u32x4*)(dst + rr * ls + c * 16) = b.v[k]; }
}
template <int T, int NCOL> struct TrBuf { u32x4 v0[(T >> 5) * (NCOL >> 5) / 8], v1[(T >> 5) * (NCOL >> 5) / 8]; };
template <int T, int NCOL> DEVI void tr_load(TrBuf<T, NCOL>& b, const bf16_t* src, size_t gstride, int tid) {
    const int lane = tid & 63, wv = tid >> 6; constexpr int nbj = T >> 5;
#pragma unroll
    for (int k = 0; k < (T >> 5) * (NCOL >> 5) / 8; ++k) { const int blk = wv + 8 * k, bj = blk % nbj, bc = blk / nbj, jp = bj * 16 + (lane & 15), cc = bc * 4 + (lane >> 4);
        b.v0[k] = *(const u32x4*)(src + (size_t)(2 * jp) * gstride + cc * 8); b.v1[k] = *(const u32x4*)(src + (size_t)(2 * jp + 1) * gstride + cc * 8); }
}
template <int T, int NCOL, class F> DEVI void tr_store(const TrBuf<T, NCOL>& b, ldsp dst, int ls, int tid, F scale) {
    const int lane = tid & 63, wv = tid >> 6; constexpr int nbj = T >> 5;
#pragma unroll
    for (int k = 0; k < (T >> 5) * (NCOL >> 5) / 8; ++k) { const int blk = wv + 8 * k, bj = blk % nbj, bc = blk / nbj, jp = bj * 16 + (lane & 15), cc = bc * 4 + (lane >> 4);
        const float s0 = scale(2 * jp), s1 = scale(2 * jp + 1);
#pragma unroll
        for (int q = 0; q < 4; ++q) {
            *(LAS unsigned*)(dst + (cc * 8 + 2 * q) * ls + jp * 4) = pk2(bflo(b.v0[k][q]) * s0, bflo(b.v1[k][q]) * s1);
            *(LAS unsigned*)(dst + (cc * 8 + 2 * q + 1) * ls + jp * 4) = pk2(bfhi(b.v0[k][q]) * s0, bfhi(b.v1[k][q]) * s1);
        } }
}
DEVI float log2_gamma(const P& p, int dir, int h) { const float rd = p.in[14][dir * 4 + h]; return -log2f(1.0f + expf(-rd)); }
DEVI u32x2 pack4(const f32x16& a, int g) { u32x2 w; w.x = pk2(a[4 * g], a[4 * g + 1]); w.y = pk2(a[4 * g + 2], a[4 * g + 3]); return w; }

DEVI void ret_stage_a(const P& p, ldsp lds, int pass, int item, int tid) {
    const int cg = item >> 2, h = item & 3, lane = tid & 63, w = __builtin_amdgcn_readfirstlane(tid >> 6), r = lane & 31, hh = lane >> 5;
    const bf16_t* PR = (const bf16_t*)(p.ws + WS_PROJ) + (size_t)(cg * 128) * PROJ_LD;
    const float lgf = log2_gamma(p, 0, h), lgb = log2_gamma(p, 1, h);
    ldsp vT = lds, kfT = lds + 69632, kbT = lds + 104448;
    { TrBuf<128, 256> bv; TrBuf<128, 128> bk;
      tr_load(bv, PR + C_RV + h * 256, PROJ_LD, tid); tr_load(bk, PR + C_RK + h * 128, PROJ_LD, tid);
      tr_store(bv, vT, 272, tid, [](int) { return 1.0f; });
      tr_store(bk, kfT, 272, tid, [lgf](int j) { return exp2f(lgf * (float)(127 - j)); });
      tr_store(bk, kbT, 272, tid, [lgb](int j) { return exp2f(lgb * (float)j); }); }
    __syncthreads();
#pragma unroll 1
    for (int dir = 0; dir < 2; ++dir) {
        f32x16 acc[4]; zero_acc(acc);
        mma_nx1<4>(acc, dir ? kbT : kfT, 272, 0, vT, 272, 32 * w, 8, r, hh);
        bf16_t* ST = (bf16_t*)(p.ws + WS_RST) + ((size_t)(cg * 4 + h) * 2 + dir) * 32768 + (size_t)(32 * w + r) * 128;
#pragma unroll
        for (int t = 0; t < 4; ++t)
#pragma unroll
            for (int g = 0; g < 4; ++g) *(u32x2*)(ST + 32 * t + 8 * g + 4 * hh) = pack4(acc[t], g);
    }
    __syncthreads();
}
template <int NB> DEVI void ret_b_item(const P& p, int pass, int idx, int nc) {
    const int dkg = idx & 15, e = (idx >> 4) & 255, hd = (idx >> 12) & 7, s = idx >> 15, dir = hd & 1, h = hd >> 1, dk0 = dkg * 8;
    const float cdec = exp2f(log2_gamma(p, dir, h) * 128.0f);
    float S[8];
    if (pass == 0) {
#pragma unroll
        for (int i = 0; i < 8; ++i) S[i] = 0.f;
    } else {
        const float* st = p.in[2] + ((size_t)(((pass - 1) * 2 + s) * 2 + dir) * 4 + h) * 32768;
#pragma unroll
        for (int i = 0; i < 8; ++i) S[i] = st[(dk0 + i) * 256 + e];
    }
    const long cstride = dir ? -(long)(4 * 2 * 32768) : (long)(4 * 2 * 32768);
    bf16_t* q = (bf16_t*)(p.ws + WS_RST) + ((size_t)((s * nc + (dir ? nc - 1 : 0)) * 4 + h) * 2 + dir) * 32768 + e * 128 + dk0;
    for (int c0 = 0; c0 < nc; c0 += NB) {
        u32x4 u[NB];
#pragma unroll
        for (int k = 0; k < NB; ++k) u[k] = *(const u32x4*)(q + (long)k * cstride);
#pragma unroll
        for (int k = 0; k < NB; ++k) {
            u32x4 o; o.x = pk2(S[0], S[1]); o.y = pk2(S[2], S[3]); o.z = pk2(S[4], S[5]); o.w = pk2(S[6], S[7]);
            *(u32x4*)(q + (long)k * cstride) = o;
#pragma unroll
            for (int qq = 0; qq < 4; ++qq) { S[2 * qq] = cdec * S[2 * qq] + bflo(u[k][qq]); S[2 * qq + 1] = cdec * S[2 * qq + 1] + bfhi(u[k][qq]); }
        }
        q += (long)NB * cstride;
    }
    if (pass == 0) {
        float* ns = p.out + OUT_RET + ((size_t)(s * 2 + dir) * 4 + h) * 32768;
#pragma unroll
        for (int i = 0; i < 8; ++i) ns[(dk0 + i) * 256 + e] = S[i];
    }
}
template <int NB> DEVI void hg_b_item(const P& p, int pass, int idx, int nc) {
    const int dkg = idx & 15, e = (idx >> 4) & 127, hd = (idx >> 11) & 15, s = idx >> 15, dir = hd & 1, h = hd >> 1, dk0 = dkg * 8;
    float S[8];
    if (pass == 0) {
#pragma unroll
        for (int i = 0; i < 8; ++i) S[i] = 0.f;
    } else {
        const float* st = p.in[3] + ((size_t)(((pass - 1) * 2 + s) * 2 + dir) * 8 + h) * 16384;
#pragma unroll
        for (int i = 0; i < 8; ++i) S[i] = st[(dk0 + i) * 128 + e];
    }
    const long cs = dir ? -16L : 16L;
    size_t ci = (size_t)((s * nc + (dir ? nc - 1 : 0)) * 8 + h) * 2 + dir;
    for (int c0 = 0; c0 < nc; c0 += NB) {
        u32x4 u[NB]; f32x4 d0[NB], d1[NB];
#pragma unroll
        for (int k = 0; k < NB; ++k) { const size_t cik = ci + (long)k * cs;
            u[k] = *(const u32x4*)((const bf16_t*)(p.ws + WS_HST) + cik * 16384 + e * 128 + dk0);
            const float* dv = (const float*)(p.ws + WS_HD) + cik * 128 + dk0; d0[k] = *(const f32x4*)dv; d1[k] = *(const f32x4*)(dv + 4); }
#pragma unroll
        for (int k = 0; k < NB; ++k) { const size_t cik = ci + (long)k * cs;
            u32x4 o; o.x = pk2(S[0], S[1]); o.y = pk2(S[2], S[3]); o.z = pk2(S[4], S[5]); o.w = pk2(S[6], S[7]);
            *(u32x4*)((bf16_t*)(p.ws + WS_HST) + cik * 16384 + e * 128 + dk0) = o;
#pragma unroll
            for (int qq = 0; qq < 4; ++qq) { const float da = qq < 2 ? d0[k][2 * qq] : d1[k][2 * qq - 4], db = qq < 2 ? d0[k][2 * qq + 1] : d1[k][2 * qq - 3];
                S[2 * qq] = da * S[2 * qq] + bflo(u[k][qq]); S[2 * qq + 1] = db * S[2 * qq + 1] + bfhi(u[k][qq]); }
        }
        ci += (long)NB * cs;
    }
    if (pass == 0) {
        float* ns = p.out + OUT_HG + ((size_t)(s * 2 + dir) * 8 + h) * 16384;
#pragma unroll
        for (int i = 0; i < 8; ++i) ns[(dk0 + i) * 128 + e] = S[i];
    }
}
DEVI void scan_stage_b(const P& p, int pass, int tid, int G) {
    const int nseq = pass == 0 ? 16 : 2, tot_r = nseq * 32768;
    for (int idx = blockIdx.x * 512 + tid; idx < 2 * tot_r; idx += G * 512) {
        if (idx < tot_r) { if (pass == 0) ret_b_item<2>(p, pass, idx, 2); else ret_b_item<8>(p, pass, idx, 16); }
        else { if (pass == 0) hg_b_item<4>(p, pass, idx - tot_r, 4); else hg_b_item<4>(p, pass, idx - tot_r, 32); }
    }
}
DEVI void ret_stage_c(const P& p, ldsp lds, int pass, int item, int tid) {
    const int cg = item >> 2, h = item & 3, lane = tid & 63, w = __builtin_amdgcn_readfirstlane(tid >> 6), r = lane & 31, hh = lane >> 5;
    const int nc = pass == 0 ? 2 : 16, c = cg % nc;
    const bf16_t* PR = (const bf16_t*)(p.ws + WS_PROJ) + (size_t)(cg * 128) * PROJ_LD;
    const float lgf = log2_gamma(p, 0, h), lgb = log2_gamma(p, 1, h);
    ldsp qL = lds, kP = lds + 34816, vS = lds + 69632; LAS float* red = (LAS float*)(lds + 139264);
    { NatBuf<128, 4> bq, bk; TrBuf<128, 256> bv;
      nat_load(bq, PR + C_RQ + h * 128, PROJ_LD, tid); nat_load(bk, PR + C_RK + h * 128, PROJ_LD, tid); tr_load(bv, PR + C_RV + h * 256, PROJ_LD, tid);
      nat_store(bq, qL, 272, tid); nat_store(bk, kP, 272, tid); tr_store(bv, vS, 272, tid, [](int) { return 1.0f; }); }
    __syncthreads();
    const int ib = w & 3, wh = w >> 2, i = 32 * ib + r;
    {
        f32x16 ap[2]; zero_acc(ap);
        mma_nx1<2>(ap, kP, 272, 64 * wh, qL, 272, 32 * ib, 8, r, hh);
        __syncthreads();
#pragma unroll
        for (int t = 0; t < 2; ++t)
#pragma unroll
            for (int g = 0; g < 4; ++g) {
                float v[4];
#pragma unroll
                for (int e2 = 0; e2 < 4; ++e2) { const int j = 64 * wh + 32 * t + 8 * g + 4 * hh + e2, d = i - j;
                    const float wgt = d > 0 ? exp2f(lgf * (float)d) : (d < 0 ? exp2f(lgb * (float)(-d)) : 2.0f);
                    v[e2] = ap[t][4 * g + e2] * wgt; }
                u32x2 o; o.x = pk2(v[0], v[1]); o.y = pk2(v[2], v[3]);
                *(LAS u32x2*)(kP + i * 272 + (64 * wh + 32 * t + 8 * g + 4 * hh) * 2) = o;
            }
        __syncthreads();
    }
    const bool has0 = pass != 0 || c != 0, has1 = pass != 0 || c != nc - 1;
    const bf16_t* ST0 = (const bf16_t*)(p.ws + WS_RST) + ((size_t)(cg * 4 + h) * 2) * 32768;
    NatBuf<256, 4> bs;
    f32x16 acc[4]; zero_acc(acc);
    mma_nx1<4>(acc, vS, 272, 128 * wh, kP, 272, 32 * ib, 8, r, hh);
    __syncthreads();
    if (has0 || has1) { nat_load(bs, has0 ? ST0 : ST0 + 32768, 128, tid); nat_store(bs, vS, 272, tid); }
    __syncthreads();
    if (has0 || has1) {
        f32x16 tmp[4]; zero_acc(tmp);
        mma_nx1<4>(tmp, vS, 272, 128 * wh, qL, 272, 32 * ib, 8, r, hh);
        const float sc = has0 ? exp2f(lgf * (float)(i + 1)) : exp2f(lgb * (float)(128 - i));
#pragma unroll
        for (int t = 0; t < 4; ++t)
#pragma unroll
            for (int q = 0; q < 16; ++q) acc[t][q] += tmp[t][q] * sc;
    }
    if (has0 && has1) {
        __syncthreads();
        nat_load(bs, ST0 + 32768, 128, tid);
        nat_store(bs, vS, 272, tid);
        __syncthreads();
        f32x16 tmp[4]; zero_acc(tmp);
        mma_nx1<4>(tmp, vS, 272, 128 * wh, qL, 272, 32 * ib, 8, r, hh);
        const float sc = exp2f(lgb * (float)(128 - i));
#pragma unroll
        for (int t = 0; t < 4; ++t)
#pragma unroll
            for (int q = 0; q < 16; ++q) acc[t][q] += tmp[t][q] * sc;
    }
    float ss = 0.f;
#pragma unroll
    for (int t = 0; t < 4; ++t)
#pragma unroll
        for (int q = 0; q < 16; ++q) ss += acc[t][q] * acc[t][q];
    ss += __shfl_xor(ss, 32);
    if (hh == 0) red[wh * 128 + i] = ss;
    __syncthreads();
    const float rstd = rsqrtf((red[i] + red[128 + i]) * (1.0f / 256.0f) + EPS);
    const bf16_t* rg = PR + (size_t)i * PROJ_LD + C_RG + h * 256 + 128 * wh;
    bf16_t* O = (bf16_t*)(p.ws + WS_ORET) + (size_t)(pass * PASS_ROWS + cg * 128 + i) * 1024 + h * 256 + 128 * wh;
#pragma unroll
    for (int t = 0; t < 4; ++t)
#pragma unroll
        for (int g = 0; g < 4; ++g) { const int e = 32 * t + 8 * g + 4 * hh; const u32x2 gv = *(const u32x2*)(rg + e);
            u32x2 o; o.x = pk2(acc[t][4 * g] * rstd * bflo(gv.x), acc[t][4 * g + 1] * rstd * bfhi(gv.x)); o.y = pk2(acc[t][4 * g + 2] * rstd * bflo(gv.y), acc[t][4 * g + 3] * rstd * bfhi(gv.y));
            *(u32x2*)(O + e) = o; }
    __syncthreads();
}

DEVI void hg_stage_a(const P& p, ldsp lds, int pass, int item, int tid) {
    const int cg = item >> 3, h = item & 7, lane = tid & 63, w = __builtin_amdgcn_readfirstlane(tid >> 6), r = lane & 31, hh = lane >> 5;
    const bf16_t* PR = (const bf16_t*)(p.ws + WS_PROJ) + (size_t)(cg * 64) * PROJ_LD;
    ldsp graw = lds, vT = lds + 34816, kT = lds + 53248;
    { NatBuf<64, 4> bf, bb; TrBuf<64, 128> bv;
      nat_load(bf, PR + C_GF + h * 128, PROJ_LD, tid); nat_load(bb, PR + C_GB + h * 128, PROJ_LD, tid); tr_load(bv, PR + C_HI + h * 128, PROJ_LD, tid);
      nat_store(bf, graw, 272, tid); nat_store(bb, graw + 17408, 272, tid); tr_store(bv, vT, 144, tid, [](int) { return 1.0f; }); }
    __syncthreads();
    if (tid < 256) {
        const int dir = tid >> 7, dk = tid & 127;
        const LAS bf16_t* g = (const LAS bf16_t*)(graw + dir * 17408) + dk;
        ldsp kd = kT + dir * 18432 + dk * 144;
        float run = 0.f;
        if (dir == 0) {
#pragma unroll 1
            for (int jg = 7; jg >= 0; --jg) {
                float v[8];
#pragma unroll
                for (int jj = 7; jj >= 0; --jj) { const float gv = bf2f(g[(8 * jg + jj) * 136]); v[jj] = (1.0f - __expf(gv)) * __expf(run); run += gv; }
                u32x4 o; o.x = pk2(v[0], v[1]); o.y = pk2(v[2], v[3]); o.z = pk2(v[4], v[5]); o.w = pk2(v[6], v[7]);
                *(LAS u32x4*)(kd + jg * 16) = o;
            }
        } else {
#pragma unroll 1
            for (int jg = 0; jg < 8; ++jg) {
                float v[8];
#pragma unroll
                for (int jj = 0; jj < 8; ++jj) { const float gv = bf2f(g[(8 * jg + jj) * 136]); v[jj] = (1.0f - __expf(gv)) * __expf(run); run += gv; }
                u32x4 o; o.x = pk2(v[0], v[1]); o.y = pk2(v[2], v[3]); o.z = pk2(v[4], v[5]); o.w = pk2(v[6], v[7]);
                *(LAS u32x4*)(kd + jg * 16) = o;
            }
        }
        ((float*)(p.ws + WS_HD))[((size_t)(cg * 8 + h) * 2 + dir) * 128 + dk] = __expf(run);
    }
    __syncthreads();
#pragma unroll 1
    for (int dir = 0; dir < 2; ++dir) {
        f32x16 acc[2]; zero_acc(acc);
        mma_nx1<2>(acc, kT + dir * 18432, 144, 64 * (w >> 2), vT, 144, 32 * (w & 3), 4, r, hh);
        bf16_t* ST = (bf16_t*)(p.ws + WS_HST) + ((size_t)(cg * 8 + h) * 2 + dir) * 16384 + (size_t)(32 * (w & 3) + r) * 128 + 64 * (w >> 2);
#pragma unroll
        for (int t = 0; t < 2; ++t)
#pragma unroll
            for (int g = 0; g < 4; ++g) *(u32x2*)(ST + 32 * t + 8 * g + 4 * hh) = pack4(acc[t], g);
    }
    __syncthreads();
}
DEVI void hg_stage_c(const P& p, ldsp lds, int pass, int item, int tid) {
    const int cg = item >> 3, h = item & 7, lane = tid & 63, w = __builtin_amdgcn_readfirstlane(tid >> 6), r = lane & 31, hh = lane >> 5;
    const int nc = pass == 0 ? 4 : 32, c = cg % nc;
    const bool hasF = pass != 0 || c != 0, hasB = pass != 0 || c != nc - 1;
    const bf16_t* PR = (const bf16_t*)(p.ws + WS_PROJ) + (size_t)(cg * 64) * PROJ_LD;
    ldsp raw = lds, img = lds + 69632, vT = lds + 139264; LAS float* ref = (LAS float*)(lds + 157696); LAS float* red = (LAS float*)(lds + 158720);
    { NatBuf<64, 4> bf, bb, bq; TrBuf<64, 128> bv;
      nat_load(bf, PR + C_GF + h * 128, PROJ_LD, tid); nat_load(bb, PR + C_GB + h * 128, PROJ_LD, tid); nat_load(bq, PR + C_HQ + h * 128, PROJ_LD, tid); tr_load(bv, PR + C_HI + h * 128, PROJ_LD, tid);
      nat_store(bf, raw, 272, tid); nat_store(bb, raw + 17408, 272, tid); nat_store(bq, raw + 34816, 272, tid); tr_store(bv, vT, 144, tid, [](int) { return 1.0f; }); }
    __syncthreads();
    if (tid < 256) {
        const int dir = tid >> 7, dk = tid & 127;
        const LAS bf16_t* g = (const LAS bf16_t*)(raw + dir * 17408) + dk;
        const LAS bf16_t* qr = (const LAS bf16_t*)(raw + 34816) + dk;
        LAS bf16_t* qi = (LAS bf16_t*)(img + dir * 34816) + dk; LAS bf16_t* ki = (LAS bf16_t*)(img + dir * 34816 + 17408) + dk;
        float d = 0.f;
#pragma unroll 4
        for (int t = 0; t < 32; ++t) { const int j = dir == 0 ? 31 - t : 32 + t; const float gv = bf2f(g[j * 136]);
            const float qv = bf2f(qr[j * 136]), kv = 1.0f - __expf(gv);
            qi[j * 136] = (bf16_t)f2bf(qv * __expf(d)); ki[j * 136] = (bf16_t)f2bf(kv * __expf(-d)); d -= gv; }
        ref[dir * 128 + dk] = __expf(-d);
        d = 0.f;
#pragma unroll 4
        for (int t = 0; t < 32; ++t) { const int j = dir == 0 ? 32 + t : 31 - t; const float gv = bf2f(g[j * 136]);
            d += gv;
            const float qv = bf2f(qr[j * 136]), kv = 1.0f - __expf(gv);
            qi[j * 136] = (bf16_t)f2bf(qv * __expf(d)); ki[j * 136] = (bf16_t)f2bf(kv * __expf(-d)); }
    }
    __syncthreads();
    ldsp qF = img, kF = img + 17408, qB = img + 34816, kB = img + 52224, Pm = kF;
    f32x16 af[1], ab[1];
    if (w < 4) {
        zero_acc(af); zero_acc(ab);
        mma_nx1<1>(af, kF, 272, 32 * (w >> 1), qF, 272, 32 * (w & 1), 8, r, hh);
        mma_nx1<1>(ab, kB, 272, 32 * (w >> 1), qB, 272, 32 * (w & 1), 8, r, hh);
    } else {
        const int t2 = tid - 256;
#pragma unroll 1
        for (int dir = 0; dir < 2; ++dir) {
            if (dir == 0 ? !hasF : !hasB) continue;
            const bf16_t* ST = (const bf16_t*)(p.ws + WS_HST) + ((size_t)(cg * 8 + h) * 2 + dir) * 16384;
            for (int u = t2; u < 2048; u += 256) { const int e = u >> 4, ch = u & 15;
                const u32x4 v = *(const u32x4*)(ST + e * 128 + ch * 8);
                const LAS float* rf = ref + dir * 128 + ch * 8;
                u32x4 o;
#pragma unroll
                for (int q = 0; q < 4; ++q) o[q] = pk2(bflo(v[q]) * rf[2 * q], bfhi(v[q]) * rf[2 * q + 1]);
                *(LAS u32x4*)(raw + dir * 34816 + e * 272 + ch * 16) = o; }
        }
    }
    __syncthreads();
    if (w < 4) {
        const int i = 32 * (w & 1) + r;
#pragma unroll
        for (int g = 0; g < 4; ++g) { float v[4];
#pragma unroll
            for (int e2 = 0; e2 < 4; ++e2) { const int j = 32 * (w >> 1) + 8 * g + 4 * hh + e2; v[e2] = (j <= i ? af[0][4 * g + e2] : 0.f) + (j >= i ? ab[0][4 * g + e2] : 0.f); }
            u32x2 o; o.x = pk2(v[0], v[1]); o.y = pk2(v[2], v[3]);
            *(LAS u32x2*)(Pm + i * 144 + (32 * (w >> 1) + 8 * g + 4 * hh) * 2) = o; }
    }
    __syncthreads();
    const int eb = w >> 1, ib = w & 1, i = 32 * ib + r;
    f32x16 acc[1]; zero_acc(acc);
    mma_nx1<1>(acc, vT, 144, 32 * eb, Pm, 144, 32 * ib, 4, r, hh);
    if (hasF) mma_nx1<1>(acc, raw, 272, 32 * eb, qF, 272, 32 * ib, 8, r, hh);
    if (hasB) mma_nx1<1>(acc, raw + 34816, 272, 32 * eb, qB, 272, 32 * ib, 8, r, hh);
    float ss = 0.f;
#pragma unroll
    for (int q = 0; q < 16; ++q) ss += acc[0][q] * acc[0][q];
    ss += __shfl_xor(ss, 32);
    if (hh == 0) red[eb * 64 + i] = ss;
    __syncthreads();
    const float rstd = rsqrtf((red[i] + red[64 + i] + red[128 + i] + red[192 + i]) * (1.0f / 128.0f) + EPS);
    const bf16_t* og = PR + (size_t)i * PROJ_LD + C_HOG + h * 128 + 32 * eb;
    const float* nw = p.in[16] + h * 128 + 32 * eb;
    bf16_t* O = (bf16_t*)(p.ws + WS_OHG) + (size_t)(pass * PASS_ROWS + cg * 64 + i) * 1024 + h * 128 + 32 * eb;
#pragma unroll
    for (int g = 0; g < 4; ++g) { const int e = 8 * g + 4 * hh; const u32x2 gv = *(const u32x2*)(og + e); const f32x4 n4 = *(const f32x4*)(nw + e);
        u32x2 o; o.x = pk2(acc[0][4 * g] * rstd * n4[0] * bflo(gv.x), acc[0][4 * g + 1] * rstd * n4[1] * bfhi(gv.x));
        o.y = pk2(acc[0][4 * g + 2] * rstd * n4[2] * bflo(gv.y), acc[0][4 * g + 3] * rstd * n4[3] * bfhi(gv.y));
        *(u32x2*)(O + e) = o; }
    __syncthreads();
}
DEVI int scan_nitems(int b, int G) { return G == 256 ? (b < 128 ? 2 : 3) : (640 - b + G - 1) / G; }
DEVI int scan_item(int b, int G, int k) { return G == 256 ? (b < 128 ? (k == 0 ? b : 128 + b) : 256 + (b - 128) * 3 + k) : b + k * G; }
#undef SCAN_A
#undef SCAN_B
#undef SCAN_C
#define SCAN_A { int tid = threadIdx.x; asm volatile("" : "+v"(tid)); const int n_ = scan_nitems(blockIdx.x, G); \
    for (int k_ = 0; k_ < n_; ++k_) { const int it_ = scan_item(blockIdx.x, G, k_); int t2_ = tid; asm volatile("" : "+v"(t2_)); if (it_ < 128) ret_stage_a(p, lds, pass, it_, t2_); else hg_stage_a(p, lds, pass, it_ - 128, t2_); } }
#define SCAN_B { int tid = threadIdx.x; asm volatile("" : "+v"(tid)); scan_stage_b(p, pass, tid, G); }
#define SCAN_C { int tid = threadIdx.x; asm volatile("" : "+v"(tid)); const int n_ = scan_nitems(blockIdx.x, G); \
    for (int k_ = 0; k_ < n_; ++k_) { const int it_ = scan_item(blockIdx.x, G, k_); int t2_ = tid; asm volatile("" : "+v"(t2_)); if (it_ < 128) ret_stage_c(p, lds, pass, it_, t2_); else hg_stage_c(p, lds, pass, it_ - 128, t2_); } }

constexpr int NWAVES = 8;
constexpr int LDS_BYTES = 163840;


DEVI float wave_sum(float v) {
#pragma unroll
    for (int o = 1; o < 64; o <<= 1) v += __shfl_xor(v, o);
    return v;
}

DEVI int map_row(int mode, int n) {
    if (mode == 1) { const int s = n >= 2816 ? 1 : 0, j = n - s * 2816; return 256 * (j >> 7) + 128 * s + (j & 127); }
    if (mode == 2) { if (n >= 1024) return n; const int t = n >> 8, q = n & 255, hh = q >> 7, part = (q >> 6) & 1, bj = (q >> 5) & 1, i = q & 31; return 256 * t + 128 * bj + 64 * hh + 32 * part + i; }
    return n;
}
DEVI void transpose_item(const float* __restrict__ W, int ldw, int n_base, bf16_t* __restrict__ WT, int Kdst, int koff, int mode, LAS float* scr, int item, int nblk, int lane) {
    const int kb = item / nblk, nb = item - kb * nblk, k0 = 64 * kb, n0 = 32 * nb;
#pragma unroll 8
    for (int i = 0; i < 32; ++i) { const int kk = 2 * i + (lane >> 5); scr[kk * 33 + (lane & 31)] = W[(size_t)(k0 + kk) * ldw + n_base + n0 + (lane & 31)]; }
    asm volatile("s_waitcnt lgkmcnt(0)" ::: "memory");
    const int c = lane & 7;
#pragma unroll
    for (int j = 0; j < 4; ++j) { const int n = (lane >> 3) + 8 * j; const LAS float* s = scr + (8 * c) * 33 + n;
        u32x4 o; o.x = pk2(s[0 * 33], s[1 * 33]); o.y = pk2(s[2 * 33], s[3 * 33]); o.z = pk2(s[4 * 33], s[5 * 33]); o.w = pk2(s[6 * 33], s[7 * 33]);
        *(u32x4*)(WT + (size_t)map_row(mode, n0 + n) * Kdst + koff + k0 + 8 * c) = o; }
    asm volatile("s_waitcnt lgkmcnt(0)" ::: "memory");
}
constexpr int I13 = 16 * 176, I2 = 44 * 32, IWIN = 16 * 256, IWG = 16 * 64, ISQ = 16 * 32;
constexpr int CV_G0 = I13, CV_G1 = I13 + I2 + I13 + I2, CV_ALL = 2 * I13 + 2 * I2 + IWIN + IWG + 3 * ISQ;
DEVI void convert_items(const P& p, ldsp lds, int lane, int wave, int first, int last, int worker, int nworkers) {
    LAS float* scr = (LAS float*)(lds + 32768 + wave * 8704);
    unsigned char* ws = p.ws;
    for (int it = first + worker * NWAVES + wave; it < last; it += nworkers * NWAVES) {
        int r = it;
        if (r < I13) { transpose_item(p.in[9], 5632, 0, (bf16_t*)(ws + WS_W13A), 1024, 0, 1, scr, r, 176, lane); continue; } r -= I13;
        if (r < I2) { transpose_item(p.in[10], 1024, 0, (bf16_t*)(ws + WS_W2A), 2816, 0, 0, scr, r, 32, lane); continue; } r -= I2;
        if (r < I13) { transpose_item(p.in[11], 5632, 0, (bf16_t*)(ws + WS_W13B), 1024, 0, 1, scr, r, 176, lane); continue; } r -= I13;
        if (r < I2) { transpose_item(p.in[12], 1024, 0, (bf16_t*)(ws + WS_W2B), 2816, 0, 0, scr, r, 32, lane); continue; } r -= I2;
        if (r < IWIN) { transpose_item(p.in[13], WIN_N, 0, (bf16_t*)(ws + WS_WIN), 1024, 0, 2, scr, r, 256, lane); continue; } r -= IWIN;
        if (r < IWG) { transpose_item(p.in[13], WIN_N, W_GR, (bf16_t*)(ws + WS_WG), 1024, 0, 0, scr, r, 64, lane); continue; } r -= IWG;
        if (r < ISQ) { transpose_item(p.in[17], 1024, 0, (bf16_t*)(ws + WS_WR), 1024, 0, 0, scr, r, 32, lane); continue; } r -= ISQ;
        if (r < ISQ) { transpose_item(p.in[18], 1024, 0, (bf16_t*)(ws + WS_WH), 1024, 0, 0, scr, r, 32, lane); continue; } r -= ISQ;
        transpose_item(p.in[19], 1024, 0, (bf16_t*)(ws + WS_WO), 1024, 0, 0, scr, r, 32, lane);
    }
}
DEVI void phase_prologue(const P& p, ldsp lds, int tid, int lane, int wave, int G) {
    if ((int)blockIdx.x < 144) {
        LAS float* sc = (LAS float*)lds;
        LAS float* red = sc + 5 * 1024;
        for (int i = tid; i < 5 * 1024; i += 512) { const int r = i >> 10, k = i & 1023; const float v = r == 0 ? p.in[5][k] : p.in[4][(r - 1) * 1024 + k]; sc[i] = siluf_(v); }
        __syncthreads();
        const int col = blockIdx.x * 64 + lane;
        const float* W = p.in[6];
        float a0 = 0.f, a1 = 0.f, a2 = 0.f, a3 = 0.f, a4 = 0.f;
#pragma unroll 8
        for (int kk = 0; kk < 128; ++kk) { const int k = wave * 128 + kk; const float w = W[(size_t)k * NMOD + col];
            a0 += sc[k] * w; a1 += sc[1024 + k] * w; a2 += sc[2048 + k] * w; a3 += sc[3072 + k] * w; a4 += sc[4096 + k] * w; }
        red[(wave * 5 + 0) * 64 + lane] = a0; red[(wave * 5 + 1) * 64 + lane] = a1; red[(wave * 5 + 2) * 64 + lane] = a2; red[(wave * 5 + 3) * 64 + lane] = a3; red[(wave * 5 + 4) * 64 + lane] = a4;
        __syncthreads();
        if (tid < 320) { const int r = tid >> 6, l = tid & 63; float s = 0.f;
#pragma unroll
            for (int w = 0; w < 8; ++w) s += red[(w * 5 + r) * 64 + l];
            const int cc = blockIdx.x * 64 + l;
            ((float*)(p.ws + WS_MOD))[r * NMOD + cc] = s + p.in[7][cc]; }
        __syncthreads();
    }
    if ((int)blockIdx.x == G - 1) {
        for (int i = tid; i < 2048; i += 512) {
            const int d = i >> 10, k = i & 1023;
            const float l0 = p.in[15][(d * 2 + 0) * 1024 + k], l1 = p.in[15][(d * 2 + 1) * 1024 + k];
            ((float*)(p.ws + WS_LB))[i] = 1.0f / (1.0f + expf(l1 - l0));
            const int pos = i >> 5, fi = i & 31;
            const double inv = exp(-(double)fi / 32.0 * log(10000.0));
            const float angf = (float)pos * (float)inv;
            double a = (double)angf; const double twopi = 6.283185307179586476925;
            a -= twopi * rint(a / twopi);
            double s = 0.0, c = 0.0, a2 = a * a, tc = 1.0, ts = a;
            for (int n = 0; n < 14; ++n) { c += tc; s += ts; tc *= -a2 / ((2 * n + 1) * (2 * n + 2)); ts *= -a2 / ((2 * n + 2) * (2 * n + 3)); }
            float* rt = (float*)(p.ws + WS_ROPE); rt[i * 2] = (float)c; rt[i * 2 + 1] = (float)s;
        }
    }
    convert_items(p, lds, lane, wave, 0, CV_G0, blockIdx.x, G);
}

template <int RB> DEVI void modnorm_rows(const P& p, int which, int lane, int m0, int mstep, int nrows) {
    f32x4 v[RB][4];
#pragma unroll
    for (int k = 0; k < RB; ++k) { const int m = m0 + k * mstep; if (k < nrows) {
        const float* xr = which == 0 ? (m < MP ? p.in[0] + (size_t)m * D : p.in[1] + (size_t)(m - MP) * D) : p.out + (size_t)m * D;
#pragma unroll
        for (int j = 0; j < 4; ++j) v[k][j] = *(const f32x4*)(xr + 4 * lane + 256 * j); } }
    f32x4 w[4];
    const float* nw = which == 3 ? p.in[20] : p.in[8] + which * D;
#pragma unroll
    for (int j = 0; j < 4; ++j) w[j] = *(const f32x4*)(nw + 4 * lane + 256 * j);
#pragma unroll
    for (int k = 0; k < RB; ++k) { const int m = m0 + k * mstep; if (k < nrows) {
        float ss = 0.f;
#pragma unroll
        for (int j = 0; j < 4; ++j) ss += (v[k][j][0] * v[k][j][0] + v[k][j][1] * v[k][j][1]) + (v[k][j][2] * v[k][j][2] + v[k][j][3] * v[k][j][3]);
        const float rstd = rsqrtf(wave_sum(ss) * (1.0f / D) + EPS);
        if (which == 3) {
            float* o = p.out + (size_t)m * D;
#pragma unroll
            for (int j = 0; j < 4; ++j) *(f32x4*)(o + 4 * lane + 256 * j) = v[k][j] * rstd * w[j];
        } else {
            const float* mod = (const float*)(p.ws + WS_MOD) + (size_t)mod_row(m) * NMOD;
            const float* sh = mod + (which * 3) * D; const float* sc = mod + (which * 3 + 1) * D;
            bf16_t* h = (bf16_t*)(p.ws + WS_H) + (size_t)m * D;
#pragma unroll
            for (int j = 0; j < 4; ++j) { const int c = 4 * lane + 256 * j;
                const f32x4 s4 = *(const f32x4*)(sc + c), h4 = *(const f32x4*)(sh + c);
                const f32x4 y = v[k][j] * rstd * w[j] * (s4 + 1.0f) + h4;
                u32x2 o; o.x = pk2(y[0], y[1]); o.y = pk2(y[2], y[3]); *(u32x2*)(h + c) = o; }
        } } }
}
DEVI void phase_modnorm(const P& p, int which, int lane, int wave, int G) {
    const int gw = blockIdx.x * NWAVES + wave, NGW = G * NWAVES;
    for (int m = gw; m < MT; m += 6 * NGW) { const int left = (MT - m + NGW - 1) / NGW; modnorm_rows<6>(p, which, lane, m, NGW, left < 6 ? left : 6); }
}

typedef GAS unsigned gu32;
#define RLX_AGENT __ATOMIC_RELAXED, __HIP_MEMORY_SCOPE_AGENT
constexpr size_t WS_BAR = 256 * 1024;
#define XB_TMO      128
#define XB_XCNT(j)  (256  + 64 * (j))
#define XB_XSUB(j)  (1280 + 64 * (j))
#define XB_XGEN(j)  (2304 + 64 * (j))
#define XB_TOP      3328
#define XB_TOPGEN   3392
#define XCD_BAR_WORDS 3456
#define XB_SPIN_CAP (1u << 18)

__device__ __forceinline__ unsigned xb_ld(unsigned* p)              { return __hip_atomic_load(p, __ATOMIC_RELAXED, __HIP_MEMORY_SCOPE_AGENT); }
__device__ __forceinline__ unsigned xb_add(unsigned* p, unsigned v) { return __hip_atomic_fetch_add(p, v, __ATOMIC_RELAXED, __HIP_MEMORY_SCOPE_AGENT); }
__device__ __forceinline__ unsigned xb_xcc_id() { return (unsigned)__builtin_amdgcn_s_getreg((3 << 11) | 20) & 0xFu; }
#define XB_SPIN(cond, bar) do { unsigned _sp = 0; while (cond) { __builtin_amdgcn_s_sleep(1); \
    if ((++_sp & 255u) == 0u) { if (xb_ld(&(bar)[XB_TMO])) break; if (_sp > XB_SPIN_CAP) { atomicAdd(&(bar)[XB_TMO], 1u); break; } } } } while (0)

struct XcdBarrier {
    unsigned* bar; unsigned x;
    volatile LAS unsigned* st;
};

__device__ __forceinline__ XcdBarrier xcd_barrier_post(unsigned* bar, volatile LAS unsigned* st) {
    XcdBarrier b; b.bar = bar; b.x = xb_xcc_id(); b.st = st;
    if (threadIdx.x == 0) (void)xb_add(&bar[XB_XCNT(b.x)], 1u);
    return b;
}
__device__ __forceinline__ void xcd_barrier_complete(unsigned* bar, unsigned x, unsigned& nloc, unsigned& nx) {
    const unsigned G = gridDim.x * gridDim.y * gridDim.z;
    unsigned sum, cnt, mine, sp = 0u;
    for (;;) {
        sum = 0u; cnt = 0u; mine = 0u;
#pragma unroll
        for (unsigned j = 0; j < 16; ++j) { const unsigned c = xb_ld(&bar[XB_XCNT(j)]); sum += c; cnt += (c > 0u) ? 1u : 0u; mine = (j == x) ? c : mine; }
        if (sum == G) break;
        __builtin_amdgcn_s_sleep(1);
        if ((++sp & 255u) == 0u) { if (xb_ld(&bar[XB_TMO])) break; if (sp > XB_SPIN_CAP) { atomicAdd(&bar[XB_TMO], 1u); break; } }
    }
    nloc = mine > 0u ? mine : 1u; nx = cnt > 0u ? cnt : 1u;
}

__device__ __forceinline__ void xcd_barrier(const XcdBarrier& b) {
    asm volatile("s_waitcnt vmcnt(0)" ::: "memory");
    __syncthreads();
    if (threadIdx.x == 0) {
        unsigned* bar = b.bar;
        __builtin_amdgcn_s_waitcnt(0);
        unsigned nloc = b.st[0], nx = b.st[1];
        if (nloc == 0u) { xcd_barrier_complete(bar, b.x, nloc, nx); b.st[0] = nloc; b.st[1] = nx; }
        const unsigned old = xb_add(&bar[XB_XSUB(b.x)], 1u);
        const unsigned gen = old / nloc;
        if (old + 1u == (gen + 1u) * nloc) {
            __builtin_amdgcn_fence(__ATOMIC_RELEASE, "agent");
            asm volatile("s_waitcnt vmcnt(0)" ::: "memory");
            const unsigned og = xb_add(&bar[XB_TOP], 1u);
            const unsigned tg = og / nx;
            if (og + 1u == (tg + 1u) * nx) xb_add(&bar[XB_TOPGEN], 1u);
            else XB_SPIN(xb_ld(&bar[XB_TOPGEN]) == tg, bar);
            __builtin_amdgcn_fence(__ATOMIC_ACQUIRE, "agent");
            xb_add(&bar[XB_XGEN(b.x)], 1u);
            asm volatile("s_waitcnt vmcnt(0)" ::: "memory");
        } else {
            XB_SPIN(xb_ld(&bar[XB_XGEN(b.x)]) == gen, bar);
            __builtin_amdgcn_fence(__ATOMIC_ACQUIRE, "agent");
            asm volatile("s_waitcnt vmcnt(0)" ::: "memory");
        }
    }
    __syncthreads();
}

#ifndef PHMASK
#define PHMASK 0xffff
#endif
#define PH(k) if (p.lo <= (k) && (k) < p.hi)
#define SYNC(k) do { if (p.lo <= (k) && (k) + 1 < p.hi) { if ((k) == 0) { asm volatile("s_waitcnt vmcnt(0) lgkmcnt(0)" ::: "memory"); cg::this_grid().sync(); } else xcd_barrier(bar); } } while (0)
#define GEMM_UP(WOFF) do { pg8::Gemm g{(const bf16_t*)(ws + WS_H), (const bf16_t*)(ws + (WOFF)), MT, 2 * FF, D}; \
    pg8::StaticOrder S; S.init(MT, 2 * FF, G, (int)blockIdx.x); pg8::EpiSwiglu E{(bf16_t*)(ws + WS_PROJ)}; \
    pg8::gemm_phase<pg8::EpiSwiglu, pg8::StaticOrder, true, true>(lds, g, S, E); } while (0)
#define GEMM_RES(AOFF, WOFF, KK, XP, XS, GIDX, SCL) do { pg8::Gemm g{(const bf16_t*)(ws + (AOFF)), (const bf16_t*)(ws + (WOFF)), MT, D, (KK)}; \
    pg8::StaticOrder S; S.init(MT, D, G, (int)blockIdx.x); pg8::EpiResid E{(XP), (XS), p.out, (const float*)(ws + WS_MOD), (GIDX), (SCL)}; \
    pg8::gemm_phase<pg8::EpiResid, pg8::StaticOrder, true, true>(lds, g, S, E); } while (0)

__global__ void __launch_bounds__(NWAVES * 64, 2) mk(P p) {
    extern __shared__ __attribute__((aligned(16))) unsigned char lds_raw[];
    ldsp lds = (ldsp)lds_raw;
    const int G = gridDim.x;
    unsigned char* ws = p.ws;
    volatile LAS unsigned* bst = (volatile LAS unsigned*)(lds + LDS_BYTES - 16);
    if (threadIdx.x < 2) bst[threadIdx.x] = 0u;
    __syncthreads();
    const XcdBarrier bar = xcd_barrier_post((unsigned*)(ws + WS_BAR), bst);
#define TIDS int tid = threadIdx.x; asm volatile("" : "+v"(tid)); const int lane = tid & 63, wave = __builtin_amdgcn_readfirstlane(tid >> 6); (void)lane; (void)wave;
    PH(0) { if (PHMASK & 1) { TIDS phase_prologue(p, lds, tid, lane, wave, G); } } SYNC(0);
    PH(1) { if (PHMASK & 2) { TIDS phase_modnorm(p, 0, lane, wave, G); } } SYNC(1);
    PH(2) { if (PHMASK & 4) GEMM_UP(WS_W13A);
        { const int idle0 = (MT / 256) * (2 * FF / 256) - 4 * G;
          if (G == 256 && (int)blockIdx.x >= idle0) { TIDS convert_items(p, lds, lane, wave, CV_G0, CV_G1, blockIdx.x - idle0, G - idle0); }
          else if (G != 256) { TIDS convert_items(p, lds, lane, wave, CV_G0, CV_G1, blockIdx.x, G); } } } SYNC(2);
    PH(3) { if (PHMASK & 8) GEMM_RES(WS_PROJ, WS_W2A, FF, p.in[0], p.in[1], 2, 0.5f);
        { const int idle0 = (MT / 256) * (D / 256);
          if (G == 256 && (int)blockIdx.x >= idle0) { TIDS convert_items(p, lds, lane, wave, CV_G1, CV_ALL, blockIdx.x - idle0, G - idle0); }
          else if (G != 256) { TIDS convert_items(p, lds, lane, wave, CV_G1, CV_ALL, blockIdx.x, G); } } } SYNC(3);
    PH(4) { if (PHMASK & 2) { TIDS phase_modnorm(p, 1, lane, wave, G); } } SYNC(4);
    for (int pass = 0; pass < 3; ++pass) {
        const int b = 5 + 4 * pass;
        PH(b) { if (PHMASK & 16) {
            pg8::Gemm g{(const bf16_t*)(ws + WS_H) + (size_t)pass * PASS_ROWS * D, (const bf16_t*)(ws + WS_WIN), PASS_ROWS, NPROJ, D};
            pg8::StaticOrder S; S.init(PASS_ROWS, NPROJ, G, (int)blockIdx.x);
            pg8::EpiWin E{(bf16_t*)(ws + WS_PROJ), (const float*)(ws + WS_LB), (const float*)(ws + WS_ROPE), pass};
            pg8::gemm_phase<pg8::EpiWin, pg8::StaticOrder, true, true>(lds, g, S, E); } } SYNC(b);
        PH(b + 1) { SCAN_A } SYNC(b + 1);
        PH(b + 2) { SCAN_B } SYNC(b + 2);
        PH(b + 3) { SCAN_C } SYNC(b + 3);
    }
    PH(17) { if (PHMASK & 32) {
        pg8::Gemm g{(const bf16_t*)(ws + WS_H), (const bf16_t*)(ws + WS_WG), MT, 2048, D};
        pg8::StaticOrder S; S.init(MT, 2048, G, (int)blockIdx.x);
        pg8::EpiGates E{(bf16_t*)(ws + WS_PROJ)};
        pg8::gemm_phase<pg8::EpiGates, pg8::StaticOrder, true, true>(lds, g, S, E); } } SYNC(17);
    PH(18) { if (PHMASK & 64) {
        { pg8::Gemm g{(const bf16_t*)(ws + WS_ORET), (const bf16_t*)(ws + WS_WR), MT, D, D};
          pg8::StaticOrder S; S.init(MT, D, G, (int)blockIdx.x);
          pg8::EpiMergeA E{(const bf16_t*)(ws + WS_PROJ), (float*)(ws + WS_ST)};
          pg8::gemm_phase<pg8::EpiMergeA, pg8::StaticOrder, true, true>(lds, g, S, E); }
        { pg8::Gemm g{(const bf16_t*)(ws + WS_OHG), (const bf16_t*)(ws + WS_WH), MT, D, D};
          pg8::StaticOrder S; S.init(MT, D, G, (int)blockIdx.x);
          pg8::EpiMergeB E{(const bf16_t*)(ws + WS_PROJ), (const float*)(ws + WS_ST), (bf16_t*)(ws + WS_H)};
          pg8::gemm_phase<pg8::EpiMergeB, pg8::StaticOrder, true, true>(lds, g, S, E); } } } SYNC(18);
    PH(19) { if (PHMASK & 8) GEMM_RES(WS_H, WS_WO, D, p.out, p.out + (size_t)MP * D, 5, 1.0f); } SYNC(19);
    PH(20) { if (PHMASK & 2) { TIDS phase_modnorm(p, 2, lane, wave, G); } } SYNC(20);
    PH(21) { if (PHMASK & 4) GEMM_UP(WS_W13B); } SYNC(21);
    PH(22) { if (PHMASK & 8) GEMM_RES(WS_PROJ, WS_W2B, FF, p.out, p.out + (size_t)MP * D, 8, 0.5f); } SYNC(22);
    PH(23) { if (PHMASK & 2) { TIDS phase_modnorm(p, 3, lane, wave, G); } }
}

static int g_grid = 0;
static void launch_mk(const P& base, int lo, int hi, hipStream_t stream, bool coop) {
    P p = base; p.lo = lo; p.hi = hi;
    if (coop) { void* args[] = {&p}; hipError_t e = hipLaunchCooperativeKernel((void*)mk, dim3(g_grid), dim3(NWAVES * 64), args, LDS_BYTES, stream);
        if (e != hipSuccess) fprintf(stderr, "cooperative launch failed: %s (grid %d)\n", hipGetErrorString(e), g_grid); }
    else hipLaunchKernelGGL(mk, dim3(g_grid), dim3(NWAVES * 64), LDS_BYTES, stream, p);
}

extern "C" void kernel_launch(void* const* d_in, const int* in_sizes, int n_in, void* d_out, int out_size, void* d_ws, size_t ws_size, hipStream_t stream) {
    if (g_grid == 0) {
        int dev = 0, cus = 0, per_cu = 0;
        hipGetDevice(&dev);
        hipDeviceGetAttribute(&cus, hipDeviceAttributeMultiprocessorCount, dev);
        hipFuncSetAttribute((const void*)mk, hipFuncAttributeMaxDynamicSharedMemorySize, LDS_BYTES);
        hipOccupancyMaxActiveBlocksPerMultiprocessor(&per_cu, (const void*)mk, NWAVES * 64, LDS_BYTES);
        if (per_cu < 1) per_cu = 1;
        g_grid = cus * per_cu;
        (void)hipGetLastError();
    }
    P p{};
    for (int i = 0; i < 21; ++i) p.in[i] = (const float*)d_in[i];
    p.out = (float*)d_out; p.ws = (unsigned char*)d_ws;
#if HYBRID
    launch_mk(p, 0, 5, stream, true);
    for (int pass = 0; pass < 3; ++pass) {
        const int nseq = pass == 0 ? 16 : 2;
        launch_mk(p, 5 + 4 * pass, 9 + 4 * pass, stream, true);
#if HYBRID == 2 || HYBRID == 4
        k_ret_scan<<<nseq * 8, 256, 0, stream>>>(p, pass);
        k_ret_fin<<<PASS_ROWS * 4 / 4, 256, 0, stream>>>(p, pass);
#endif
#if HYBRID == 3 || HYBRID == 4
        k_hg_scan<<<nseq * 16, 128, 0, stream>>>(p, pass);
        k_hg_fin<<<PASS_ROWS * 8 / 4, 256, 0, stream>>>(p, pass);
#endif
    }
    launch_mk(p, 17, 24, stream, true);
#else
    (void)hipMemsetAsync((char*)d_ws + WS_BAR, 0, 16384, stream);
    launch_mk(p, 0, 24, stream, true);
#endif
}
```

```cpp
#include <hip/hip_runtime.h>
#include <hip/hip_cooperative_groups.h>
#include <cstdint>
#include <cstdio>
namespace cg = cooperative_groups;

#define DEVI __device__ __forceinline__
#define LAS __attribute__((address_space(3)))
#define GAS __attribute__((address_space(1)))

constexpr int D = 1024, MP = 4096, MS = 8192, MT = 12288, FF = 2816, NPROJ = 8192, NMOD = 9 * 1024;
constexpr int PASS_ROWS = 4096;
constexpr int PROJ_LD = 8192 + 64;
constexpr float EPS = 1e-6f;
constexpr int C_RQ = 0, C_RK = 512, C_RV = 1024, C_RG = 2048, C_HQ = 3072, C_GF = 4096, C_GB = 5120, C_HI = 6144, C_HOG = 7168;
constexpr int W_GR = 8192, WIN_N = 10240;
constexpr float QK_SCALE = 0.08838834764831845f;

constexpr size_t MiB = 1u << 20;
constexpr size_t WS_MOD = 0;
constexpr size_t WS_LB = 192 * 1024;
constexpr size_t WS_ROPE = 200 * 1024;
constexpr size_t WS_W13A = 1 * MiB, WS_W2A = 12 * MiB, WS_W13B = 18 * MiB, WS_W2B = 29 * MiB;
constexpr size_t WS_WIN = 35 * MiB, WS_WG = 51 * MiB, WS_WR = 55 * MiB, WS_WH = 57 * MiB, WS_WO = 59 * MiB;
constexpr size_t WS_H = 61 * MiB;
constexpr size_t WS_ORET = 85 * MiB, WS_OHG = 109 * MiB;
constexpr size_t WS_PROJ = 133 * MiB;
constexpr size_t WS_ST = 199 * MiB;

typedef unsigned short bf16_t;
typedef float f32x4 __attribute__((ext_vector_type(4)));
typedef float f32x2 __attribute__((ext_vector_type(2)));
typedef unsigned u32x4 __attribute__((ext_vector_type(4)));
typedef unsigned u32x2 __attribute__((ext_vector_type(2)));
typedef short bf16x8 __attribute__((ext_vector_type(8)));

struct P {
    const float* in[21];
    float* out;
    unsigned char* ws;
    int lo, hi;
};

DEVI float bf2f(bf16_t v) { return __uint_as_float(((unsigned)v) << 16); }
DEVI unsigned f2bf(float f) { unsigned u = __float_as_uint(f); return (u + 0x7fffu + ((u >> 16) & 1u)) >> 16; }
typedef __bf16 bf16x2_t __attribute__((ext_vector_type(2)));
DEVI unsigned pk2(float lo, float hi) { bf16x2_t v; v[0] = (__bf16)lo; v[1] = (__bf16)hi; return __builtin_bit_cast(unsigned, v); }
DEVI float bflo(unsigned w) { return __uint_as_float(w << 16); }
DEVI float bfhi(unsigned w) { return __uint_as_float(w & 0xffff0000u); }
DEVI float sigmoidf_(float x) { return 1.0f / (1.0f + __expf(-x)); }
DEVI float siluf_(float x) { return x / (1.0f + __expf(-x)); }
DEVI int mod_row(int m) { return m < MP ? 0 : 1 + ((m - MP) >> 11); }

typedef LAS unsigned char* ldsp;
#define HYBRID 0
namespace pg8 {
#define PG8_LAS __attribute__((address_space(3)))
typedef unsigned short bf16_t;
typedef short bf16x8 __attribute__((ext_vector_type(8)));
typedef float f32x4 __attribute__((ext_vector_type(4)));
typedef unsigned u32x4 __attribute__((ext_vector_type(4)));
constexpr int BM = 256, BK = 64, HALF = 128, HTB = HALF * BK * 2  , STAGE_BYTES = 8 * HTB, NXCD = 8, WGM = 8;

__host__ __device__ __forceinline__ int lds_byte(int r, int c) { const int st = (r >> 4) * 2 + (c >> 5), rr = r & 15, cc = c & 31, ob = rr * 64 + cc * 2; return st * 1024 + (ob ^ (((ob >> 9) & 1) << 5)); }
__host__ __device__ __forceinline__ void stage_rc(int b, int& R, int& C) { const int st = b / 1024, sb = b % 1024, swz = sb ^ (((sb >> 9) & 1) << 5); R = (st >> 1) * 16 + swz / 64; C = (st & 1) * 32 + (swz % 64) / 2; }
__host__ __device__ __forceinline__ int perm32(int rho) { const int n = rho >> 4, i = rho & 15; return 8 * (i >> 2) + 4 * n + (i & 3); }

struct Unit { int pm, pn; };
struct Gemm { const bf16_t* A; const bf16_t* Bt; int M, N, K; };

struct StaticOrder {
    int nM, nN, nwg, G, c;
    __host__ __device__ void init(int M, int N, int G_, int c_) { nM = M / BM; nN = N / BM; nwg = nM * nN; G = G_; c = c_; }
    __host__ __device__ bool next(int i, Unit& u) const {
        const long L = (long)i * G + c; if (L >= nwg) return false;
        int wgid = (int)L; { const int q = nwg / NXCD, r = nwg % NXCD, xcd = wgid % NXCD, off = wgid / NXCD; wgid = (xcd < r ? xcd * (q + 1) : r * (q + 1) + (xcd - r) * q) + off; }
        const int nig = WGM * nN, gid = wgid / nig, fm = gid * WGM, gsz = (nM - fm) < WGM ? (nM - fm) : WGM;
        u.pm = fm + ((wgid % nig) % gsz); u.pn = (wgid % nig) / gsz; return true;
    }
    __device__ __forceinline__ void a_ready(const Unit&) const {}
    __device__ __forceinline__ void done(const Unit&) const {}
};


struct EpiSwiglu {
    static constexpr bool PERM = true, AFTER_DRAIN = false, HAS_MID = false;
    bf16_t* act;
    __device__ __forceinline__ void mid(f32x4 (&)[2][2][4][2], const Unit&, int, int, int, int) const {}
    __device__ __forceinline__ void operator()(const f32x4 (&acc)[2][2][4][2], const Unit& u, int wr, int wc, int fr, int fq) const {
        const int row0 = u.pm * BM + wr * 64 + fr, col0 = u.pn * 128 + wc * 32 + 8 * fq;
#pragma unroll
        for (int ai = 0; ai < 2; ++ai)
#pragma unroll
            for (int m = 0; m < 4; ++m) {
                float v[8];
#pragma unroll
                for (int n = 0; n < 2; ++n)
#pragma unroll
                    for (int e = 0; e < 4; ++e) { const float a = acc[ai][0][m][n][e], b = acc[ai][1][m][n][e]; v[n * 4 + e] = a * __builtin_amdgcn_rcpf(1.0f + __expf(-a)) * b; }
                u32x4 w; w.x = ::pk2(v[0], v[1]); w.y = ::pk2(v[2], v[3]); w.z = ::pk2(v[4], v[5]); w.w = ::pk2(v[6], v[7]);
                *(u32x4*)(act + (size_t)(row0 + ai * HALF + m * 16) * 2816 + col0) = w;
            }
    }
};
struct EpiResid {
    static constexpr bool PERM = false, AFTER_DRAIN = false, HAS_MID = false;
    const float* xp; const float* xs; float* out; const float* mod; int gidx; float scale;
    __device__ __forceinline__ void mid(f32x4 (&)[2][2][4][2], const Unit&, int, int, int, int) const {}
    __device__ __forceinline__ void operator()(const f32x4 (&acc)[2][2][4][2], const Unit& u, int wr, int wc, int fr, int fq) const {
        const int rowt = u.pm * BM, row0 = rowt + wr * 64 + fr, col0 = u.pn * BM + wc * 32 + 4 * fq;
        const float* gate = mod + (size_t)(rowt < 4096 ? 0 : 1 + ((rowt - 4096) >> 11)) * 9216 + gidx * 1024;
        const float* xb = rowt < 4096 ? xp : xs - (size_t)4096 * 1024;
#pragma unroll
        for (int bj = 0; bj < 2; ++bj)
#pragma unroll
            for (int n = 0; n < 2; ++n) {
                const int c = col0 + bj * HALF + n * 16;
                const f32x4 g4 = *(const f32x4*)(gate + c) * scale;
#pragma unroll
                for (int ai = 0; ai < 2; ++ai)
#pragma unroll
                    for (int m = 0; m < 4; ++m) { const size_t off = (size_t)(row0 + ai * HALF + m * 16) * 1024 + c;
                        const f32x4 xin = *(const f32x4*)(xb + off); *(f32x4*)(out + off) = xin + g4 * acc[ai][bj][m][n]; }
            }
    }
};
struct EpiWin {
    static constexpr bool PERM = true, AFTER_DRAIN = false, HAS_MID = false;
    bf16_t* PR; const float* lb; const float* rope; int pass;
    __device__ __forceinline__ void mid(f32x4 (&)[2][2][4][2], const Unit&, int, int, int, int) const {}
    __device__ __forceinline__ void operator()(const f32x4 (&acc)[2][2][4][2], const Unit& u, int wr, int wc, int fr, int fq) const {
        const int row0 = u.pm * BM + wr * 64 + fr;
        if (u.pn < 4) {
            const int hh = wc >> 1, part = wc & 1, i0 = 8 * fq;
            const float sc = u.pn >= 2 ? 0.08838834764831845f : 1.0f;
#pragma unroll
            for (int ai = 0; ai < 2; ++ai)
#pragma unroll
                for (int m = 0; m < 4; ++m) {
                    const int row = row0 + ai * HALF + m * 16;
                    float cs[8], sn[8];
                    if (pass > 0) { const int t = row & 2047; const int pos = part ? (t & 63) : (t >> 6);
                        const f32x4* rp = (const f32x4*)(rope + (size_t)(pos * 32 + i0) * 2);
#pragma unroll
                        for (int q = 0; q < 4; ++q) { const f32x4 r4 = rp[q]; cs[2 * q] = r4[0]; sn[2 * q] = r4[1]; cs[2 * q + 1] = r4[2]; sn[2 * q + 1] = r4[3]; } }
                    else {
#pragma unroll
                        for (int q = 0; q < 8; ++q) { cs[q] = 1.0f; sn[q] = 0.0f; } }
                    float y1[8], y2[8];
#pragma unroll
                    for (int e = 0; e < 8; ++e) { const float x1 = acc[ai][0][m][e >> 2][e & 3], x2 = acc[ai][1][m][e >> 2][e & 3];
                        y1[e] = (x1 * cs[e] - x2 * sn[e]) * sc; y2[e] = (x2 * cs[e] + x1 * sn[e]) * sc; }
                    bf16_t* dst = PR + (size_t)row * PROJ_LD + u.pn * BM + 128 * hh + 64 * part + i0;
                    u32x4 w; w.x = ::pk2(y1[0], y1[1]); w.y = ::pk2(y1[2], y1[3]); w.z = ::pk2(y1[4], y1[5]); w.w = ::pk2(y1[6], y1[7]);
                    *(u32x4*)dst = w;
                    w.x = ::pk2(y2[0], y2[1]); w.y = ::pk2(y2[2], y2[3]); w.z = ::pk2(y2[4], y2[5]); w.w = ::pk2(y2[6], y2[7]);
                    *(u32x4*)(dst + 32) = w;
                }
        } else {
            const int seg = u.pn >> 2;
            if (seg == 1 || seg == 6) plain<0>(acc, u, wr, wc, fr, fq);
            else if (seg == 2 || seg == 7) plain<1>(acc, u, wr, wc, fr, fq);
            else if (seg == 3) plain<2>(acc, u, wr, wc, fr, fq);
            else plain<3>(acc, u, wr, wc, fr, fq);
        }
    }
    template <int MODE> __device__ __forceinline__ void plain(const f32x4 (&acc)[2][2][4][2], const Unit& u, int wr, int wc, int fr, int fq) const {
        const int row0 = u.pm * BM + wr * 64 + fr;
#pragma unroll
        for (int bj = 0; bj < 2; ++bj) {
            const int col = u.pn * BM + bj * HALF + wc * 32 + 8 * fq;
            float l[8];
            if (MODE == 3) {
                const f32x4 l0 = *(const f32x4*)(lb + (col - 4096)), l1 = *(const f32x4*)(lb + (col - 4096) + 4);
#pragma unroll
                for (int e = 0; e < 4; ++e) { l[e] = l0[e]; l[4 + e] = l1[e]; }
            }
#pragma unroll
            for (int ai = 0; ai < 2; ++ai)
#pragma unroll
                for (int m = 0; m < 4; ++m) {
                    float v[8];
#pragma unroll
                    for (int e = 0; e < 8; ++e) { float x = acc[ai][bj][m][e >> 2][e & 3];
                        if (MODE == 1) x = x * __builtin_amdgcn_rcpf(1.0f + __expf(-x));
                        else if (MODE == 2) x = x * 0.08838834764831845f * __builtin_amdgcn_rcpf(1.0f + __expf(-x));
                        else if (MODE == 3) x = __logf(l[e] + (1.0f - l[e]) * __builtin_amdgcn_rcpf(1.0f + __expf(-x)));
                        v[e] = x; }
                    u32x4 w; w.x = ::pk2(v[0], v[1]); w.y = ::pk2(v[2], v[3]); w.z = ::pk2(v[4], v[5]); w.w = ::pk2(v[6], v[7]);
                    *(u32x4*)(PR + (size_t)(row0 + ai * HALF + m * 16) * PROJ_LD + col) = w;
                }
        }
    }
};
struct EpiGates {
    static constexpr bool PERM = true, AFTER_DRAIN = false, HAS_MID = false;
    bf16_t* G;
    __device__ __forceinline__ void mid(f32x4 (&)[2][2][4][2], const Unit&, int, int, int, int) const {}
    __device__ __forceinline__ void operator()(const f32x4 (&acc)[2][2][4][2], const Unit& u, int wr, int wc, int fr, int fq) const {
        const int row0 = u.pm * BM + wr * 64 + fr;
#pragma unroll
        for (int bj = 0; bj < 2; ++bj) {
            const int col = u.pn * BM + bj * HALF + wc * 32 + 8 * fq;
#pragma unroll
            for (int ai = 0; ai < 2; ++ai)
#pragma unroll
                for (int m = 0; m < 4; ++m) {
                    float v[8];
#pragma unroll
                    for (int e = 0; e < 8; ++e) v[e] = __builtin_amdgcn_rcpf(1.0f + __expf(-acc[ai][bj][m][e >> 2][e & 3]));
                    u32x4 w; w.x = ::pk2(v[0], v[1]); w.y = ::pk2(v[2], v[3]); w.z = ::pk2(v[4], v[5]); w.w = ::pk2(v[6], v[7]);
                    *(u32x4*)(G + (size_t)(row0 + ai * HALF + m * 16) * 2048 + col) = w;
                }
        }
    }
};
struct EpiMergeA {
    static constexpr bool PERM = false, AFTER_DRAIN = false, HAS_MID = false;
    const bf16_t* G; float* T;
    __device__ __forceinline__ void mid(f32x4 (&)[2][2][4][2], const Unit&, int, int, int, int) const {}
    __device__ __forceinline__ void operator()(const f32x4 (&acc)[2][2][4][2], const Unit& u, int wr, int wc, int fr, int fq) const {
        const int row0 = u.pm * BM + wr * 64 + fr, col0 = u.pn * BM + wc * 32 + 4 * fq;
#pragma unroll
        for (int ai = 0; ai < 2; ++ai)
#pragma unroll
            for (int m = 0; m < 4; ++m) { const size_t row = (size_t)(row0 + ai * HALF + m * 16);
#pragma unroll
                for (int bj = 0; bj < 2; ++bj)
#pragma unroll
                    for (int n = 0; n < 2; ++n) { const int c = col0 + bj * HALF + n * 16;
                        const u32x2 g = *(const u32x2*)(G + row * 2048 + c);
                        f32x4 v = acc[ai][bj][m][n]; v[0] *= ::bflo(g.x); v[1] *= ::bfhi(g.x); v[2] *= ::bflo(g.y); v[3] *= ::bfhi(g.y);
                        *(f32x4*)(T + row * 1024 + c) = v; } }
    }
};
struct EpiMergeB {
    static constexpr bool PERM = false, AFTER_DRAIN = false, HAS_MID = false;
    const bf16_t* G; const float* T; bf16_t* Mg;
    __device__ __forceinline__ void mid(f32x4 (&)[2][2][4][2], const Unit&, int, int, int, int) const {}
    __device__ __forceinline__ void operator()(const f32x4 (&acc)[2][2][4][2], const Unit& u, int wr, int wc, int fr, int fq) const {
        const int row0 = u.pm * BM + wr * 64 + fr, col0 = u.pn * BM + wc * 32 + 4 * fq;
#pragma unroll
        for (int ai = 0; ai < 2; ++ai)
#pragma unroll
            for (int m = 0; m < 4; ++m) { const size_t row = (size_t)(row0 + ai * HALF + m * 16);
#pragma unroll
                for (int bj = 0; bj < 2; ++bj)
#pragma unroll
                    for (int n = 0; n < 2; ++n) { const int c = col0 + bj * HALF + n * 16;
                        const u32x2 g = *(const u32x2*)(G + row * 2048 + 1024 + c);
                        f32x4 v = acc[ai][bj][m][n]; const f32x4 t = *(const f32x4*)(T + row * 1024 + c);
                        v[0] = v[0] * ::bflo(g.x) + t[0]; v[1] = v[1] * ::bfhi(g.x) + t[1]; v[2] = v[2] * ::bflo(g.y) + t[2]; v[3] = v[3] * ::bfhi(g.y) + t[3];
                        u32x2 w; w.x = ::pk2(v[0], v[1]); w.y = ::pk2(v[2], v[3]);
                        *(u32x2*)(Mg + row * 1024 + c) = w; } }
    }
};

template <class Epi, class Sched, bool ALIGN_EPI = false, bool SP2 = false>
__device__ __forceinline__ void gemm_phase(PG8_LAS unsigned char* lds, const Gemm g, const Sched& S, const Epi& E) {
    int tid_ = threadIdx.x; asm volatile("" : "+v"(tid_)); const int tid = tid_, wid = __builtin_amdgcn_readfirstlane(tid >> 6), lane = tid & 63, wr = wid >> 2, wc = wid & 3, fr = lane & 15, fq = lane >> 4;
    const int K = g.K, nt = K / BK;
    unsigned voffA[2], voffB[2];
#pragma unroll
    for (int i = 0; i < 2; ++i) { int R, C; stage_rc(tid * 16 + i * 8192, R, C); const int Rb = Epi::PERM ? ((R & ~31) + perm32(R & 31)) : R;
        voffA[i] = (unsigned)(R * K + C) * 2u; voffB[i] = (unsigned)(Rb * K + C) * 2u; }
    const size_t kstep = (size_t)(BK * 2);
    const size_t hstep = (size_t)HALF * K * 2;
    const size_t tstep = 2 * hstep;
    const unsigned ldsw = (unsigned)wid * 1024u;
    const int aoff = lds_byte(wr * 64 + fr, fq * 8), boff = lds_byte(wc * 32 + fr, fq * 8);
#define PG8_SA(b, h) (((b) * 2 + (h)) * HTB)
#define PG8_SB(b, h) ((4 + (b) * 2 + (h)) * HTB)
#define PG8_STAGE(bufoff, gbase, voff) do { _Pragma("unroll") for (int _i = 0; _i < 2; ++_i) \
        __builtin_amdgcn_global_load_lds((const unsigned*)((const char*)(gbase) + (voff)[_i]), (PG8_LAS unsigned*)(lds + (bufoff) + ldsw + _i * 8192), 16, 0, 0); } while (0)
#define PG8_LDA(dst, b, h) do { _Pragma("unroll") for (int m = 0; m < 4; ++m) _Pragma("unroll") for (int k = 0; k < 2; ++k) dst[m][k] = *(const PG8_LAS bf16x8*)(lds + PG8_SA(b, h) + aoff + m * 2048 + k * 1024); } while (0)
#define PG8_LDB(dst, b, h) do { _Pragma("unroll") for (int n = 0; n < 2; ++n) _Pragma("unroll") for (int k = 0; k < 2; ++k) dst[n][k] = *(const PG8_LAS bf16x8*)(lds + PG8_SB(b, h) + boff + n * 2048 + k * 1024); } while (0)
#define PG8_MMA(ai, bj, At, Bt) do { __builtin_amdgcn_s_setprio(1); _Pragma("unroll") for (int m = 0; m < 4; ++m) _Pragma("unroll") for (int n = 0; n < 2; ++n) _Pragma("unroll") for (int k = 0; k < 2; ++k) \
        acc[ai][bj][m][n] = __builtin_amdgcn_mfma_f32_16x16x32_bf16(Bt[n][k], At[m][k], acc[ai][bj][m][n], 0, 0, 0); __builtin_amdgcn_s_setprio(0); } while (0)
#define PG8_WAIT_V(n) asm volatile("s_waitcnt vmcnt(" #n ")" ::: "memory")
#define PG8_WAIT_L(n) asm volatile("s_waitcnt lgkmcnt(" #n ")" ::: "memory")
#define PG8_BAR __builtin_amdgcn_s_barrier()
#define PG8_SCHED __builtin_amdgcn_sched_barrier(0)
    Unit cur, nxt; int ui = 0;
    if (!S.next(0, cur)) return;
    f32x4 acc[2][2][4][2];
#pragma unroll
    for (int a = 0; a < 2; ++a)
#pragma unroll
        for (int b = 0; b < 2; ++b)
#pragma unroll
            for (int m = 0; m < 4; ++m)
#pragma unroll
                for (int n = 0; n < 2; ++n) acc[a][b][m][n] = (f32x4){0.f, 0.f, 0.f, 0.f};
    bf16x8 At[4][2], B0[2][2], B1[2][2];
    const char* cA = (const char*)g.A + (size_t)cur.pm * tstep; const char* cB = (const char*)g.Bt + (size_t)cur.pn * tstep;
    S.a_ready(cur);
    if constexpr (SP2) {
        PG8_STAGE(PG8_SB(0, 0), cB, voffB); PG8_STAGE(PG8_SB(0, 1), cB + hstep, voffB); PG8_STAGE(PG8_SA(0, 0), cA, voffA); PG8_STAGE(PG8_SA(0, 1), cA + hstep, voffA);
        if (wr == 1) PG8_BAR;
        PG8_WAIT_V(2); PG8_BAR;
        PG8_STAGE(PG8_SB(1, 0), cB + kstep, voffB); PG8_STAGE(PG8_SA(1, 0), cA + kstep, voffA); PG8_STAGE(PG8_SB(1, 1), cB + hstep + kstep, voffB);
        PG8_WAIT_V(6); PG8_BAR;
    } else {
        PG8_STAGE(PG8_SB(0, 0), cB, voffB); PG8_STAGE(PG8_SA(0, 0), cA, voffA); PG8_STAGE(PG8_SB(0, 1), cB + hstep, voffB); PG8_STAGE(PG8_SA(0, 1), cA + hstep, voffA);
        if (wr == 1) PG8_BAR;
        PG8_WAIT_V(4); PG8_BAR;
        PG8_STAGE(PG8_SB(1, 0), cB + kstep, voffB); PG8_STAGE(PG8_SA(1, 0), cA + kstep, voffA); PG8_STAGE(PG8_SB(1, 1), cB + hstep + kstep, voffB);
        PG8_WAIT_V(6); PG8_BAR;
    }
    for (;;) {
        const bool has_next = S.next(ui + 1, nxt);
        const char* nA = has_next ? (const char*)g.A + (size_t)nxt.pm * tstep : cA; const char* nB = has_next ? (const char*)g.Bt + (size_t)nxt.pn * tstep : cB;
        for (int t = 0; t < nt; t += 2) {
            if constexpr (Epi::HAS_MID) { if (t == (nt >> 1)) E.mid(acc, cur, wr, wc, fr, fq); }
            const bool last = (t == nt - 2);
            const char* a1 = cA + (size_t)(t + 1) * kstep;
            const char* a2 = last ? nA : cA + (size_t)(t + 2) * kstep; const char* b2 = last ? nB : cB + (size_t)(t + 2) * kstep;
            const char* a3 = a2 + kstep; const char* b3 = b2 + kstep;
            if (last && has_next) S.a_ready(nxt);
            if constexpr (SP2) {
            PG8_LDB(B0, 0, 0); PG8_LDB(B1, 0, 1); PG8_SCHED; PG8_LDA(At, 0, 0); PG8_STAGE(PG8_SA(1, 1), a1 + hstep, voffA);
            PG8_WAIT_V(8); PG8_WAIT_L(0); PG8_BAR; PG8_MMA(0, 0, At, B0); PG8_MMA(0, 1, At, B1); PG8_BAR; PG8_SCHED;
            PG8_LDA(At, 0, 1); PG8_STAGE(PG8_SB(0, 0), b2, voffB); PG8_STAGE(PG8_SB(0, 1), b2 + hstep, voffB); PG8_STAGE(PG8_SA(0, 0), a2, voffA);
            PG8_WAIT_V(8); PG8_WAIT_L(0); PG8_BAR; PG8_MMA(1, 0, At, B0); PG8_MMA(1, 1, At, B1); PG8_BAR; PG8_SCHED;
            PG8_LDB(B0, 1, 0); PG8_LDB(B1, 1, 1); PG8_SCHED; PG8_LDA(At, 1, 0); PG8_STAGE(PG8_SA(0, 1), a2 + hstep, voffA);
            PG8_WAIT_V(8); PG8_WAIT_L(0); PG8_BAR; PG8_MMA(0, 0, At, B0); PG8_MMA(0, 1, At, B1); PG8_BAR; PG8_SCHED;
            PG8_LDA(At, 1, 1); PG8_STAGE(PG8_SB(1, 0), b3, voffB); PG8_STAGE(PG8_SB(1, 1), b3 + hstep, voffB); PG8_STAGE(PG8_SA(1, 0), a3, voffA);
            PG8_WAIT_V(8); PG8_WAIT_L(0); PG8_BAR; PG8_MMA(1, 0, At, B0); PG8_MMA(1, 1, At, B1); PG8_BAR; PG8_SCHED;
            } else {
            PG8_LDB(B0, 0, 0); PG8_SCHED; PG8_LDA(At, 0, 0); PG8_STAGE(PG8_SA(1, 1), a1 + hstep, voffA);
            PG8_WAIT_L(8); PG8_BAR; PG8_WAIT_L(0); PG8_MMA(0, 0, At, B0); PG8_BAR; PG8_SCHED;
            PG8_LDB(B1, 0, 1); PG8_STAGE(PG8_SB(0, 0), b2, voffB);
            PG8_BAR; PG8_WAIT_L(0); PG8_MMA(0, 1, At, B1); PG8_BAR;
            PG8_LDA(At, 0, 1); PG8_STAGE(PG8_SA(0, 0), a2, voffA);
            PG8_BAR; PG8_WAIT_L(0); PG8_MMA(1, 0, At, B0); PG8_BAR; PG8_SCHED;
            PG8_STAGE(PG8_SB(0, 1), b2 + hstep, voffB);
            PG8_WAIT_V(6); PG8_BAR; PG8_MMA(1, 1, At, B1); PG8_BAR;
            PG8_LDB(B0, 1, 0); PG8_SCHED; PG8_LDA(At, 1, 0); PG8_STAGE(PG8_SA(0, 1), a2 + hstep, voffA);
            PG8_WAIT_L(8); PG8_BAR; PG8_WAIT_L(0); PG8_MMA(0, 0, At, B0); PG8_BAR; PG8_SCHED;
            PG8_LDB(B1, 1, 1); PG8_STAGE(PG8_SB(1, 0), b3, voffB);
            PG8_BAR; PG8_WAIT_L(0); PG8_MMA(0, 1, At, B1); PG8_BAR;
            PG8_LDA(At, 1, 1); PG8_STAGE(PG8_SA(1, 0), a3, voffA);
            PG8_BAR; PG8_WAIT_L(0); PG8_MMA(1, 0, At, B0); PG8_BAR; PG8_SCHED;
            PG8_STAGE(PG8_SB(1, 1), b3 + hstep, voffB);
            PG8_WAIT_V(6); PG8_BAR; PG8_MMA(1, 1, At, B1); PG8_BAR;
            }
        }
        if constexpr (ALIGN_EPI) { if (wr == 0) PG8_BAR; }
        if constexpr (!Epi::AFTER_DRAIN) { E(acc, cur, wr, wc, fr, fq); S.done(cur); }
        if (!has_next) break;
#pragma unroll
        for (int a = 0; a < 2; ++a)
#pragma unroll
            for (int b = 0; b < 2; ++b)
#pragma unroll
                for (int m = 0; m < 4; ++m)
#pragma unroll
                    for (int n = 0; n < 2; ++n) acc[a][b][m][n] = (f32x4){0.f, 0.f, 0.f, 0.f};
        cur = nxt; cA = nA; cB = nB; ++ui;
        if constexpr (ALIGN_EPI) { if (wr == 1) PG8_BAR; }
    }
    PG8_WAIT_V(0);
    if constexpr (!ALIGN_EPI) { if (wr == 0) PG8_BAR; }
    PG8_BAR;
    if constexpr (Epi::AFTER_DRAIN) { E.fused(acc, cur, wr, wc, fr, fq, lds, wid, lane); S.done(cur); }
#undef PG8_SA
#undef PG8_SB
#undef PG8_STAGE
#undef PG8_LDA
#undef PG8_LDB
#undef PG8_MMA
#undef PG8_WAIT_V
#undef PG8_WAIT_L
#undef PG8_BAR
#undef PG8_SCHED
}
}

typedef float f32x16 __attribute__((ext_vector_type(16)));
constexpr size_t WS_RST = WS_ST;
constexpr size_t WS_HST = WS_ST + 16 * MiB;
constexpr size_t WS_HD = WS_ST + 48 * MiB;
constexpr size_t OUT_RET = (size_t)MT * D, OUT_HG = OUT_RET + (size_t)16 * 2 * 4 * 128 * 256;

DEVI bf16x8 ldfrag(ldsp base, int stride, int row, int k0, int hh) { return *(const LAS bf16x8*)(base + row * stride + (k0 + 8 * hh) * 2); }
template <int NX> DEVI void mma_nx1(f32x16 (&acc)[NX], ldsp X, int xs, int x0, ldsp Y, int ys, int y0, int ksteps, int r, int hh) {

    for (int s = 0; s < ksteps; ++s) {
        const bf16x8 b = ldfrag(Y, ys, y0 + r, 16 * s, hh);
#pragma unroll
        for (int t = 0; t < NX; ++t) { const bf16x8 a = ldfrag(X, xs, x0 + 32 * t + r, 16 * s, hh); acc[t] = __builtin_amdgcn_mfma_f32_32x32x16_bf16(a, b, acc[t], 0, 0, 0); }
    }
}
template <int NX> DEVI void zero_acc(f32x16 (&acc)[NX]) {
#pragma unroll
    for (int t = 0; t < NX; ++t)
#pragma unroll
        for (int i = 0; i < 16; ++i) acc[t][i] = 0.f;
}
template <int ROWS, int LC> struct NatBuf { u32x4 v[(ROWS << LC) / 512]; };
template <int ROWS, int LC> DEVI void nat_load(NatBuf<ROWS, LC>& b, const bf16_t* src, size_t gstride, int tid) {
#pragma unroll
    for (int k = 0; k < (ROWS << LC) / 512; ++k) { const int u = tid + 512 * k, rr = u >> LC, c = u & ((1 << LC) - 1); b.v[k] = *(const u32x4*)(src + (size_t)rr * gstride + c * 8); }
}
template <int ROWS, int LC> DEVI void nat_store(const NatBuf<ROWS, LC>& b, ldsp dst, int ls, int tid) {
#pragma unroll
    for (int k = 0; k < (ROWS << LC) / 512; ++k) { const int u = tid + 512 * k, rr = u >> LC, c = u & ((1 << LC) - 1); *(LAS u32x4*)(dst + rr * ls + c * 16) = b.v[k]; }
}
template <int T, int NCOL> struct TrBuf { u32x4 v0[(T >> 5) * (NCOL >> 5) / 8], v1[(T >> 5) * (NCOL >> 5) / 8]; };
template <int T, int NCOL> DEVI void tr_load(TrBuf<T, NCOL>& b, const bf16_t* src, size_t gstride, int tid) {
    const int lane = tid & 63, wv = tid >> 6; constexpr int nbj = T >> 5;
#pragma unroll
    for (int k = 0; k < (T >> 5) * (NCOL >> 5) / 8; ++k) { const int blk = wv + 8 * k, bj = blk % nbj, bc = blk / nbj, jp = bj * 16 + (lane & 15), cc = bc * 4 + (lane >> 4);
        b.v0[k] = *(const u32x4*)(src + (size_t)(2 * jp) * gstride + cc * 8); b.v1[k] = *(const u32x4*)(src + (size_t)(2 * jp + 1) * gstride + cc * 8); }
}
template <int T, int NCOL, class F> DEVI void tr_store(const TrBuf<T, NCOL>& b, ldsp dst, int ls, int tid, F scale) {
    const int lane = tid & 63, wv = tid >> 6; constexpr int nbj = T >> 5;
#pragma unroll
    for (int k = 0; k < (T >> 5) * (NCOL >> 5) / 8; ++k) { const int blk = wv + 8 * k, bj = blk % nbj, bc = blk / nbj, jp = bj * 16 + (lane & 15), cc = bc * 4 + (lane >> 4);
        const float s0 = scale(2 * jp), s1 = scale(2 * jp + 1);
#pragma unroll
        for (int q = 0; q < 4; ++q) {
            *(LAS unsigned*)(dst + (cc * 8 + 2 * q) * ls + jp * 4) = pk2(bflo(b.v0[k][q]) * s0, bflo(b.v1[k][q]) * s1);
            *(LAS unsigned*)(dst + (cc * 8 + 2 * q + 1) * ls + jp * 4) = pk2(bfhi(b.v0[k][q]) * s0, bfhi(b.v1[k][q]) * s1);
        } }
}
DEVI float log2_gamma(const P& p, int dir, int h) { const float rd = p.in[14][dir * 4 + h]; return -log2f(1.0f + expf(-rd)); }
DEVI u32x2 pack4(const f32x16& a, int g) { u32x2 w; w.x = pk2(a[4 * g], a[4 * g + 1]); w.y = pk2(a[4 * g + 2], a[4 * g + 3]); return w; }

DEVI void ret_stage_a(const P& p, ldsp lds, int pass, int item, int tid) {
    const int cg = item >> 2, h = item & 3, lane = tid & 63, w = __builtin_amdgcn_readfirstlane(tid >> 6), r = lane & 31, hh = lane >> 5;
    const bf16_t* PR = (const bf16_t*)(p.ws + WS_PROJ) + (size_t)(cg * 128) * PROJ_LD;
    const float lgf = log2_gamma(p, 0, h), lgb = log2_gamma(p, 1, h);
    ldsp vT = lds, kfT = lds + 69632, kbT = lds + 104448;
    { TrBuf<128, 256> bv; TrBuf<128, 128> bk;
      tr_load(bv, PR + C_RV + h * 256, PROJ_LD, tid); tr_load(bk, PR + C_RK + h * 128, PROJ_LD, tid);
      tr_store(bv, vT, 272, tid, [](int) { return 1.0f; });
      tr_store(bk, kfT, 272, tid, [lgf](int j) { return exp2f(lgf * (float)(127 - j)); });
      tr_store(bk, kbT, 272, tid, [lgb](int j) { return exp2f(lgb * (float)j); }); }
    __syncthreads();
#pragma unroll 1
    for (int dir = 0; dir < 2; ++dir) {
        f32x16 acc[4]; zero_acc(acc);
        mma_nx1<4>(acc, dir ? kbT : kfT, 272, 0, vT, 272, 32 * w, 8, r, hh);
        bf16_t* ST = (bf16_t*)(p.ws + WS_RST) + ((size_t)(cg * 4 + h) * 2 + dir) * 32768 + (size_t)(32 * w + r) * 128;
#pragma unroll
        for (int t = 0; t < 4; ++t)
#pragma unroll
            for (int g = 0; g < 4; ++g) *(u32x2*)(ST + 32 * t + 8 * g + 4 * hh) = pack4(acc[t], g);
    }
    __syncthreads();
}
template <int NB> DEVI void ret_b_item(const P& p, int pass, int idx, int nc) {
    const int dkg = idx & 15, e = (idx >> 4) & 255, hd = (idx >> 12) & 7, s = idx >> 15, dir = hd & 1, h = hd >> 1, dk0 = dkg * 8;
    const float cdec = exp2f(log2_gamma(p, dir, h) * 128.0f);
    float S[8];
    if (pass == 0) {
#pragma unroll
        for (int i = 0; i < 8; ++i) S[i] = 0.f;
    } else {
        const float* st = p.in[2] + ((size_t)(((pass - 1) * 2 + s) * 2 + dir) * 4 + h) * 32768;
#pragma unroll
        for (int i = 0; i < 8; ++i) S[i] = st[(dk0 + i) * 256 + e];
    }
    const long cstride = dir ? -(long)(4 * 2 * 32768) : (long)(4 * 2 * 32768);
    bf16_t* q = (bf16_t*)(p.ws + WS_RST) + ((size_t)((s * nc + (dir ? nc - 1 : 0)) * 4 + h) * 2 + dir) * 32768 + e * 128 + dk0;
    for (int c0 = 0; c0 < nc; c0 += NB) {
        u32x4 u[NB];
#pragma unroll
        for (int k = 0; k < NB; ++k) u[k] = *(const u32x4*)(q + (long)k * cstride);
#pragma unroll
        for (int k = 0; k < NB; ++k) {
            u32x4 o; o.x = pk2(S[0], S[1]); o.y = pk2(S[2], S[3]); o.z = pk2(S[4], S[5]); o.w = pk2(S[6], S[7]);
            *(u32x4*)(q + (long)k * cstride) = o;
#pragma unroll
            for (int qq = 0; qq < 4; ++qq) { S[2 * qq] = cdec * S[2 * qq] + bflo(u[k][qq]); S[2 * qq + 1] = cdec * S[2 * qq + 1] + bfhi(u[k][qq]); }
        }
        q += (long)NB * cstride;
    }
    if (pass == 0) {
        float* ns = p.out + OUT_RET + ((size_t)(s * 2 + dir) * 4 + h) * 32768;
#pragma unroll
        for (int i = 0; i < 8; ++i) ns[(dk0 + i) * 256 + e] = S[i];
    }
}
template <int NB> DEVI void hg_b_item(const P& p, int pass, int idx, int nc) {
    const int dkg = idx & 15, e = (idx >> 4) & 127, hd = (idx >> 11) & 15, s = idx >> 15, dir = hd & 1, h = hd >> 1, dk0 = dkg * 8;
    float S[8];
    if (pass == 0) {
#pragma unroll
        for (int i = 0; i < 8; ++i) S[i] = 0.f;
    } else {
        const float* st = p.in[3] + ((size_t)(((pass - 1) * 2 + s) * 2 + dir) * 8 + h) * 16384;
#pragma unroll
        for (int i = 0; i < 8; ++i) S[i] = st[(dk0 + i) * 128 + e];
    }
    const long cs = dir ? -16L : 16L;
    size_t ci = (size_t)((s * nc + (dir ? nc - 1 : 0)) * 8 + h) * 2 + dir;
    for (int c0 = 0; c0 < nc; c0 += NB) {
        u32x4 u[NB]; f32x4 d0[NB], d1[NB];
#pragma unroll
        for (int k = 0; k < NB; ++k) { const size_t cik = ci + (long)k * cs;
            u[k] = *(const u32x4*)((const bf16_t*)(p.ws + WS_HST) + cik * 16384 + e * 128 + dk0);
            const float* dv = (const float*)(p.ws + WS_HD) + cik * 128 + dk0; d0[k] = *(const f32x4*)dv; d1[k] = *(const f32x4*)(dv + 4); }
#pragma unroll
        for (int k = 0; k < NB; ++k) { const size_t cik = ci + (long)k * cs;
            u32x4 o; o.x = pk2(S[0], S[1]); o.y = pk2(S[2], S[3]); o.z = pk2(S[4], S[5]); o.w = pk2(S[6], S[7]);
            *(u32x4*)((bf16_t*)(p.ws + WS_HST) + cik * 16384 + e * 128 + dk0) = o;
#pragma unroll
            for (int qq = 0; qq < 4; ++qq) { const float da = qq < 2 ? d0[k][2 * qq] : d1[k][2 * qq - 4], db = qq < 2 ? d0[k][2 * qq + 1] : d1[k][2 * qq - 3];
                S[2 * qq] = da * S[2 * qq] + bflo(u[k][qq]); S[2 * qq + 1] = db * S[2 * qq + 1] + bfhi(u[k][qq]); }
        }
        ci += (long)NB * cs;
    }
    if (pass == 0) {
        float* ns = p.out + OUT_HG + ((size_t)(s * 2 + dir) * 8 + h) * 16384;
#pragma unroll
        for (int i = 0; i < 8; ++i) ns[(dk0 + i) * 128 + e] = S[i];
    }
}
DEVI void scan_stage_b(const P& p, int pass, int tid, int G) {
    const int nseq = pass == 0 ? 16 : 2, tot_r = nseq * 32768;
    for (int idx = blockIdx.x * 512 + tid; idx < 2 * tot_r; idx += G * 512) {
        if (idx < tot_r) { if (pass == 0) ret_b_item<2>(p, pass, idx, 2); else ret_b_item<8>(p, pass, idx, 16); }
        else { if (pass == 0) hg_b_item<4>(p, pass, idx - tot_r, 4); else hg_b_item<4>(p, pass, idx - tot_r, 32); }
    }
}
DEVI void ret_stage_c(const P& p, ldsp lds, int pass, int item, int tid) {
    const int cg = item >> 2, h = item & 3, lane = tid & 63, w = __builtin_amdgcn_readfirstlane(tid >> 6), r = lane & 31, hh = lane >> 5;
    const int nc = pass == 0 ? 2 : 16, c = cg % nc;
    const bf16_t* PR = (const bf16_t*)(p.ws + WS_PROJ) + (size_t)(cg * 128) * PROJ_LD;
    const float lgf = log2_gamma(p, 0, h), lgb = log2_gamma(p, 1, h);
    ldsp qL = lds, kP = lds + 34816, vS = lds + 69632; LAS float* red = (LAS float*)(lds + 139264);
    { NatBuf<128, 4> bq, bk; TrBuf<128, 256> bv;
      nat_load(bq, PR + C_RQ + h * 128, PROJ_LD, tid); nat_load(bk, PR + C_RK + h * 128, PROJ_LD, tid); tr_load(bv, PR + C_RV + h * 256, PROJ_LD, tid);
      nat_store(bq, qL, 272, tid); nat_store(bk, kP, 272, tid); tr_store(bv, vS, 272, tid, [](int) { return 1.0f; }); }
    __syncthreads();
    const int ib = w & 3, wh = w >> 2, i = 32 * ib + r;
    {
        f32x16 ap[2]; zero_acc(ap);
        mma_nx1<2>(ap, kP, 272, 64 * wh, qL, 272, 32 * ib, 8, r, hh);
        __syncthreads();
#pragma unroll
        for (int t = 0; t < 2; ++t)
#pragma unroll
            for (int g = 0; g < 4; ++g) {
                float v[4];
#pragma unroll
                for (int e2 = 0; e2 < 4; ++e2) { const int j = 64 * wh + 32 * t + 8 * g + 4 * hh + e2, d = i - j;
                    const float wgt = d > 0 ? exp2f(lgf * (float)d) : (d < 0 ? exp2f(lgb * (float)(-d)) : 2.0f);
                    v[e2] = ap[t][4 * g + e2] * wgt; }
                u32x2 o; o.x = pk2(v[0], v[1]); o.y = pk2(v[2], v[3]);
                *(LAS u32x2*)(kP + i * 272 + (64 * wh + 32 * t + 8 * g + 4 * hh) * 2) = o;
            }
        __syncthreads();
    }
    const bool has0 = pass != 0 || c != 0, has1 = pass != 0 || c != nc - 1;
    const bf16_t* ST0 = (const bf16_t*)(p.ws + WS_RST) + ((size_t)(cg * 4 + h) * 2) * 32768;
    NatBuf<256, 4> bs;
    f32x16 acc[4]; zero_acc(acc);
    mma_nx1<4>(acc, vS, 272, 128 * wh, kP, 272, 32 * ib, 8, r, hh);
    __syncthreads();
    if (has0 || has1) { nat_load(bs, has0 ? ST0 : ST0 + 32768, 128, tid); nat_store(bs, vS, 272, tid); }
    __syncthreads();
    if (has0 || has1) {
        f32x16 tmp[4]; zero_acc(tmp);
        mma_nx1<4>(tmp, vS, 272, 128 * wh, qL, 272, 32 * ib, 8, r, hh);
        const float sc = has0 ? exp2f(lgf * (float)(i + 1)) : exp2f(lgb * (float)(128 - i));
#pragma unroll
        for (int t = 0; t < 4; ++t)
#pragma unroll
            for (int q = 0; q < 16; ++q) acc[t][q] += tmp[t][q] * sc;
    }
    if (has0 && has1) {
        __syncthreads();
        nat_load(bs, ST0 + 32768, 128, tid);
        nat_store(bs, vS, 272, tid);
        __syncthreads();
        f32x16 tmp[4]; zero_acc(tmp);
        mma_nx1<4>(tmp, vS, 272, 128 * wh, qL, 272, 32 * ib, 8, r, hh);
        const float sc = exp2f(lgb * (float)(128 - i));
#pragma unroll
        for (int t = 0; t < 4; ++t)
#pragma unroll
            for (int q = 0; q < 16; ++q) acc[t][q] += tmp[t][q] * sc;
    }
    float ss = 0.f;
#pragma unroll
    for (int t = 0; t < 4; ++t)
#pragma unroll
        for (int q = 0; q < 16; ++q) ss += acc[t][q] * acc[t][q];
    ss += __shfl_xor(ss, 32);
    if (hh == 0) red[wh * 128 + i] = ss;
    __syncthreads();
    const float rstd = rsqrtf((red[i] + red[128 + i]) * (1.0f / 256.0f) + EPS);
    const bf16_t* rg = PR + (size_t)i * PROJ_LD + C_RG + h * 256 + 128 * wh;
    bf16_t* O = (bf16_t*)(p.ws + WS_ORET) + (size_t)(pass * PASS_ROWS + cg * 128 + i) * 1024 + h * 256 + 128 * wh;
#pragma unroll
    for (int t = 0; t < 4; ++t)
#pragma unroll
        for (int g = 0; g < 4; ++g) { const int e = 32 * t + 8 * g + 4 * hh; const u32x2 gv = *(const u32x2*)(rg + e);
            u32x2 o; o.x = pk2(acc[t][4 * g] * rstd * bflo(gv.x), acc[t][4 * g + 1] * rstd * bfhi(gv.x)); o.y = pk2(acc[t][4 * g + 2] * rstd * bflo(gv.y), acc[t][4 * g + 3] * rstd * bfhi(gv.y));
            *(u32x2*)(O + e) = o; }
    __syncthreads();
}

DEVI void hg_stage_a(const P& p, ldsp lds, int pass, int item, int tid) {
    const int cg = item >> 3, h = item & 7, lane = tid & 63, w = __builtin_amdgcn_readfirstlane(tid >> 6), r = lane & 31, hh = lane >> 5;
    const bf16_t* PR = (const bf16_t*)(p.ws + WS_PROJ) + (size_t)(cg * 64) * PROJ_LD;
    ldsp graw = lds, vT = lds + 34816, kT = lds + 53248;
    { NatBuf<64, 4> bf, bb; TrBuf<64, 128> bv;
      nat_load(bf, PR + C_GF + h * 128, PROJ_LD, tid); nat_load(bb, PR + C_GB + h * 128, PROJ_LD, tid); tr_load(bv, PR + C_HI + h * 128, PROJ_LD, tid);
      nat_store(bf, graw, 272, tid); nat_store(bb, graw + 17408, 272, tid); tr_store(bv, vT, 144, tid, [](int) { return 1.0f; }); }
    __syncthreads();
    if (tid < 256) {
        const int dir = tid >> 7, dk = tid & 127;
        const LAS bf16_t* g = (const LAS bf16_t*)(graw + dir * 17408) + dk;
        ldsp kd = kT + dir * 18432 + dk * 144;
        float run = 0.f;
        if (dir == 0) {
#pragma unroll 1
            for (int jg = 7; jg >= 0; --jg) {
                float v[8];
#pragma unroll
                for (int jj = 7; jj >= 0; --jj) { const float gv = bf2f(g[(8 * jg + jj) * 136]); v[jj] = (1.0f - __expf(gv)) * __expf(run); run += gv; }
                u32x4 o; o.x = pk2(v[0], v[1]); o.y = pk2(v[2], v[3]); o.z = pk2(v[4], v[5]); o.w = pk2(v[6], v[7]);
                *(LAS u32x4*)(kd + jg * 16) = o;
            }
        } else {
#pragma unroll 1
            for (int jg = 0; jg < 8; ++jg) {
                float v[8];
#pragma unroll
                for (int jj = 0; jj < 8; ++jj) { const float gv = bf2f(g[(8 * jg + jj) * 136]); v[jj] = (1.0f - __expf(gv)) * __expf(run); run += gv; }
                u32x4 o; o.x = pk2(v[0], v[1]); o.y = pk2(v[2], v[3]); o.z = pk2(v[4], v[5]); o.w = pk2(v[6], v[7]);
                *(LAS u32x4*)(kd + jg * 16) = o;
            }
        }
        ((float*)(p.ws + WS_HD))[((size_t)(cg * 8 + h) * 2 + dir) * 128 + dk] = __expf(run);
    }
    __syncthreads();
#pragma unroll 1
    for (int dir = 0; dir < 2; ++dir) {
        f32x16 acc[2]; zero_acc(acc);
        mma_nx1<2>(acc, kT + dir * 18432, 144, 64 * (w >> 2), vT, 144, 32 * (w & 3), 4, r, hh);
        bf16_t* ST = (bf16_t*)(p.ws + WS_HST) + ((size_t)(cg * 8 + h) * 2 + dir) * 16384 + (size_t)(32 * (w & 3) + r) * 128 + 64 * (w >> 2);
#pragma unroll
        for (int t = 0; t < 2; ++t)
#pragma unroll
            for (int g = 0; g < 4; ++g) *(u32x2*)(ST + 32 * t + 8 * g + 4 * hh) = pack4(acc[t], g);
    }
    __syncthreads();
}
DEVI void hg_stage_c(const P& p, ldsp lds, int pass, int item, int tid) {
    const int cg = item >> 3, h = item & 7, lane = tid & 63, w = __builtin_amdgcn_readfirstlane(tid >> 6), r = lane & 31, hh = lane >> 5;
    const int nc = pass == 0 ? 4 : 32, c = cg % nc;
    const bool hasF = pass != 0 || c != 0, hasB = pass != 0 || c != nc - 1;
    const bf16_t* PR = (const bf16_t*)(p.ws + WS_PROJ) + (size_t)(cg * 64) * PROJ_LD;
    ldsp raw = lds, img = lds + 69632, vT = lds + 139264; LAS float* ref = (LAS float*)(lds + 157696); LAS float* red = (LAS float*)(lds + 158720);
    { NatBuf<64, 4> bf, bb, bq; TrBuf<64, 128> bv;
      nat_load(bf, PR + C_GF + h * 128, PROJ_LD, tid); nat_load(bb, PR + C_GB + h * 128, PROJ_LD, tid); nat_load(bq, PR + C_HQ + h * 128, PROJ_LD, tid); tr_load(bv, PR + C_HI + h * 128, PROJ_LD, tid);
      nat_store(bf, raw, 272, tid); nat_store(bb, raw + 17408, 272, tid); nat_store(bq, raw + 34816, 272, tid); tr_store(bv, vT, 144, tid, [](int) { return 1.0f; }); }
    __syncthreads();
    if (tid < 256) {
        const int dir = tid >> 7, dk = tid & 127;
        const LAS bf16_t* g = (const LAS bf16_t*)(raw + dir * 17408) + dk;
        const LAS bf16_t* qr = (const LAS bf16_t*)(raw + 34816) + dk;
        LAS bf16_t* qi = (LAS bf16_t*)(img + dir * 34816) + dk; LAS bf16_t* ki = (LAS bf16_t*)(img + dir * 34816 + 17408) + dk;
        float d = 0.f;
#pragma unroll 4
        for (int t = 0; t < 32; ++t) { const int j = dir == 0 ? 31 - t : 32 + t; const float gv = bf2f(g[j * 136]);
            const float qv = bf2f(qr[j * 136]), kv = 1.0f - __expf(gv);
            qi[j * 136] = (bf16_t)f2bf(qv * __expf(d)); ki[j * 136] = (bf16_t)f2bf(kv * __expf(-d)); d -= gv; }
        ref[dir * 128 + dk] = __expf(-d);
        d = 0.f;
#pragma unroll 4
        for (int t = 0; t < 32; ++t) { const int j = dir == 0 ? 32 + t : 31 - t; const float gv = bf2f(g[j * 136]);
            d += gv;
            const float qv = bf2f(qr[j * 136]), kv = 1.0f - __expf(gv);
            qi[j * 136] = (bf16_t)f2bf(qv * __expf(d)); ki[j * 136] = (bf16_t)f2bf(kv * __expf(-d)); }
    }
    __syncthreads();
    ldsp qF = img, kF = img + 17408, qB = img + 34816, kB = img + 52224, Pm = kF;
    f32x16 af[1], ab[1];
    if (w < 4) {
        zero_acc(af); zero_acc(ab);
        mma_nx1<1>(af, kF, 272, 32 * (w >> 1), qF, 272, 32 * (w & 1), 8, r, hh);
        mma_nx1<1>(ab, kB, 272, 32 * (w >> 1), qB, 272, 32 * (w & 1), 8, r, hh);
    } else {
        const int t2 = tid - 256;
#pragma unroll 1
        for (int dir = 0; dir < 2; ++dir) {
            if (dir == 0 ? !hasF : !hasB) continue;
            const bf16_t* ST = (const bf16_t*)(p.ws + WS_HST) + ((size_t)(cg * 8 + h) * 2 + dir) * 16384;
            for (int u = t2; u < 2048; u += 256) { const int e = u >> 4, ch = u & 15;
                const u32x4 v = *(const u32x4*)(ST + e * 128 + ch * 8);
                const LAS float* rf = ref + dir * 128 + ch * 8;
                u32x4 o;
#pragma unroll
                for (int q = 0; q < 4; ++q) o[q] = pk2(bflo(v[q]) * rf[2 * q], bfhi(v[q]) * rf[2 * q + 1]);
                *(LAS u32x4*)(raw + dir * 34816 + e * 272 + ch * 16) = o; }
        }
    }
    __syncthreads();
    if (w < 4) {
        const int i = 32 * (w & 1) + r;
#pragma unroll
        for (int g = 0; g < 4; ++g) { float v[4];
#pragma unroll
            for (int e2 = 0; e2 < 4; ++e2) { const int j = 32 * (w >> 1) + 8 * g + 4 * hh + e2; v[e2] = (j <= i ? af[0][4 * g + e2] : 0.f) + (j >= i ? ab[0][4 * g + e2] : 0.f); }
            u32x2 o; o.x = pk2(v[0], v[1]); o.y = pk2(v[2], v[3]);
            *(LAS u32x2*)(Pm + i * 144 + (32 * (w >> 1) + 8 * g + 4 * hh) * 2) = o; }
    }
    __syncthreads();
    const int eb = w >> 1, ib = w & 1, i = 32 * ib + r;
    f32x16 acc[1]; zero_acc(acc);
    mma_nx1<1>(acc, vT, 144, 32 * eb, Pm, 144, 32 * ib, 4, r, hh);
    if (hasF) mma_nx1<1>(acc, raw, 272, 32 * eb, qF, 272, 32 * ib, 8, r, hh);
    if (hasB) mma_nx1<1>(acc, raw + 34816, 272, 32 * eb, qB, 272, 32 * ib, 8, r, hh);
    float ss = 0.f;
#pragma unroll
    for (int q = 0; q < 16; ++q) ss += acc[0][q] * acc[0][q];
    ss += __shfl_xor(ss, 32);
    if (hh == 0) red[eb * 64 + i] = ss;
    __syncthreads();
    const float rstd = rsqrtf((red[i] + red[64 + i] + red[128 + i] + red[192 + i]) * (1.0f / 128.0f) + EPS);
    const bf16_t* og = PR + (size_t)i * PROJ_LD + C_HOG + h * 128 + 32 * eb;
    const float* nw = p.in[16] + h * 128 + 32 * eb;
    bf16_t* O = (bf16_t*)(p.ws + WS_OHG) + (size_t)(pass * PASS_ROWS + cg * 64 + i) * 1024 + h * 128 + 32 * eb;
#pragma unroll
    for (int g = 0; g < 4; ++g) { const int e = 8 * g + 4 * hh; const u32x2 gv = *(const u32x2*)(og + e); const f32x4 n4 = *(const f32x4*)(nw + e);
        u32x2 o; o.x = pk2(acc[0][4 * g] * rstd * n4[0] * bflo(gv.x), acc[0][4 * g + 1] * rstd * n4[1] * bfhi(gv.x));
        o.y = pk2(acc[0][4 * g + 2] * rstd * n4[2] * bflo(gv.y), acc[0][4 * g + 3] * rstd * n4[3] * bfhi(gv.y));
        *(u32x2*)(O + e) = o; }
    __syncthreads();
}
DEVI int scan_nitems(int b, int G) { return G == 256 ? (b < 128 ? 2 : 3) : (640 - b + G - 1) / G; }
DEVI int scan_item(int b, int G, int k) { return G == 256 ? (b < 128 ? (k == 0 ? b : 128 + b) : 256 + (b - 128) * 3 + k) : b + k * G; }
#undef SCAN_A
#undef SCAN_B
#undef SCAN_C
#define SCAN_A { int tid = threadIdx.x; asm volatile("" : "+v"(tid)); const int n_ = scan_nitems(blockIdx.x, G); \
    for (int k_ = 0; k_ < n_; ++k_) { const int it_ = scan_item(blockIdx.x, G, k_); int t2_ = tid; asm volatile("" : "+v"(t2_)); if (it_ < 128) ret_stage_a(p, lds, pass, it_, t2_); else hg_stage_a(p, lds, pass, it_ - 128, t2_); } }
#define SCAN_B { int tid = threadIdx.x; asm volatile("" : "+v"(tid)); scan_stage_b(p, pass, tid, G); }
#define SCAN_C { int tid = threadIdx.x; asm volatile("" : "+v"(tid)); const int n_ = scan_nitems(blockIdx.x, G); \
    for (int k_ = 0; k_ < n_; ++k_) { const int it_ = scan_item(blockIdx.x, G, k_); int t2_ = tid; asm volatile("" : "+v"(t2_)); if (it_ < 128) ret_stage_c(p, lds, pass, it_, t2_); else hg_stage_c(p, lds, pass, it_ - 128, t2_); } }

constexpr int NWAVES = 8;
constexpr int LDS_BYTES = 163840;


DEVI float wave_sum(float v) {
#pragma unroll
    for (int o = 1; o < 64; o <<= 1) v += __shfl_xor(v, o);
    return v;
}

DEVI int map_row(int mode, int n) {
    if (mode == 1) { const int s = n >= 2816 ? 1 : 0, j = n - s * 2816; return 256 * (j >> 7) + 128 * s + (j & 127); }
    if (mode == 2) { if (n >= 1024) return n; const int t = n >> 8, q = n & 255, hh = q >> 7, part = (q >> 6) & 1, bj = (q >> 5) & 1, i = q & 31; return 256 * t + 128 * bj + 64 * hh + 32 * part + i; }
    return n;
}
DEVI void transpose_item(const float* __restrict__ W, int ldw, int n_base, bf16_t* __restrict__ WT, int Kdst, int koff, int mode, LAS float* scr, int item, int nblk, int lane) {
    const int kb = item / nblk, nb = item - kb * nblk, k0 = 64 * kb, n0 = 32 * nb;
#pragma unroll 8
    for (int i = 0; i < 32; ++i) { const int kk = 2 * i + (lane >> 5); scr[kk * 33 + (lane & 31)] = W[(size_t)(k0 + kk) * ldw + n_base + n0 + (lane & 31)]; }
    asm volatile("s_waitcnt lgkmcnt(0)" ::: "memory");
    const int c = lane & 7;
#pragma unroll
    for (int j = 0; j < 4; ++j) { const int n = (lane >> 3) + 8 * j; const LAS float* s = scr + (8 * c) * 33 + n;
        u32x4 o; o.x = pk2(s[0 * 33], s[1 * 33]); o.y = pk2(s[2 * 33], s[3 * 33]); o.z = pk2(s[4 * 33], s[5 * 33]); o.w = pk2(s[6 * 33], s[7 * 33]);
        *(u32x4*)(WT + (size_t)map_row(mode, n0 + n) * Kdst + koff + k0 + 8 * c) = o; }
    asm volatile("s_waitcnt lgkmcnt(0)" ::: "memory");
}
constexpr int I13 = 16 * 176, I2 = 44 * 32, IWIN = 16 * 256, IWG = 16 * 64, ISQ = 16 * 32;
constexpr int CV_G0 = I13, CV_G1 = I13 + I2 + I13 + I2, CV_ALL = 2 * I13 + 2 * I2 + IWIN + IWG + 3 * ISQ;
DEVI void convert_items(const P& p, ldsp lds, int lane, int wave, int first, int last, int worker, int nworkers) {
    LAS float* scr = (LAS float*)(lds + 32768 + wave * 8704);
    unsigned char* ws = p.ws;
    for (int it = first + worker * NWAVES + wave; it < last; it += nworkers * NWAVES) {
        int r = it;
        if (r < I13) { transpose_item(p.in[9], 5632, 0, (bf16_t*)(ws + WS_W13A), 1024, 0, 1, scr, r, 176, lane); continue; } r -= I13;
        if (r < I2) { transpose_item(p.in[10], 1024, 0, (bf16_t*)(ws + WS_W2A), 2816, 0, 0, scr, r, 32, lane); continue; } r -= I2;
        if (r < I13) { transpose_item(p.in[11], 5632, 0, (bf16_t*)(ws + WS_W13B), 1024, 0, 1, scr, r, 176, lane); continue; } r -= I13;
        if (r < I2) { transpose_item(p.in[12], 1024, 0, (bf16_t*)(ws + WS_W2B), 2816, 0, 0, scr, r, 32, lane); continue; } r -= I2;
        if (r < IWIN) { transpose_item(p.in[13], WIN_N, 0, (bf16_t*)(ws + WS_WIN), 1024, 0, 2, scr, r, 256, lane); continue; } r -= IWIN;
        if (r < IWG) { transpose_item(p.in[13], WIN_N, W_GR, (bf16_t*)(ws + WS_WG), 1024, 0, 0, scr, r, 64, lane); continue; } r -= IWG;
        if (r < ISQ) { transpose_item(p.in[17], 1024, 0, (bf16_t*)(ws + WS_WR), 1024, 0, 0, scr, r, 32, lane); continue; } r -= ISQ;
        if (r < ISQ) { transpose_item(p.in[18], 1024, 0, (bf16_t*)(ws + WS_WH), 1024, 0, 0, scr, r, 32, lane); continue; } r -= ISQ;
        transpose_item(p.in[19], 1024, 0, (bf16_t*)(ws + WS_WO), 1024, 0, 0, scr, r, 32, lane);
    }
}
DEVI void phase_prologue(const P& p, ldsp lds, int tid, int lane, int wave, int G) {
    if ((int)blockIdx.x < 144) {
        LAS float* sc = (LAS float*)lds;
        LAS float* red = sc + 5 * 1024;
        for (int i = tid; i < 5 * 1024; i += 512) { const int r = i >> 10, k = i & 1023; const float v = r == 0 ? p.in[5][k] : p.in[4][(r - 1) * 1024 + k]; sc[i] = siluf_(v); }
        __syncthreads();
        const int col = blockIdx.x * 64 + lane;
        const float* W = p.in[6];
        float a0 = 0.f, a1 = 0.f, a2 = 0.f, a3 = 0.f, a4 = 0.f;
#pragma unroll 8
        for (int kk = 0; kk < 128; ++kk) { const int k = wave * 128 + kk; const float w = W[(size_t)k * NMOD + col];
            a0 += sc[k] * w; a1 += sc[1024 + k] * w; a2 += sc[2048 + k] * w; a3 += sc[3072 + k] * w; a4 += sc[4096 + k] * w; }
        red[(wave * 5 + 0) * 64 + lane] = a0; red[(wave * 5 + 1) * 64 + lane] = a1; red[(wave * 5 + 2) * 64 + lane] = a2; red[(wave * 5 + 3) * 64 + lane] = a3; red[(wave * 5 + 4) * 64 + lane] = a4;
        __syncthreads();
        if (tid < 320) { const int r = tid >> 6, l = tid & 63; float s = 0.f;
#pragma unroll
            for (int w = 0; w < 8; ++w) s += red[(w * 5 + r) * 64 + l];
            const int cc = blockIdx.x * 64 + l;
            ((float*)(p.ws + WS_MOD))[r * NMOD + cc] = s + p.in[7][cc]; }
        __syncthreads();
    }
    if ((int)blockIdx.x == G - 1) {
        for (int i = tid; i < 2048; i += 512) {
            const int d = i >> 10, k = i & 1023;
            const float l0 = p.in[15][(d * 2 + 0) * 1024 + k], l1 = p.in[15][(d * 2 + 1) * 1024 + k];
            ((float*)(p.ws + WS_LB))[i] = 1.0f / (1.0f + expf(l1 - l0));
            const int pos = i >> 5, fi = i & 31;
            const double inv = exp(-(double)fi / 32.0 * log(10000.0));
            const float angf = (float)pos * (float)inv;
            double a = (double)angf; const double twopi = 6.283185307179586476925;
            a -= twopi * rint(a / twopi);
            double s = 0.0, c = 0.0, a2 = a * a, tc = 1.0, ts = a;
            for (int n = 0; n < 14; ++n) { c += tc; s += ts; tc *= -a2 / ((2 * n + 1) * (2 * n + 2)); ts *= -a2 / ((2 * n + 2) * (2 * n + 3)); }
            float* rt = (float*)(p.ws + WS_ROPE); rt[i * 2] = (float)c; rt[i * 2 + 1] = (float)s;
        }
    }
    convert_items(p, lds, lane, wave, 0, CV_G0, blockIdx.x, G);
}

template <int RB> DEVI void modnorm_rows(const P& p, int which, int lane, int m0, int mstep, int nrows) {
    f32x4 v[RB][4];
#pragma unroll
    for (int k = 0; k < RB; ++k) { const int m = m0 + k * mstep; if (k < nrows) {
        const float* xr = which == 0 ? (m < MP ? p.in[0] + (size_t)m * D : p.in[1] + (size_t)(m - MP) * D) : p.out + (size_t)m * D;
#pragma unroll
        for (int j = 0; j < 4; ++j) v[k][j] = *(const f32x4*)(xr + 4 * lane + 256 * j); } }
    f32x4 w[4];
    const float* nw = which == 3 ? p.in[20] : p.in[8] + which * D;
#pragma unroll
    for (int j = 0; j < 4; ++j) w[j] = *(const f32x4*)(nw + 4 * lane + 256 * j);
#pragma unroll
    for (int k = 0; k < RB; ++k) { const int m = m0 + k * mstep; if (k < nrows) {
        float ss = 0.f;
#pragma unroll
        for (int j = 0; j < 4; ++j) ss += (v[k][j][0] * v[k][j][0] + v[k][j][1] * v[k][j][1]) + (v[k][j][2] * v[k][j][2] + v[k][j][3] * v[k][j][3]);
        const float rstd = rsqrtf(wave_sum(ss) * (1.0f / D) + EPS);
        if (which == 3) {
            float* o = p.out + (size_t)m * D;
#pragma unroll
            for (int j = 0; j < 4; ++j) *(f32x4*)(o + 4 * lane + 256 * j) = v[k][j] * rstd * w[j];
        } else {
            const float* mod = (const float*)(p.ws + WS_MOD) + (size_t)mod_row(m) * NMOD;
            const float* sh = mod + (which * 3) * D; const float* sc = mod + (which * 3 + 1) * D;
            bf16_t* h = (bf16_t*)(p.ws + WS_H) + (size_t)m * D;
#pragma unroll
            for (int j = 0; j < 4; ++j) { const int c = 4 * lane + 256 * j;
                const f32x4 s4 = *(const f32x4*)(sc + c), h4 = *(const f32x4*)(sh + c);
                const f32x4 y = v[k][j] * rstd * w[j] * (s4 + 1.0f) + h4;
                u32x2 o; o.x = pk2(y[0], y[1]); o.y = pk2(y[2], y[3]); *(u32x2*)(h + c) = o; }
        } } }
}
DEVI void phase_modnorm(const P& p, int which, int lane, int wave, int G) {
    const int gw = blockIdx.x * NWAVES + wave, NGW = G * NWAVES;
    for (int m = gw; m < MT; m += 6 * NGW) { const int left = (MT - m + NGW - 1) / NGW; modnorm_rows<6>(p, which, lane, m, NGW, left < 6 ? left : 6); }
}

typedef GAS unsigned gu32;
#define RLX_AGENT __ATOMIC_RELAXED, __HIP_MEMORY_SCOPE_AGENT
constexpr size_t WS_BAR = 256 * 1024;
#define XB_TMO      128
#define XB_XCNT(j)  (256  + 64 * (j))
#define XB_XSUB(j)  (1280 + 64 * (j))
#define XB_XGEN(j)  (2304 + 64 * (j))
#define XB_TOP      3328
#define XB_TOPGEN   3392
#define XCD_BAR_WORDS 3456
#define XB_SPIN_CAP (1u << 18)

__device__ __forceinline__ unsigned xb_ld(unsigned* p)              { return __hip_atomic_load(p, __ATOMIC_RELAXED, __HIP_MEMORY_SCOPE_AGENT); }
__device__ __forceinline__ unsigned xb_add(unsigned* p, unsigned v) { return __hip_atomic_fetch_add(p, v, __ATOMIC_RELAXED, __HIP_MEMORY_SCOPE_AGENT); }
__device__ __forceinline__ unsigned xb_xcc_id() { return (unsigned)__builtin_amdgcn_s_getreg((3 << 11) | 20) & 0xFu; }
#define XB_SPIN(cond, bar) do { unsigned _sp = 0; while (cond) { __builtin_amdgcn_s_sleep(1); \
    if ((++_sp & 255u) == 0u) { if (xb_ld(&(bar)[XB_TMO])) break; if (_sp > XB_SPIN_CAP) { atomicAdd(&(bar)[XB_TMO], 1u); break; } } } } while (0)

struct XcdBarrier {
    unsigned* bar; unsigned x;
    volatile LAS unsigned* st;
};

__device__ __forceinline__ XcdBarrier xcd_barrier_post(unsigned* bar, volatile LAS unsigned* st) {
    XcdBarrier b; b.bar = bar; b.x = xb_xcc_id(); b.st = st;
    if (threadIdx.x == 0) (void)xb_add(&bar[XB_XCNT(b.x)], 1u);
    return b;
}
__device__ __forceinline__ void xcd_barrier_complete(unsigned* bar, unsigned x, unsigned& nloc, unsigned& nx) {
    const unsigned G = gridDim.x * gridDim.y * gridDim.z;
    unsigned sum, cnt, mine, sp = 0u;
    for (;;) {
        sum = 0u; cnt = 0u; mine = 0u;
#pragma unroll
        for (unsigned j = 0; j < 16; ++j) { const unsigned c = xb_ld(&bar[XB_XCNT(j)]); sum += c; cnt += (c > 0u) ? 1u : 0u; mine = (j == x) ? c : mine; }
        if (sum == G) break;
        __builtin_amdgcn_s_sleep(1);
        if ((++sp & 255u) == 0u) { if (xb_ld(&bar[XB_TMO])) break; if (sp > XB_SPIN_CAP) { atomicAdd(&bar[XB_TMO], 1u); break; } }
    }
    nloc = mine > 0u ? mine : 1u; nx = cnt > 0u ? cnt : 1u;
}

__device__ __forceinline__ void xcd_barrier(const XcdBarrier& b) {
    asm volatile("s_waitcnt vmcnt(0)" ::: "memory");
    __syncthreads();
    if (threadIdx.x == 0) {
        unsigned* bar = b.bar;
        __builtin_amdgcn_s_waitcnt(0);
        unsigned nloc = b.st[0], nx = b.st[1];
        if (nloc == 0u) { xcd_barrier_complete(bar, b.x, nloc, nx); b.st[0] = nloc; b.st[1] = nx; }
        const unsigned old = xb_add(&bar[XB_XSUB(b.x)], 1u);
        const unsigned gen = old / nloc;
        if (old + 1u == (gen + 1u) * nloc) {
            __builtin_amdgcn_fence(__ATOMIC_RELEASE, "agent");
            asm volatile("s_waitcnt vmcnt(0)" ::: "memory");
            const unsigned og = xb_add(&bar[XB_TOP], 1u);
            const unsigned tg = og / nx;
            if (og + 1u == (tg + 1u) * nx) xb_add(&bar[XB_TOPGEN], 1u);
            else XB_SPIN(xb_ld(&bar[XB_TOPGEN]) == tg, bar);
            __builtin_amdgcn_fence(__ATOMIC_ACQUIRE, "agent");
            xb_add(&bar[XB_XGEN(b.x)], 1u);
            asm volatile("s_waitcnt vmcnt(0)" ::: "memory");
        } else {
            XB_SPIN(xb_ld(&bar[XB_XGEN(b.x)]) == gen, bar);
            __builtin_amdgcn_fence(__ATOMIC_ACQUIRE, "agent");
            asm volatile("s_waitcnt vmcnt(0)" ::: "memory");
        }
    }
    __syncthreads();
}

#ifndef PHMASK
#define PHMASK 0xffff
#endif
#define PH(k) if (p.lo <= (k) && (k) < p.hi)
#define SYNC(k) do { if (p.lo <= (k) && (k) + 1 < p.hi) { if (p.hi > 1000) { asm volatile("s_waitcnt vmcnt(0) lgkmcnt(0)" ::: "memory"); cg::this_grid().sync(); } else xcd_barrier(bar); } } while (0)
#define GEMM_UP(WOFF) do { pg8::Gemm g{(const bf16_t*)(ws + WS_H), (const bf16_t*)(ws + (WOFF)), MT, 2 * FF, D}; \
    pg8::StaticOrder S; S.init(MT, 2 * FF, G, (int)blockIdx.x); pg8::EpiSwiglu E{(bf16_t*)(ws + WS_PROJ)}; \
    pg8::gemm_phase<pg8::EpiSwiglu, pg8::StaticOrder, true, true>(lds, g, S, E); } while (0)
#define GEMM_RES(AOFF, WOFF, KK, XP, XS, GIDX, SCL) do { pg8::Gemm g{(const bf16_t*)(ws + (AOFF)), (const bf16_t*)(ws + (WOFF)), MT, D, (KK)}; \
    pg8::StaticOrder S; S.init(MT, D, G, (int)blockIdx.x); pg8::EpiResid E{(XP), (XS), p.out, (const float*)(ws + WS_MOD), (GIDX), (SCL)}; \
    pg8::gemm_phase<pg8::EpiResid, pg8::StaticOrder, true, true>(lds, g, S, E); } while (0)

__global__ void __launch_bounds__(NWAVES * 64, 2) mk(P p) {
    extern __shared__ __attribute__((aligned(16))) unsigned char lds_raw[];
    ldsp lds = (ldsp)lds_raw;
    const int G = gridDim.x;
    unsigned char* ws = p.ws;
    volatile LAS unsigned* bst = (volatile LAS unsigned*)(lds + LDS_BYTES - 16);
    if (threadIdx.x < 2) bst[threadIdx.x] = 0u;
    __syncthreads();
    const XcdBarrier bar = xcd_barrier_post((unsigned*)(ws + WS_BAR), bst);
#define TIDS int tid = threadIdx.x; asm volatile("" : "+v"(tid)); const int lane = tid & 63, wave = __builtin_amdgcn_readfirstlane(tid >> 6); (void)lane; (void)wave;
    PH(0) { if (PHMASK & 1) { TIDS phase_prologue(p, lds, tid, lane, wave, G); } } SYNC(0);
    PH(1) { if (PHMASK & 2) { TIDS phase_modnorm(p, 0, lane, wave, G); } } SYNC(1);
    PH(2) { if (PHMASK & 4) GEMM_UP(WS_W13A);
        { const int idle0 = (MT / 256) * (2 * FF / 256) - 4 * G;
          if (G == 256 && (int)blockIdx.x >= idle0) { TIDS convert_items(p, lds, lane, wave, CV_G0, CV_G1, blockIdx.x - idle0, G - idle0); }
          else if (G != 256) { TIDS convert_items(p, lds, lane, wave, CV_G0, CV_G1, blockIdx.x, G); } } } SYNC(2);
    PH(3) { if (PHMASK & 8) GEMM_RES(WS_PROJ, WS_W2A, FF, p.in[0], p.in[1], 2, 0.5f);
        { const int idle0 = (MT / 256) * (D / 256);
          if (G == 256 && (int)blockIdx.x >= idle0) { TIDS convert_items(p, lds, lane, wave, CV_G1, CV_ALL, blockIdx.x - idle0, G - idle0); }
          else if (G != 256) { TIDS convert_items(p, lds, lane, wave, CV_G1, CV_ALL, blockIdx.x, G); } } } SYNC(3);
    PH(4) { if (PHMASK & 2) { TIDS phase_modnorm(p, 1, lane, wave, G); } } SYNC(4);
    for (int pass = 0; pass < 3; ++pass) {
        const int b = 5 + 4 * pass;
        PH(b) { if (PHMASK & 16) {
            pg8::Gemm g{(const bf16_t*)(ws + WS_H) + (size_t)pass * PASS_ROWS * D, (const bf16_t*)(ws + WS_WIN), PASS_ROWS, NPROJ, D};
            pg8::StaticOrder S; S.init(PASS_ROWS, NPROJ, G, (int)blockIdx.x);
            pg8::EpiWin E{(bf16_t*)(ws + WS_PROJ), (const float*)(ws + WS_LB), (const float*)(ws + WS_ROPE), pass};
            pg8::gemm_phase<pg8::EpiWin, pg8::StaticOrder, true, true>(lds, g, S, E); } } SYNC(b);
        PH(b + 1) { SCAN_A } SYNC(b + 1);
        PH(b + 2) { SCAN_B } SYNC(b + 2);
        PH(b + 3) { SCAN_C } SYNC(b + 3);
    }
    PH(17) { if (PHMASK & 32) {
        pg8::Gemm g{(const bf16_t*)(ws + WS_H), (const bf16_t*)(ws + WS_WG), MT, 2048, D};
        pg8::StaticOrder S; S.init(MT, 2048, G, (int)blockIdx.x);
        pg8::EpiGates E{(bf16_t*)(ws + WS_PROJ)};
        pg8::gemm_phase<pg8::EpiGates, pg8::StaticOrder, true, true>(lds, g, S, E); } } SYNC(17);
    PH(18) { if (PHMASK & 64) {
        { pg8::Gemm g{(const bf16_t*)(ws + WS_ORET), (const bf16_t*)(ws + WS_WR), MT, D, D};
          pg8::StaticOrder S; S.init(MT, D, G, (int)blockIdx.x);
          pg8::EpiMergeA E{(const bf16_t*)(ws + WS_PROJ), (float*)(ws + WS_ST)};
          pg8::gemm_phase<pg8::EpiMergeA, pg8::StaticOrder, true, true>(lds, g, S, E); }
        { pg8::Gemm g{(const bf16_t*)(ws + WS_OHG), (const bf16_t*)(ws + WS_WH), MT, D, D};
          pg8::StaticOrder S; S.init(MT, D, G, (int)blockIdx.x);
          pg8::EpiMergeB E{(const bf16_t*)(ws + WS_PROJ), (const float*)(ws + WS_ST), (bf16_t*)(ws + WS_H)};
          pg8::gemm_phase<pg8::EpiMergeB, pg8::StaticOrder, true, true>(lds, g, S, E); } } } SYNC(18);
    PH(19) { if (PHMASK & 8) GEMM_RES(WS_H, WS_WO, D, p.out, p.out + (size_t)MP * D, 5, 1.0f); } SYNC(19);
    PH(20) { if (PHMASK & 2) { TIDS phase_modnorm(p, 2, lane, wave, G); } } SYNC(20);
    PH(21) { if (PHMASK & 4) GEMM_UP(WS_W13B); } SYNC(21);
    PH(22) { if (PHMASK & 8) GEMM_RES(WS_PROJ, WS_W2B, FF, p.out, p.out + (size_t)MP * D, 8, 0.5f); } SYNC(22);
    PH(23) { if (PHMASK & 2) { TIDS phase_modnorm(p, 3, lane, wave, G); } }
}

static int g_grid = 0;
static void launch_mk(const P& base, int lo, int hi, hipStream_t stream, bool coop) {
    P p = base; p.lo = lo; p.hi = hi;
    if (coop) { void* args[] = {&p}; hipError_t e = hipLaunchCooperativeKernel((void*)mk, dim3(g_grid), dim3(NWAVES * 64), args, LDS_BYTES, stream);
        if (e != hipSuccess) fprintf(stderr, "cooperative launch failed: %s (grid %d)\n", hipGetErrorString(e), g_grid); }
    else hipLaunchKernelGGL(mk, dim3(g_grid), dim3(NWAVES * 64), LDS_BYTES, stream, p);
}

extern "C" void kernel_launch(void* const* d_in, const int* in_sizes, int n_in, void* d_out, int out_size, void* d_ws, size_t ws_size, hipStream_t stream) {
    if (g_grid == 0) {
        int dev = 0, cus = 0, per_cu = 0;
        hipGetDevice(&dev);
        hipDeviceGetAttribute(&cus, hipDeviceAttributeMultiprocessorCount, dev);
        hipFuncSetAttribute((const void*)mk, hipFuncAttributeMaxDynamicSharedMemorySize, LDS_BYTES);
        hipOccupancyMaxActiveBlocksPerMultiprocessor(&per_cu, (const void*)mk, NWAVES * 64, LDS_BYTES);
        if (per_cu < 1) per_cu = 1;
        g_grid = cus * per_cu;
        (void)hipGetLastError();
    }
    P p{};
    for (int i = 0; i < 21; ++i) p.in[i] = (const float*)d_in[i];
    p.out = (float*)d_out; p.ws = (unsigned char*)d_ws;
#if HYBRID
    launch_mk(p, 0, 5, stream, true);
    for (int pass = 0; pass < 3; ++pass) {
        const int nseq = pass == 0 ? 16 : 2;
        launch_mk(p, 5 + 4 * pass, 9 + 4 * pass, stream, true);
#if HYBRID == 2 || HYBRID == 4
        k_ret_scan<<<nseq * 8, 256, 0, stream>>>(p, pass);
        k_ret_fin<<<PASS_ROWS * 4 / 4, 256, 0, stream>>>(p, pass);
#endif
#if HYBRID == 3 || HYBRID == 4
        k_hg_scan<<<nseq * 16, 128, 0, stream>>>(p, pass);
        k_hg_fin<<<PASS_ROWS * 8 / 4, 256, 0, stream>>>(p, pass);
#endif
    }
    launch_mk(p, 17, 24, stream, true);
#else
    (void)hipMemsetAsync((char*)d_ws + WS_BAR, 0, 16384, stream);
    launch_mk(p, 0, 24, stream, true);
#endif
}
```

```cpp
#include <hip/hip_runtime.h>
#include <hip/hip_cooperative_groups.h>
#include <cstdint>
#include <cstdio>
namespace cg = cooperative_groups;

#define DEVI __device__ __forceinline__
#define LAS __attribute__((address_space(3)))
#define GAS __attribute__((address_space(1)))

constexpr int D = 1024, MP = 4096, MS = 8192, MT = 12288, FF = 2816, NPROJ = 8192, NMOD = 9 * 1024;
constexpr int PASS_ROWS = 4096;
constexpr int PROJ_LD = 8192 + 64;
constexpr float EPS = 1e-6f;
constexpr int C_RQ = 0, C_RK = 512, C_RV = 1024, C_RG = 2048, C_HQ = 3072, C_GF = 4096, C_GB = 5120, C_HI = 6144, C_HOG = 7168;
constexpr int W_GR = 8192, WIN_N = 10240;
constexpr float QK_SCALE = 0.08838834764831845f;

constexpr size_t MiB = 1u << 20;
constexpr size_t WS_MOD = 0;
constexpr size_t WS_LB = 192 * 1024;
constexpr size_t WS_ROPE = 200 * 1024;
constexpr size_t WS_W13A = 1 * MiB, WS_W2A = 12 * MiB, WS_W13B = 18 * MiB, WS_W2B = 29 * MiB;
constexpr size_t WS_WIN = 35 * MiB, WS_WG = 51 * MiB, WS_WR = 55 * MiB, WS_WH = 57 * MiB, WS_WO = 59 * MiB;
constexpr size_t WS_H = 61 * MiB;
constexpr size_t WS_ORET = 85 * MiB, WS_OHG = 109 * MiB;
constexpr size_t WS_PROJ = 133 * MiB;
constexpr size_t WS_ST = 199 * MiB;

typedef unsigned short bf16_t;
typedef float f32x4 __attribute__((ext_vector_type(4)));
typedef float f32x2 __attribute__((ext_vector_type(2)));
typedef unsigned u32x4 __attribute__((ext_vector_type(4)));
typedef unsigned u32x2 __attribute__((ext_vector_type(2)));
typedef short bf16x8 __attribute__((ext_vector_type(8)));

struct P {
    const float* in[21];
    float* out;
    unsigned char* ws;
    int lo, hi;
};

DEVI float bf2f(bf16_t v) { return __uint_as_float(((unsigned)v) << 16); }
DEVI unsigned f2bf(float f) { unsigned u = __float_as_uint(f); return (u + 0x7fffu + ((u >> 16) & 1u)) >> 16; }
typedef __bf16 bf16x2_t __attribute__((ext_vector_type(2)));
DEVI unsigned pk2(float lo, float hi) { bf16x2_t v; v[0] = (__bf16)lo; v[1] = (__bf16)hi; return __builtin_bit_cast(unsigned, v); }
DEVI float bflo(unsigned w) { return __uint_as_float(w << 16); }
DEVI float bfhi(unsigned w) { return __uint_as_float(w & 0xffff0000u); }
DEVI float sigmoidf_(float x) { return 1.0f / (1.0f + __expf(-x)); }
DEVI float siluf_(float x) { return x / (1.0f + __expf(-x)); }
DEVI int mod_row(int m) { return m < MP ? 0 : 1 + ((m - MP) >> 11); }

typedef LAS unsigned char* ldsp;
#define HYBRID 0
namespace pg8 {
#define PG8_LAS __attribute__((address_space(3)))
typedef unsigned short bf16_t;
typedef short bf16x8 __attribute__((ext_vector_type(8)));
typedef float f32x4 __attribute__((ext_vector_type(4)));
typedef unsigned u32x4 __attribute__((ext_vector_type(4)));
constexpr int BM = 256, BK = 64, HALF = 128, HTB = HALF * BK * 2  , STAGE_BYTES = 8 * HTB, NXCD = 8, WGM = 8;

__host__ __device__ __forceinline__ int lds_byte(int r, int c) { const int st = (r >> 4) * 2 + (c >> 5), rr = r & 15, cc = c & 31, ob = rr * 64 + cc * 2; return st * 1024 + (ob ^ (((ob >> 9) & 1) << 5)); }
__host__ __device__ __forceinline__ void stage_rc(int b, int& R, int& C) { const int st = b / 1024, sb = b % 1024, swz = sb ^ (((sb >> 9) & 1) << 5); R = (st >> 1) * 16 + swz / 64; C = (st & 1) * 32 + (swz % 64) / 2; }
__host__ __device__ __forceinline__ int perm32(int rho) { const int n = rho >> 4, i = rho & 15; return 8 * (i >> 2) + 4 * n + (i & 3); }

struct Unit { int pm, pn; };
struct Gemm { const bf16_t* A; const bf16_t* Bt; int M, N, K; };

struct StaticOrder {
    int nM, nN, nwg, G, c;
    __host__ __device__ void init(int M, int N, int G_, int c_) { nM = M / BM; nN = N / BM; nwg = nM * nN; G = G_; c = c_; }
    __host__ __device__ bool next(int i, Unit& u) const {
        const long L = (long)i * G + c; if (L >= nwg) return false;
        int wgid = (int)L; { const int q = nwg / NXCD, r = nwg % NXCD, xcd = wgid % NXCD, off = wgid / NXCD; wgid = (xcd < r ? xcd * (q + 1) : r * (q + 1) + (xcd - r) * q) + off; }
        const int nig = WGM * nN, gid = wgid / nig, fm = gid * WGM, gsz = (nM - fm) < WGM ? (nM - fm) : WGM;
        u.pm = fm + ((wgid % nig) % gsz); u.pn = (wgid % nig) / gsz; return true;
    }
    __device__ __forceinline__ void a_ready(const Unit&) const {}
    __device__ __forceinline__ void done(const Unit&) const {}
};


struct EpiSwiglu {
    static constexpr bool PERM = true, AFTER_DRAIN = false, HAS_MID = false;
    bf16_t* act;
    __device__ __forceinline__ void mid(f32x4 (&)[2][2][4][2], const Unit&, int, int, int, int) const {}
    __device__ __forceinline__ void operator()(const f32x4 (&acc)[2][2][4][2], const Unit& u, int wr, int wc, int fr, int fq) const {
        const int row0 = u.pm * BM + wr * 64 + fr, col0 = u.pn * 128 + wc * 32 + 8 * fq;
#pragma unroll
        for (int ai = 0; ai < 2; ++ai)
#pragma unroll
            for (int m = 0; m < 4; ++m) {
                float v[8];
#pragma unroll
                for (int n = 0; n < 2; ++n)
#pragma unroll
                    for (int e = 0; e < 4; ++e) { const float a = acc[ai][0][m][n][e], b = acc[ai][1][m][n][e]; v[n * 4 + e] = a * __builtin_amdgcn_rcpf(1.0f + __expf(-a)) * b; }
                u32x4 w; w.x = ::pk2(v[0], v[1]); w.y = ::pk2(v[2], v[3]); w.z = ::pk2(v[4], v[5]); w.w = ::pk2(v[6], v[7]);
                *(u32x4*)(act + (size_t)(row0 + ai * HALF + m * 16) * 2816 + col0) = w;
            }
    }
};
struct EpiResid {
    static constexpr bool PERM = false, AFTER_DRAIN = false, HAS_MID = false;
    const float* xp; const float* xs; float* out; const float* mod; int gidx; float scale;
    __device__ __forceinline__ void mid(f32x4 (&)[2][2][4][2], const Unit&, int, int, int, int) const {}
    __device__ __forceinline__ void operator()(const f32x4 (&acc)[2][2][4][2], const Unit& u, int wr, int wc, int fr, int fq) const {
        const int rowt = u.pm * BM, row0 = rowt + wr * 64 + fr, col0 = u.pn * BM + wc * 32 + 4 * fq;
        const float* gate = mod + (size_t)(rowt < 4096 ? 0 : 1 + ((rowt - 4096) >> 11)) * 9216 + gidx * 1024;
        const float* xb = rowt < 4096 ? xp : xs - (size_t)4096 * 1024;
#pragma unroll
        for (int bj = 0; bj < 2; ++bj)
#pragma unroll
            for (int n = 0; n < 2; ++n) {
                const int c = col0 + bj * HALF + n * 16;
                const f32x4 g4 = *(const f32x4*)(gate + c) * scale;
#pragma unroll
                for (int ai = 0; ai < 2; ++ai)
#pragma unroll
                    for (int m = 0; m < 4; ++m) { const size_t off = (size_t)(row0 + ai * HALF + m * 16) * 1024 + c;
                        const f32x4 xin = *(const f32x4*)(xb + off); *(f32x4*)(out + off) = xin + g4 * acc[ai][bj][m][n]; }
            }
    }
};
struct EpiWin {
    static constexpr bool PERM = true, AFTER_DRAIN = false, HAS_MID = false;
    bf16_t* PR; const float* lb; const float* rope; int pass;
    __device__ __forceinline__ void mid(f32x4 (&)[2][2][4][2], const Unit&, int, int, int, int) const {}
    __device__ __forceinline__ void operator()(const f32x4 (&acc)[2][2][4][2], const Unit& u, int wr, int wc, int fr, int fq) const {
        const int row0 = u.pm * BM + wr * 64 + fr;
        if (u.pn < 4) {
            const int hh = wc >> 1, part = wc & 1, i0 = 8 * fq;
            const float sc = u.pn >= 2 ? 0.08838834764831845f : 1.0f;
#pragma unroll
            for (int ai = 0; ai < 2; ++ai)
#pragma unroll
                for (int m = 0; m < 4; ++m) {
                    const int row = row0 + ai * HALF + m * 16;
                    float cs[8], sn[8];
                    if (pass > 0) { const int t = row & 2047; const int pos = part ? (t & 63) : (t >> 6);
                        const f32x4* rp = (const f32x4*)(rope + (size_t)(pos * 32 + i0) * 2);
#pragma unroll
                        for (int q = 0; q < 4; ++q) { const f32x4 r4 = rp[q]; cs[2 * q] = r4[0]; sn[2 * q] = r4[1]; cs[2 * q + 1] = r4[2]; sn[2 * q + 1] = r4[3]; } }
                    else {
#pragma unroll
                        for (int q = 0; q < 8; ++q) { cs[q] = 1.0f; sn[q] = 0.0f; } }
                    float y1[8], y2[8];
#pragma unroll
                    for (int e = 0; e < 8; ++e) { const float x1 = acc[ai][0][m][e >> 2][e & 3], x2 = acc[ai][1][m][e >> 2][e & 3];
                        y1[e] = (x1 * cs[e] - x2 * sn[e]) * sc; y2[e] = (x2 * cs[e] + x1 * sn[e]) * sc; }
                    bf16_t* dst = PR + (size_t)row * PROJ_LD + u.pn * BM + 128 * hh + 64 * part + i0;
                    u32x4 w; w.x = ::pk2(y1[0], y1[1]); w.y = ::pk2(y1[2], y1[3]); w.z = ::pk2(y1[4], y1[5]); w.w = ::pk2(y1[6], y1[7]);
                    *(u32x4*)dst = w;
                    w.x = ::pk2(y2[0], y2[1]); w.y = ::pk2(y2[2], y2[3]); w.z = ::pk2(y2[4], y2[5]); w.w = ::pk2(y2[6], y2[7]);
                    *(u32x4*)(dst + 32) = w;
                }
        } else {
            const int seg = u.pn >> 2;
            if (seg == 1 || seg == 6) plain<0>(acc, u, wr, wc, fr, fq);
            else if (seg == 2 || seg == 7) plain<1>(acc, u, wr, wc, fr, fq);
            else if (seg == 3) plain<2>(acc, u, wr, wc, fr, fq);
            else plain<3>(acc, u, wr, wc, fr, fq);
        }
    }
    template <int MODE> __device__ __forceinline__ void plain(const f32x4 (&acc)[2][2][4][2], const Unit& u, int wr, int wc, int fr, int fq) const {
        const int row0 = u.pm * BM + wr * 64 + fr;
#pragma unroll
        for (int bj = 0; bj < 2; ++bj) {
            const int col = u.pn * BM + bj * HALF + wc * 32 + 8 * fq;
            float l[8];
            if (MODE == 3) {
                const f32x4 l0 = *(const f32x4*)(lb + (col - 4096)), l1 = *(const f32x4*)(lb + (col - 4096) + 4);
#pragma unroll
                for (int e = 0; e < 4; ++e) { l[e] = l0[e]; l[4 + e] = l1[e]; }
            }
#pragma unroll
            for (int ai = 0; ai < 2; ++ai)
#pragma unroll
                for (int m = 0; m < 4; ++m) {
                    float v[8];
#pragma unroll
                    for (int e = 0; e < 8; ++e) { float x = acc[ai][bj][m][e >> 2][e & 3];
                        if (MODE == 1) x = x * __builtin_amdgcn_rcpf(1.0f + __expf(-x));
                        else if (MODE == 2) x = x * 0.08838834764831845f * __builtin_amdgcn_rcpf(1.0f + __expf(-x));
                        else if (MODE == 3) x = __logf(l[e] + (1.0f - l[e]) * __builtin_amdgcn_rcpf(1.0f + __expf(-x)));
                        v[e] = x; }
                    u32x4 w; w.x = ::pk2(v[0], v[1]); w.y = ::pk2(v[2], v[3]); w.z = ::pk2(v[4], v[5]); w.w = ::pk2(v[6], v[7]);
                    *(u32x4*)(PR + (size_t)(row0 + ai * HALF + m * 16) * PROJ_LD + col) = w;
                }
        }
    }
};
struct EpiGates {
    static constexpr bool PERM = true, AFTER_DRAIN = false, HAS_MID = false;
    bf16_t* G;
    __device__ __forceinline__ void mid(f32x4 (&)[2][2][4][2], const Unit&, int, int, int, int) const {}
    __device__ __forceinline__ void operator()(const f32x4 (&acc)[2][2][4][2], const Unit& u, int wr, int wc, int fr, int fq) const {
        const int row0 = u.pm * BM + wr * 64 + fr;
#pragma unroll
        for (int bj = 0; bj < 2; ++bj) {
            const int col = u.pn * BM + bj * HALF + wc * 32 + 8 * fq;
#pragma unroll
            for (int ai = 0; ai < 2; ++ai)
#pragma unroll
                for (int m = 0; m < 4; ++m) {
                    float v[8];
#pragma unroll
                    for (int e = 0; e < 8; ++e) v[e] = __builtin_amdgcn_rcpf(1.0f + __expf(-acc[ai][bj][m][e >> 2][e & 3]));
                    u32x4 w; w.x = ::pk2(v[0], v[1]); w.y = ::pk2(v[2], v[3]); w.z = ::pk2(v[4], v[5]); w.w = ::pk2(v[6], v[7]);
                    *(u32x4*)(G + (size_t)(row0 + ai * HALF + m * 16) * 2048 + col) = w;
                }
        }
    }
};
struct EpiMergeA {
    static constexpr bool PERM = false, AFTER_DRAIN = false, HAS_MID = false;
    const bf16_t* G; float* T;
    __device__ __forceinline__ void mid(f32x4 (&)[2][2][4][2], const Unit&, int, int, int, int) const {}
    __device__ __forceinline__ void operator()(const f32x4 (&acc)[2][2][4][2], const Unit& u, int wr, int wc, int fr, int fq) const {
        const int row0 = u.pm * BM + wr * 64 + fr, col0 = u.pn * BM + wc * 32 + 4 * fq;
#pragma unroll
        for (int ai = 0; ai < 2; ++ai)
#pragma unroll
            for (int m = 0; m < 4; ++m) { const size_t row = (size_t)(row0 + ai * HALF + m * 16);
#pragma unroll
                for (int bj = 0; bj < 2; ++bj)
#pragma unroll
                    for (int n = 0; n < 2; ++n) { const int c = col0 + bj * HALF + n * 16;
                        const u32x2 g = *(const u32x2*)(G + row * 2048 + c);
                        f32x4 v = acc[ai][bj][m][n]; v[0] *= ::bflo(g.x); v[1] *= ::bfhi(g.x); v[2] *= ::bflo(g.y); v[3] *= ::bfhi(g.y);
                        *(f32x4*)(T + row * 1024 + c) = v; } }
    }
};
struct EpiMergeB {
    static constexpr bool PERM = false, AFTER_DRAIN = false, HAS_MID = false;
    const bf16_t* G; const float* T; bf16_t* Mg;
    __device__ __forceinline__ void mid(f32x4 (&)[2][2][4][2], const Unit&, int, int, int, int) const {}
    __device__ __forceinline__ void operator()(const f32x4 (&acc)[2][2][4][2], const Unit& u, int wr, int wc, int fr, int fq) const {
        const int row0 = u.pm * BM + wr * 64 + fr, col0 = u.pn * BM + wc * 32 + 4 * fq;
#pragma unroll
        for (int ai = 0; ai < 2; ++ai)
#pragma unroll
            for (int m = 0; m < 4; ++m) { const size_t row = (size_t)(row0 + ai * HALF + m * 16);
#pragma unroll
                for (int bj = 0; bj < 2; ++bj)
#pragma unroll
                    for (int n = 0; n < 2; ++n) { const int c = col0 + bj * HALF + n * 16;
                        const u32x2 g = *(const u32x2*)(G + row * 2048 + 1024 + c);
                        f32x4 v = acc[ai][bj][m][n]; const f32x4 t = *(const f32x4*)(T + row * 1024 + c);
                        v[0] = v[0] * ::bflo(g.x) + t[0]; v[1] = v[1] * ::bfhi(g.x) + t[1]; v[2] = v[2] * ::bflo(g.y) + t[2]; v[3] = v[3] * ::bfhi(g.y) + t[3];
                        u32x2 w; w.x = ::pk2(v[0], v[1]); w.y = ::pk2(v[2], v[3]);
                        *(u32x2*)(Mg + row * 1024 + c) = w; } }
    }
};

template <class Epi, class Sched, bool ALIGN_EPI = false, bool SP2 = false>
__device__ __forceinline__ void gemm_phase(PG8_LAS unsigned char* lds, const Gemm g, const Sched& S, const Epi& E) {
    int tid_ = threadIdx.x; asm volatile("" : "+v"(tid_)); const int tid = tid_, wid = __builtin_amdgcn_readfirstlane(tid >> 6), lane = tid & 63, wr = wid >> 2, wc = wid & 3, fr = lane & 15, fq = lane >> 4;
    const int K = g.K, nt = K / BK;
    unsigned voffA[2], voffB[2];
#pragma unroll
    for (int i = 0; i < 2; ++i) { int R, C; stage_rc(tid * 16 + i * 8192, R, C); const int Rb = Epi::PERM ? ((R & ~31) + perm32(R & 31)) : R;
        voffA[i] = (unsigned)(R * K + C) * 2u; voffB[i] = (unsigned)(Rb * K + C) * 2u; }
    const size_t kstep = (size_t)(BK * 2);
    const size_t hstep = (size_t)HALF * K * 2;
    const size_t tstep = 2 * hstep;
    const unsigned ldsw = (unsigned)wid * 1024u;
    const int aoff = lds_byte(wr * 64 + fr, fq * 8), boff = lds_byte(wc * 32 + fr, fq * 8);
#define PG8_SA(b, h) (((b) * 2 + (h)) * HTB)
#define PG8_SB(b, h) ((4 + (b) * 2 + (h)) * HTB)
#define PG8_STAGE(bufoff, gbase, voff) do { _Pragma("unroll") for (int _i = 0; _i < 2; ++_i) \
        __builtin_amdgcn_global_load_lds((const unsigned*)((const char*)(gbase) + (voff)[_i]), (PG8_LAS unsigned*)(lds + (bufoff) + ldsw + _i * 8192), 16, 0, 0); } while (0)
#define PG8_LDA(dst, b, h) do { _Pragma("unroll") for (int m = 0; m < 4; ++m) _Pragma("unroll") for (int k = 0; k < 2; ++k) dst[m][k] = *(const PG8_LAS bf16x8*)(lds + PG8_SA(b, h) + aoff + m * 2048 + k * 1024); } while (0)
#define PG8_LDB(dst, b, h) do { _Pragma("unroll") for (int n = 0; n < 2; ++n) _Pragma("unroll") for (int k = 0; k < 2; ++k) dst[n][k] = *(const PG8_LAS bf16x8*)(lds + PG8_SB(b, h) + boff + n * 2048 + k * 1024); } while (0)
#define PG8_MMA(ai, bj, At, Bt) do { __builtin_amdgcn_s_setprio(1); _Pragma("unroll") for (int m = 0; m < 4; ++m) _Pragma("unroll") for (int n = 0; n < 2; ++n) _Pragma("unroll") for (int k = 0; k < 2; ++k) \
        acc[ai][bj][m][n] = __builtin_amdgcn_mfma_f32_16x16x32_bf16(Bt[n][k], At[m][k], acc[ai][bj][m][n], 0, 0, 0); __builtin_amdgcn_s_setprio(0); } while (0)
#define PG8_WAIT_V(n) asm volatile("s_waitcnt vmcnt(" #n ")" ::: "memory")
#define PG8_WAIT_L(n) asm volatile("s_waitcnt lgkmcnt(" #n ")" ::: "memory")
#define PG8_BAR __builtin_amdgcn_s_barrier()
#define PG8_SCHED __builtin_amdgcn_sched_barrier(0)
    Unit cur, nxt; int ui = 0;
    if (!S.next(0, cur)) return;
    f32x4 acc[2][2][4][2];
#pragma unroll
    for (int a = 0; a < 2; ++a)
#pragma unroll
        for (int b = 0; b < 2; ++b)
#pragma unroll
            for (int m = 0; m < 4; ++m)
#pragma unroll
                for (int n = 0; n < 2; ++n) acc[a][b][m][n] = (f32x4){0.f, 0.f, 0.f, 0.f};
    bf16x8 At[4][2], B0[2][2], B1[2][2];
    const char* cA = (const char*)g.A + (size_t)cur.pm * tstep; const char* cB = (const char*)g.Bt + (size_t)cur.pn * tstep;
    S.a_ready(cur);
    if constexpr (SP2) {
        PG8_STAGE(PG8_SB(0, 0), cB, voffB); PG8_STAGE(PG8_SB(0, 1), cB + hstep, voffB); PG8_STAGE(PG8_SA(0, 0), cA, voffA); PG8_STAGE(PG8_SA(0, 1), cA + hstep, voffA);
        if (wr == 1) PG8_BAR;
        PG8_WAIT_V(2); PG8_BAR;
        PG8_STAGE(PG8_SB(1, 0), cB + kstep, voffB); PG8_STAGE(PG8_SA(1, 0), cA + kstep, voffA); PG8_STAGE(PG8_SB(1, 1), cB + hstep + kstep, voffB);
        PG8_WAIT_V(6); PG8_BAR;
    } else {
        PG8_STAGE(PG8_SB(0, 0), cB, voffB); PG8_STAGE(PG8_SA(0, 0), cA, voffA); PG8_STAGE(PG8_SB(0, 1), cB + hstep, voffB); PG8_STAGE(PG8_SA(0, 1), cA + hstep, voffA);
        if (wr == 1) PG8_BAR;
        PG8_WAIT_V(4); PG8_BAR;
        PG8_STAGE(PG8_SB(1, 0), cB + kstep, voffB); PG8_STAGE(PG8_SA(1, 0), cA + kstep, voffA); PG8_STAGE(PG8_SB(1, 1), cB + hstep + kstep, voffB);
        PG8_WAIT_V(6); PG8_BAR;
    }
    for (;;) {
        const bool has_next = S.next(ui + 1, nxt);
        const char* nA = has_next ? (const char*)g.A + (size_t)nxt.pm * tstep : cA; const char* nB = has_next ? (const char*)g.Bt + (size_t)nxt.pn * tstep : cB;
        for (int t = 0; t < nt; t += 2) {
            if constexpr (Epi::HAS_MID) { if (t == (nt >> 1)) E.mid(acc, cur, wr, wc, fr, fq); }
            const bool last = (t == nt - 2);
            const char* a1 = cA + (size_t)(t + 1) * kstep;
            const char* a2 = last ? nA : cA + (size_t)(t + 2) * kstep; const char* b2 = last ? nB : cB + (size_t)(t + 2) * kstep;
            const char* a3 = a2 + kstep; const char* b3 = b2 + kstep;
            if (last && has_next) S.a_ready(nxt);
            if constexpr (SP2) {
            PG8_LDB(B0, 0, 0); PG8_LDB(B1, 0, 1); PG8_SCHED; PG8_LDA(At, 0, 0); PG8_STAGE(PG8_SA(1, 1), a1 + hstep, voffA);
            PG8_WAIT_V(8); PG8_WAIT_L(0); PG8_BAR; PG8_MMA(0, 0, At, B0); PG8_MMA(0, 1, At, B1); PG8_BAR; PG8_SCHED;
            PG8_LDA(At, 0, 1); PG8_STAGE(PG8_SB(0, 0), b2, voffB); PG8_STAGE(PG8_SB(0, 1), b2 + hstep, voffB); PG8_STAGE(PG8_SA(0, 0), a2, voffA);
            PG8_WAIT_V(8); PG8_WAIT_L(0); PG8_BAR; PG8_MMA(1, 0, At, B0); PG8_MMA(1, 1, At, B1); PG8_BAR; PG8_SCHED;
            PG8_LDB(B0, 1, 0); PG8_LDB(B1, 1, 1); PG8_SCHED; PG8_LDA(At, 1, 0); PG8_STAGE(PG8_SA(0, 1), a2 + hstep, voffA);
            PG8_WAIT_V(8); PG8_WAIT_L(0); PG8_BAR; PG8_MMA(0, 0, At, B0); PG8_MMA(0, 1, At, B1); PG8_BAR; PG8_SCHED;
            PG8_LDA(At, 1, 1); PG8_STAGE(PG8_SB(1, 0), b3, voffB); PG8_STAGE(PG8_SB(1, 1), b3 + hstep, voffB); PG8_STAGE(PG8_SA(1, 0), a3, voffA);
            PG8_WAIT_V(8); PG8_WAIT_L(0); PG8_BAR; PG8_MMA(1, 0, At, B0); PG8_MMA(1, 1, At, B1); PG8_BAR; PG8_SCHED;
            } else {
            PG8_LDB(B0, 0, 0); PG8_SCHED; PG8_LDA(At, 0, 0); PG8_STAGE(PG8_SA(1, 1), a1 + hstep, voffA);
            PG8_WAIT_L(8); PG8_BAR; PG8_WAIT_L(0); PG8_MMA(0, 0, At, B0); PG8_BAR; PG8_SCHED;
            PG8_LDB(B1, 0, 1); PG8_STAGE(PG8_SB(0, 0), b2, voffB);
            PG8_BAR; PG8_WAIT_L(0); PG8_MMA(0, 1, At, B1); PG8_BAR;
            PG8_LDA(At, 0, 1); PG8_STAGE(PG8_SA(0, 0), a2, voffA);
            PG8_BAR; PG8_WAIT_L(0); PG8_MMA(1, 0, At, B0); PG8_BAR; PG8_SCHED;
            PG8_STAGE(PG8_SB(0, 1), b2 + hstep, voffB);
            PG8_WAIT_V(6); PG8_BAR; PG8_MMA(1, 1, At, B1); PG8_BAR;
            PG8_LDB(B0, 1, 0); PG8_SCHED; PG8_LDA(At, 1, 0); PG8_STAGE(PG8_SA(0, 1), a2 + hstep, voffA);
            PG8_WAIT_L(8); PG8_BAR; PG8_WAIT_L(0); PG8_MMA(0, 0, At, B0); PG8_BAR; PG8_SCHED;
            PG8_LDB(B1, 1, 1); PG8_STAGE(PG8_SB(1, 0), b3, voffB);
            PG8_BAR; PG8_WAIT_L(0); PG8_MMA(0, 1, At, B1); PG8_BAR;
            PG8_LDA(At, 1, 1); PG8_STAGE(PG8_SA(1, 0), a3, voffA);
            PG8_BAR; PG8_WAIT_L(0); PG8_MMA(1, 0, At, B0); PG8_BAR; PG8_SCHED;
            PG8_STAGE(PG8_SB(1, 1), b3 + hstep, voffB);
            PG8_WAIT_V(6); PG8_BAR; PG8_MMA(1, 1, At, B1); PG8_BAR;
            }
        }
        if constexpr (ALIGN_EPI) { if (wr == 0) PG8_BAR; }
        if constexpr (!Epi::AFTER_DRAIN) { E(acc, cur, wr, wc, fr, fq); S.done(cur); }
        if (!has_next) break;
#pragma unroll
        for (int a = 0; a < 2; ++a)
#pragma unroll
            for (int b = 0; b < 2; ++b)
#pragma unroll
                for (int m = 0; m < 4; ++m)
#pragma unroll
                    for (int n = 0; n < 2; ++n) acc[a][b][m][n] = (f32x4){0.f, 0.f, 0.f, 0.f};
        cur = nxt; cA = nA; cB = nB; ++ui;
        if constexpr (ALIGN_EPI) { if (wr == 1) PG8_BAR; }
    }
    PG8_WAIT_V(0);
    if constexpr (!ALIGN_EPI) { if (wr == 0) PG8_BAR; }
    PG8_BAR;
    if constexpr (Epi::AFTER_DRAIN) { E.fused(acc, cur, wr, wc, fr, fq, lds, wid, lane); S.done(cur); }
#undef PG8_SA
#undef PG8_SB
#undef PG8_STAGE
#undef PG8_LDA
#undef PG8_LDB
#undef PG8_MMA
#undef PG8_WAIT_V
#undef PG8_WAIT_L
#undef PG8_BAR
#undef PG8_SCHED
}
}

typedef float f32x16 __attribute__((ext_vector_type(16)));
constexpr size_t WS_RST = WS_ST;
constexpr size_t WS_HST = WS_ST + 16 * MiB;
constexpr size_t WS_HD = WS_ST + 48 * MiB;
constexpr size_t OUT_RET = (size_t)MT * D, OUT_HG = OUT_RET + (size_t)16 * 2 * 4 * 128 * 256;

DEVI bf16x8 ldfrag(ldsp base, int stride, int row, int k0, int hh) { return *(const LAS bf16x8*)(base + row * stride + (k0 + 8 * hh) * 2); }
template <int NX> DEVI void mma_nx1(f32x16 (&acc)[NX], ldsp X, int xs, int x0, ldsp Y, int ys, int y0, int ksteps, int r, int hh) {

    for (int s = 0; s < ksteps; ++s) {
        const bf16x8 b = ldfrag(Y, ys, y0 + r, 16 * s, hh);
#pragma unroll
        for (int t = 0; t < NX; ++t) { const bf16x8 a = ldfrag(X, xs, x0 + 32 * t + r, 16 * s, hh); acc[t] = __builtin_amdgcn_mfma_f32_32x32x16_bf16(a, b, acc[t], 0, 0, 0); }
    }
}
template <int NX> DEVI void zero_acc(f32x16 (&acc)[NX]) {
#pragma unroll
    for (int t = 0; t < NX; ++t)
#pragma unroll
        for (int i = 0; i < 16; ++i) acc[t][i] = 0.f;
}
template <int ROWS, int LC> struct NatBuf { u32x4 v[(ROWS << LC) / 512]; };
template <int ROWS, int LC> DEVI void nat_load(NatBuf<ROWS, LC>& b, const bf16_t* src, size_t gstride, int tid) {
#pragma unroll
    for (int k = 0; k < (ROWS << LC) / 512; ++k) { const int u = tid + 512 * k, rr = u >> LC, c = u & ((1 << LC) - 1); b.v[k] = *(const u32x4*)(src + (size_t)rr * gstride + c * 8); }
}
template <int ROWS, int LC> DEVI void nat_store(const NatBuf<ROWS, LC>& b, ldsp dst, int ls, int tid) {
#pragma unroll
    for (int k = 0; k < (ROWS << LC) / 512; ++k) { const int u = tid + 512 * k, rr = u >> LC, c = u & ((1 << LC) - 1); *(LAS u32x4*)(dst + rr * ls + c * 16) = b.v[k]; }
}
template <int T, int NCOL> struct TrBuf { u32x4 v0[(T >> 5) * (NCOL >> 5) / 8], v1[(T >> 5) * (NCOL >> 5) / 8]; };
template <int T, int NCOL> DEVI void tr_load(TrBuf<T, NCOL>& b, const bf16_t* src, size_t gstride, int tid) {
    const int lane = tid & 63, wv = tid >> 6; constexpr int nbj = T >> 5;
#pragma unroll
    for (int k = 0; k < (T >> 5) * (NCOL >> 5) / 8; ++k) { const int blk = wv + 8 * k, bj = blk % nbj, bc = blk / nbj, jp = bj * 16 + (lane & 15), cc = bc * 4 + (lane >> 4);
        b.v0[k] = *(const u32x4*)(src + (size_t)(2 * jp) * gstride + cc * 8); b.v1[k] = *(const u32x4*)(src + (size_t)(2 * jp + 1) * gstride + cc * 8); }
}
template <int T, int NCOL, class F> DEVI void tr_store(const TrBuf<T, NCOL>& b, ldsp dst, int ls, int tid, F scale) {
    const int lane = tid & 63, wv = tid >> 6; constexpr int nbj = T >> 5;
#pragma unroll
    for (int k = 0; k < (T >> 5) * (NCOL >> 5) / 8; ++k) { const int blk = wv + 8 * k, bj = blk % nbj, bc = blk / nbj, jp = bj * 16 + (lane & 15), cc = bc * 4 + (lane >> 4);
        const float s0 = scale(2 * jp), s1 = scale(2 * jp + 1);
#pragma unroll
        for (int q = 0; q < 4; ++q) {
            *(LAS unsigned*)(dst + (cc * 8 + 2 * q) * ls + jp * 4) = pk2(bflo(b.v0[k][q]) * s0, bflo(b.v1[k][q]) * s1);
            *(LAS unsigned*)(dst + (cc * 8 + 2 * q + 1) * ls + jp * 4) = pk2(bfhi(b.v0[k][q]) * s0, bfhi(b.v1[k][q]) * s1);
        } }
}
DEVI float log2_gamma(const P& p, int dir, int h) { const float rd = p.in[14][dir * 4 + h]; return -log2f(1.0f + expf(-rd)); }
DEVI u32x2 pack4(const f32x16& a, int g) { u32x2 w; w.x = pk2(a[4 * g], a[4 * g + 1]); w.y = pk2(a[4 * g + 2], a[4 * g + 3]); return w; }

DEVI void ret_stage_a(const P& p, ldsp lds, int pass, int item, int tid) {
    const int cg = item >> 2, h = item & 3, lane = tid & 63, w = __builtin_amdgcn_readfirstlane(tid >> 6), r = lane & 31, hh = lane >> 5;
    const bf16_t* PR = (const bf16_t*)(p.ws + WS_PROJ) + (size_t)(cg * 128) * PROJ_LD;
    const float lgf = log2_gamma(p, 0, h), lgb = log2_gamma(p, 1, h);
    ldsp vT = lds, kfT = lds + 69632, kbT = lds + 104448;
    { TrBuf<128, 256> bv; TrBuf<128, 128> bk;
      tr_load(bv, PR + C_RV + h * 256, PROJ_LD, tid); tr_load(bk, PR + C_RK + h * 128, PROJ_LD, tid);
      tr_store(bv, vT, 272, tid, [](int) { return 1.0f; });
      tr_store(bk, kfT, 272, tid, [lgf](int j) { return exp2f(lgf * (float)(127 - j)); });
      tr_store(bk, kbT, 272, tid, [lgb](int j) { return exp2f(lgb * (float)j); }); }
    __syncthreads();
#pragma unroll 1
    for (int dir = 0; dir < 2; ++dir) {
        f32x16 acc[4]; zero_acc(acc);
        mma_nx1<4>(acc, dir ? kbT : kfT, 272, 0, vT, 272, 32 * w, 8, r, hh);
        bf16_t* ST = (bf16_t*)(p.ws + WS_RST) + ((size_t)(cg * 4 + h) * 2 + dir) * 32768 + (size_t)(32 * w + r) * 128;
#pragma unroll
        for (int t = 0; t < 4; ++t)
#pragma unroll
            for (int g = 0; g < 4; ++g) *(u32x2*)(ST + 32 * t + 8 * g + 4 * hh) = pack4(acc[t], g);
    }
    __syncthreads();
}
template <int NB> DEVI void ret_b_item(const P& p, int pass, int idx, int nc) {
    const int dkg = idx & 15, e = (idx >> 4) & 255, hd = (idx >> 12) & 7, s = idx >> 15, dir = hd & 1, h = hd >> 1, dk0 = dkg * 8;
    const float cdec = exp2f(log2_gamma(p, dir, h) * 128.0f);
    float S[8];
    if (pass == 0) {
#pragma unroll
        for (int i = 0; i < 8; ++i) S[i] = 0.f;
    } else {
        const float* st = p.in[2] + ((size_t)(((pass - 1) * 2 + s) * 2 + dir) * 4 + h) * 32768;
#pragma unroll
        for (int i = 0; i < 8; ++i) S[i] = st[(dk0 + i) * 256 + e];
    }
    const long cstride = dir ? -(long)(4 * 2 * 32768) : (long)(4 * 2 * 32768);
    bf16_t* q = (bf16_t*)(p.ws + WS_RST) + ((size_t)((s * nc + (dir ? nc - 1 : 0)) * 4 + h) * 2 + dir) * 32768 + e * 128 + dk0;
    for (int c0 = 0; c0 < nc; c0 += NB) {
        u32x4 u[NB];
#pragma unroll
        for (int k = 0; k < NB; ++k) u[k] = *(const u32x4*)(q + (long)k * cstride);
#pragma unroll
        for (int k = 0; k < NB; ++k) {
            u32x4 o; o.x = pk2(S[0], S[1]); o.y = pk2(S[2], S[3]); o.z = pk2(S[4], S[5]); o.w = pk2(S[6], S[7]);
            *(u32x4*)(q + (long)k * cstride) = o;
#pragma unroll
            for (int qq = 0; qq < 4; ++qq) { S[2 * qq] = cdec * S[2 * qq] + bflo(u[k][qq]); S[2 * qq + 1] = cdec * S[2 * qq + 1] + bfhi(u[k][qq]); }
        }
        q += (long)NB * cstride;
    }
    if (pass == 0) {
        float* ns = p.out + OUT_RET + ((size_t)(s * 2 + dir) * 4 + h) * 32768;
#pragma unroll
        for (int i = 0; i < 8; ++i) ns[(dk0 + i) * 256 + e] = S[i];
    }
}
template <int NB> DEVI void hg_b_item(const P& p, int pass, int idx, int nc) {
    const int dkg = idx & 15, e = (idx >> 4) & 127, hd = (idx >> 11) & 15, s = idx >> 15, dir = hd & 1, h = hd >> 1, dk0 = dkg * 8;
    float S[8];
    if (pass == 0) {
#pragma unroll
        for (int i = 0; i < 8; ++i) S[i] = 0.f;
    } else {
        const float* st = p.in[3] + ((size_t)(((pass - 1) * 2 + s) * 2 + dir) * 8 + h) * 16384;
#pragma unroll
        for (int i = 0; i < 8; ++i) S[i] = st[(dk0 + i) * 128 + e];
    }
    const long cs = dir ? -16L : 16L;
    size_t ci = (size_t)((s * nc + (dir ? nc - 1 : 0)) * 8 + h) * 2 + dir;
    for (int c0 = 0; c0 < nc; c0 += NB) {
        u32x4 u[NB]; f32x4 d0[NB], d1[NB];
#pragma unroll
        for (int k = 0; k < NB; ++k) { const size_t cik = ci + (long)k * cs;
            u[k] = *(const u32x4*)((const bf16_t*)(p.ws + WS_HST) + cik * 16384 + e * 128 + dk0);
            const float* dv = (const float*)(p.ws + WS_HD) + cik * 128 + dk0; d0[k] = *(const f32x4*)dv; d1[k] = *(const f32x4*)(dv + 4); }
#pragma unroll
        for (int k = 0; k < NB; ++k) { const size_t cik = ci + (long)k * cs;
            u32x4 o; o.x = pk2(S[0], S[1]); o.y = pk2(S[2], S[3]); o.z = pk2(S[4], S[5]); o.w = pk2(S[6], S[7]);
            *(u32x4*)((bf16_t*)(p.ws + WS_HST) + cik * 16384 + e * 128 + dk0) = o;
#pragma unroll
            for (int qq = 0; qq < 4; ++qq) { const float da = qq < 2 ? d0[k][2 * qq] : d1[k][2 * qq - 4], db = qq < 2 ? d0[k][2 * qq + 1] : d1[k][2 * qq - 3];
                S[2 * qq] = da * S[2 * qq] + bflo(u[k][qq]); S[2 * qq + 1] = db * S[2 * qq + 1] + bfhi(u[k][qq]); }
        }
        ci += (long)NB * cs;
    }
    if (pass == 0) {
        float* ns = p.out + OUT_HG + ((size_t)(s * 2 + dir) * 8 + h) * 16384;
#pragma unroll
        for (int i = 0; i < 8; ++i) ns[(dk0 + i) * 128 + e] = S[i];
    }
}
DEVI void scan_stage_b(const P& p, int pass, int tid, int G) {
    const int nseq = pass == 0 ? 16 : 2, tot_r = nseq * 32768;
    for (int idx = blockIdx.x * 512 + tid; idx < 2 * tot_r; idx += G * 512) {
        if (idx < tot_r) { if (pass == 0) ret_b_item<2>(p, pass, idx, 2); else ret_b_item<8>(p, pass, idx, 16); }
        else { if (pass == 0) hg_b_item<4>(p, pass, idx - tot_r, 4); else hg_b_item<4>(p, pass, idx - tot_r, 32); }
    }
}
DEVI void ret_stage_c(const P& p, ldsp lds, int pass, int item, int tid) {
    const int cg = item >> 2, h = item & 3, lane = tid & 63, w = __builtin_amdgcn_readfirstlane(tid >> 6), r = lane & 31, hh = lane >> 5;
    const int nc = pass == 0 ? 2 : 16, c = cg % nc;
    const bf16_t* PR = (const bf16_t*)(p.ws + WS_PROJ) + (size_t)(cg * 128) * PROJ_LD;
    const float lgf = log2_gamma(p, 0, h), lgb = log2_gamma(p, 1, h);
    ldsp qL = lds, kP = lds + 34816, vS = lds + 69632; LAS float* red = (LAS float*)(lds + 139264);
    { NatBuf<128, 4> bq, bk; TrBuf<128, 256> bv;
      nat_load(bq, PR + C_RQ + h * 128, PROJ_LD, tid); nat_load(bk, PR + C_RK + h * 128, PROJ_LD, tid); tr_load(bv, PR + C_RV + h * 256, PROJ_LD, tid);
      nat_store(bq, qL, 272, tid); nat_store(bk, kP, 272, tid); tr_store(bv, vS, 272, tid, [](int) { return 1.0f; }); }
    __syncthreads();
    const int ib = w & 3, wh = w >> 2, i = 32 * ib + r;
    {
        f32x16 ap[2]; zero_acc(ap);
        mma_nx1<2>(ap, kP, 272, 64 * wh, qL, 272, 32 * ib, 8, r, hh);
        __syncthreads();
#pragma unroll
        for (int t = 0; t < 2; ++t)
#pragma unroll
            for (int g = 0; g < 4; ++g) {
                float v[4];
#pragma unroll
                for (int e2 = 0; e2 < 4; ++e2) { const int j = 64 * wh + 32 * t + 8 * g + 4 * hh + e2, d = i - j;
                    const float wgt = d > 0 ? exp2f(lgf * (float)d) : (d < 0 ? exp2f(lgb * (float)(-d)) : 2.0f);
                    v[e2] = ap[t][4 * g + e2] * wgt; }
                u32x2 o; o.x = pk2(v[0], v[1]); o.y = pk2(v[2], v[3]);
                *(LAS u32x2*)(kP + i * 272 + (64 * wh + 32 * t + 8 * g + 4 * hh) * 2) = o;
            }
        __syncthreads();
    }
    const bool has0 = pass != 0 || c != 0, has1 = pass != 0 || c != nc - 1;
    const bf16_t* ST0 = (const bf16_t*)(p.ws + WS_RST) + ((size_t)(cg * 4 + h) * 2) * 32768;
    NatBuf<256, 4> bs;
    f32x16 acc[4]; zero_acc(acc);
    mma_nx1<4>(acc, vS, 272, 128 * wh, kP, 272, 32 * ib, 8, r, hh);
    __syncthreads();
    if (has0 || has1) { nat_load(bs, has0 ? ST0 : ST0 + 32768, 128, tid); nat_store(bs, vS, 272, tid); }
    __syncthreads();
    if (has0 || has1) {
        f32x16 tmp[4]; zero_acc(tmp);
        mma_nx1<4>(tmp, vS, 272, 128 * wh, qL, 272, 32 * ib, 8, r, hh);
        const float sc = has0 ? exp2f(lgf * (float)(i + 1)) : exp2f(lgb * (float)(128 - i));
#pragma unroll
        for (int t = 0; t < 4; ++t)
#pragma unroll
            for (int q = 0; q < 16; ++q) acc[t][q] += tmp[t][q] * sc;
    }
    if (has0 && has1) {
        __syncthreads();
        nat_load(bs, ST0 + 32768, 128, tid);
        nat_store(bs, vS, 272, tid);
        __syncthreads();
        f32x16 tmp[4]; zero_acc(tmp);
        mma_nx1<4>(tmp, vS, 272, 128 * wh, qL, 272, 32 * ib, 8, r, hh);
        const float sc = exp2f(lgb * (float)(128 - i));
#pragma unroll
        for (int t = 0; t < 4; ++t)
#pragma unroll
            for (int q = 0; q < 16; ++q) acc[t][q] += tmp[t][q] * sc;
    }
    float ss = 0.f;
#pragma unroll
    for (int t = 0; t < 4; ++t)
#pragma unroll
        for (int q = 0; q < 16; ++q) ss += acc[t][q] * acc[t][q];
    ss += __shfl_xor(ss, 32);
    if (hh == 0) red[wh * 128 + i] = ss;
    __syncthreads();
    const float rstd = rsqrtf((red[i] + red[128 + i]) * (1.0f / 256.0f) + EPS);
    const bf16_t* rg = PR + (size_t)i * PROJ_LD + C_RG + h * 256 + 128 * wh;
    bf16_t* O = (bf16_t*)(p.ws + WS_ORET) + (size_t)(pass * PASS_ROWS + cg * 128 + i) * 1024 + h * 256 + 128 * wh;
#pragma unroll
    for (int t = 0; t < 4; ++t)
#pragma unroll
        for (int g = 0; g < 4; ++g) { const int e = 32 * t + 8 * g + 4 * hh; const u32x2 gv = *(const u32x2*)(rg + e);
            u32x2 o; o.x = pk2(acc[t][4 * g] * rstd * bflo(gv.x), acc[t][4 * g + 1] * rstd * bfhi(gv.x)); o.y = pk2(acc[t][4 * g + 2] * rstd * bflo(gv.y), acc[t][4 * g + 3] * rstd * bfhi(gv.y));
            *(u32x2*)(O + e) = o; }
    __syncthreads();
}

DEVI void hg_stage_a(const P& p, ldsp lds, int pass, int item, int tid) {
    const int cg = item >> 3, h = item & 7, lane = tid & 63, w = __builtin_amdgcn_readfirstlane(tid >> 6), r = lane & 31, hh = lane >> 5;
    const bf16_t* PR = (const bf16_t*)(p.ws + WS_PROJ) + (size_t)(cg * 64) * PROJ_LD;
    ldsp graw = lds, vT = lds + 34816, kT = lds + 53248;
    { NatBuf<64, 4> bf, bb; TrBuf<64, 128> bv;
      nat_load(bf, PR + C_GF + h * 128, PROJ_LD, tid); nat_load(bb, PR + C_GB + h * 128, PROJ_LD, tid); tr_load(bv, PR + C_HI + h * 128, PROJ_LD, tid);
      nat_store(bf, graw, 272, tid); nat_store(bb, graw + 17408, 272, tid); tr_store(bv, vT, 144, tid, [](int) { return 1.0f; }); }
    __syncthreads();
    if (tid < 256) {
        const int dir = tid >> 7, dk = tid & 127;
        const LAS bf16_t* g = (const LAS bf16_t*)(graw + dir * 17408) + dk;
        ldsp kd = kT + dir * 18432 + dk * 144;
        float run = 0.f;
        if (dir == 0) {
#pragma unroll 1
            for (int jg = 7; jg >= 0; --jg) {
                float v[8];
#pragma unroll
                for (int jj = 7; jj >= 0; --jj) { const float gv = bf2f(g[(8 * jg + jj) * 136]); v[jj] = (1.0f - __expf(gv)) * __expf(run); run += gv; }
                u32x4 o; o.x = pk2(v[0], v[1]); o.y = pk2(v[2], v[3]); o.z = pk2(v[4], v[5]); o.w = pk2(v[6], v[7]);
                *(LAS u32x4*)(kd + jg * 16) = o;
            }
        } else {
#pragma unroll 1
            for (int jg = 0; jg < 8; ++jg) {
                float v[8];
#pragma unroll
                for (int jj = 0; jj < 8; ++jj) { const float gv = bf2f(g[(8 * jg + jj) * 136]); v[jj] = (1.0f - __expf(gv)) * __expf(run); run += gv; }
                u32x4 o; o.x = pk2(v[0], v[1]); o.y = pk2(v[2], v[3]); o.z = pk2(v[4], v[5]); o.w = pk2(v[6], v[7]);
                *(LAS u32x4*)(kd + jg * 16) = o;
            }
        }
        ((float*)(p.ws + WS_HD))[((size_t)(cg * 8 + h) * 2 + dir) * 128 + dk] = __expf(run);
    }
    __syncthreads();
#pragma unroll 1
    for (int dir = 0; dir < 2; ++dir) {
        f32x16 acc[2]; zero_acc(acc);
        mma_nx1<2>(acc, kT + dir * 18432, 144, 64 * (w >> 2), vT, 144, 32 * (w & 3), 4, r, hh);
        bf16_t* ST = (bf16_t*)(p.ws + WS_HST) + ((size_t)(cg * 8 + h) * 2 + dir) * 16384 + (size_t)(32 * (w & 3) + r) * 128 + 64 * (w >> 2);
#pragma unroll
        for (int t = 0; t < 2; ++t)
#pragma unroll
            for (int g = 0; g < 4; ++g) *(u32x2*)(ST + 32 * t + 8 * g + 4 * hh) = pack4(acc[t], g);
    }
    __syncthreads();
}
DEVI void hg_stage_c(const P& p, ldsp lds, int pass, int item, int tid) {
    const int cg = item >> 3, h = item & 7, lane = tid & 63, w = __builtin_amdgcn_readfirstlane(tid >> 6), r = lane & 31, hh = lane >> 5;
    const int nc = pass == 0 ? 4 : 32, c = cg % nc;
    const bool hasF = pass != 0 || c != 0, hasB = pass != 0 || c != nc - 1;
    const bf16_t* PR = (const bf16_t*)(p.ws + WS_PROJ) + (size_t)(cg * 64) * PROJ_LD;
    ldsp raw = lds, img = lds + 69632, vT = lds + 139264; LAS float* ref = (LAS float*)(lds + 157696); LAS float* red = (LAS float*)(lds + 158720);
    { NatBuf<64, 4> bf, bb, bq; TrBuf<64, 128> bv;
      nat_load(bf, PR + C_GF + h * 128, PROJ_LD, tid); nat_load(bb, PR + C_GB + h * 128, PROJ_LD, tid); nat_load(bq, PR + C_HQ + h * 128, PROJ_LD, tid); tr_load(bv, PR + C_HI + h * 128, PROJ_LD, tid);
      nat_store(bf, raw, 272, tid); nat_store(bb, raw + 17408, 272, tid); nat_store(bq, raw + 34816, 272, tid); tr_store(bv, vT, 144, tid, [](int) { return 1.0f; }); }
    __syncthreads();
    {
        const int half = tid >> 8, dir = (tid >> 7) & 1, dk = tid & 127;
        const LAS bf16_t* g = (const LAS bf16_t*)(raw + dir * 17408) + dk;
        const LAS bf16_t* qr = (const LAS bf16_t*)(raw + 34816) + dk;
        LAS bf16_t* qi = (LAS bf16_t*)(img + dir * 34816) + dk; LAS bf16_t* ki = (LAS bf16_t*)(img + dir * 34816 + 17408) + dk;
        float d = 0.f;
        if (half == 0) {
#pragma unroll 4
        for (int t = 0; t < 32; ++t) { const int j = dir == 0 ? 31 - t : 32 + t; const float gv = bf2f(g[j * 136]);
            const float qv = bf2f(qr[j * 136]), kv = 1.0f - __expf(gv);
            qi[j * 136] = (bf16_t)f2bf(qv * __expf(d)); ki[j * 136] = (bf16_t)f2bf(kv * __expf(-d)); d -= gv; }
        ref[dir * 128 + dk] = __expf(-d);
        } else {
#pragma unroll 4
        for (int t = 0; t < 32; ++t) { const int j = dir == 0 ? 32 + t : 31 - t; const float gv = bf2f(g[j * 136]);
            d += gv;
            const float qv = bf2f(qr[j * 136]), kv = 1.0f - __expf(gv);
            qi[j * 136] = (bf16_t)f2bf(qv * __expf(d)); ki[j * 136] = (bf16_t)f2bf(kv * __expf(-d)); }
        }
    }
    __syncthreads();
    ldsp qF = img, kF = img + 17408, qB = img + 34816, kB = img + 52224, Pm = kF;
    f32x16 af[1], ab[1];
    if (w < 4) {
        zero_acc(af); zero_acc(ab);
        mma_nx1<1>(af, kF, 272, 32 * (w >> 1), qF, 272, 32 * (w & 1), 8, r, hh);
        mma_nx1<1>(ab, kB, 272, 32 * (w >> 1), qB, 272, 32 * (w & 1), 8, r, hh);
    } else {
        const int t2 = tid - 256;
#pragma unroll 1
        for (int dir = 0; dir < 2; ++dir) {
            if (dir == 0 ? !hasF : !hasB) continue;
            const bf16_t* ST = (const bf16_t*)(p.ws + WS_HST) + ((size_t)(cg * 8 + h) * 2 + dir) * 16384;
            for (int u = t2; u < 2048; u += 256) { const int e = u >> 4, ch = u & 15;
                const u32x4 v = *(const u32x4*)(ST + e * 128 + ch * 8);
                const LAS float* rf = ref + dir * 128 + ch * 8;
                u32x4 o;
#pragma unroll
                for (int q = 0; q < 4; ++q) o[q] = pk2(bflo(v[q]) * rf[2 * q], bfhi(v[q]) * rf[2 * q + 1]);
                *(LAS u32x4*)(raw + dir * 34816 + e * 272 + ch * 16) = o; }
        }
    }
    __syncthreads();
    if (w < 4) {
        const int i = 32 * (w & 1) + r;
#pragma unroll
        for (int g = 0; g < 4; ++g) { float v[4];
#pragma unroll
            for (int e2 = 0; e2 < 4; ++e2) { const int j = 32 * (w >> 1) + 8 * g + 4 * hh + e2; v[e2] = (j <= i ? af[0][4 * g + e2] : 0.f) + (j >= i ? ab[0][4 * g + e2] : 0.f); }
            u32x2 o; o.x = pk2(v[0], v[1]); o.y = pk2(v[2], v[3]);
            *(LAS u32x2*)(Pm + i * 144 + (32 * (w >> 1) + 8 * g + 4 * hh) * 2) = o; }
    }
    __syncthreads();
    const int eb = w >> 1, ib = w & 1, i = 32 * ib + r;
    f32x16 acc[1]; zero_acc(acc);
    mma_nx1<1>(acc, vT, 144, 32 * eb, Pm, 144, 32 * ib, 4, r, hh);
    if (hasF) mma_nx1<1>(acc, raw, 272, 32 * eb, qF, 272, 32 * ib, 8, r, hh);
    if (hasB) mma_nx1<1>(acc, raw + 34816, 272, 32 * eb, qB, 272, 32 * ib, 8, r, hh);
    float ss = 0.f;
#pragma unroll
    for (int q = 0; q < 16; ++q) ss += acc[0][q] * acc[0][q];
    ss += __shfl_xor(ss, 32);
    if (hh == 0) red[eb * 64 + i] = ss;
    __syncthreads();
    const float rstd = rsqrtf((red[i] + red[64 + i] + red[128 + i] + red[192 + i]) * (1.0f / 128.0f) + EPS);
    const bf16_t* og = PR + (size_t)i * PROJ_LD + C_HOG + h * 128 + 32 * eb;
    const float* nw = p.in[16] + h * 128 + 32 * eb;
    bf16_t* O = (bf16_t*)(p.ws + WS_OHG) + (size_t)(pass * PASS_ROWS + cg * 64 + i) * 1024 + h * 128 + 32 * eb;
#pragma unroll
    for (int g = 0; g < 4; ++g) { const int e = 8 * g + 4 * hh; const u32x2 gv = *(const u32x2*)(og + e); const f32x4 n4 = *(const f32x4*)(nw + e);
        u32x2 o; o.x = pk2(acc[0][4 * g] * rstd * n4[0] * bflo(gv.x), acc[0][4 * g + 1] * rstd * n4[1] * bfhi(gv.x));
        o.y = pk2(acc[0][4 * g + 2] * rstd * n4[2] * bflo(gv.y), acc[0][4 * g + 3] * rstd * n4[3] * bfhi(gv.y));
        *(u32x2*)(O + e) = o; }
    __syncthreads();
}
DEVI int scan_nitems(int b, int G) { return G == 256 ? (b < 128 ? 2 : 3) : (640 - b + G - 1) / G; }
DEVI int scan_item(int b, int G, int k) { return G == 256 ? (b < 128 ? (k == 0 ? b : 128 + b) : 256 + (b - 128) * 3 + k) : b + k * G; }
#undef SCAN_A
#undef SCAN_B
#undef SCAN_C
#define SCAN_A { int tid = threadIdx.x; asm volatile("" : "+v"(tid)); const int n_ = scan_nitems(blockIdx.x, G); \
    for (int k_ = 0; k_ < n_; ++k_) { const int it_ = scan_item(blockIdx.x, G, k_); int t2_ = tid; asm volatile("" : "+v"(t2_)); if (it_ < 128) ret_stage_a(p, lds, pass, it_, t2_); else hg_stage_a(p, lds, pass, it_ - 128, t2_); } }
#define SCAN_B { int tid = threadIdx.x; asm volatile("" : "+v"(tid)); scan_stage_b(p, pass, tid, G); }
#define SCAN_C { int tid = threadIdx.x; asm volatile("" : "+v"(tid)); const int n_ = scan_nitems(blockIdx.x, G); \
    for (int k_ = 0; k_ < n_; ++k_) { const int it_ = scan_item(blockIdx.x, G, k_); int t2_ = tid; asm volatile("" : "+v"(t2_)); if (it_ < 128) ret_stage_c(p, lds, pass, it_, t2_); else hg_stage_c(p, lds, pass, it_ - 128, t2_); } }

constexpr int NWAVES = 8;
constexpr int LDS_BYTES = 163840;


DEVI float wave_sum(float v) {
#pragma unroll
    for (int o = 1; o < 64; o <<= 1) v += __shfl_xor(v, o);
    return v;
}

DEVI int map_row(int mode, int n) {
    if (mode == 1) { const int s = n >= 2816 ? 1 : 0, j = n - s * 2816; return 256 * (j >> 7) + 128 * s + (j & 127); }
    if (mode == 2) { if (n >= 1024) return n; const int t = n >> 8, q = n & 255, hh = q >> 7, part = (q >> 6) & 1, bj = (q >> 5) & 1, i = q & 31; return 256 * t + 128 * bj + 64 * hh + 32 * part + i; }
    return n;
}
DEVI void transpose_item(const float* __restrict__ W, int ldw, int n_base, bf16_t* __restrict__ WT, int Kdst, int koff, int mode, LAS float* scr, int item, int nblk, int lane) {
    const int kb = item / nblk, nb = item - kb * nblk, k0 = 64 * kb, n0 = 32 * nb;
#pragma unroll 8
    for (int i = 0; i < 32; ++i) { const int kk = 2 * i + (lane >> 5); scr[kk * 33 + (lane & 31)] = W[(size_t)(k0 + kk) * ldw + n_base + n0 + (lane & 31)]; }
    asm volatile("s_waitcnt lgkmcnt(0)" ::: "memory");
    const int c = lane & 7;
#pragma unroll
    for (int j = 0; j < 4; ++j) { const int n = (lane >> 3) + 8 * j; const LAS float* s = scr + (8 * c) * 33 + n;
        u32x4 o; o.x = pk2(s[0 * 33], s[1 * 33]); o.y = pk2(s[2 * 33], s[3 * 33]); o.z = pk2(s[4 * 33], s[5 * 33]); o.w = pk2(s[6 * 33], s[7 * 33]);
        *(u32x4*)(WT + (size_t)map_row(mode, n0 + n) * Kdst + koff + k0 + 8 * c) = o; }
    asm volatile("s_waitcnt lgkmcnt(0)" ::: "memory");
}
constexpr int I13 = 16 * 176, I2 = 44 * 32, IWIN = 16 * 256, IWG = 16 * 64, ISQ = 16 * 32;
constexpr int CV_G0 = I13, CV_G1 = I13 + I2 + I13 + I2, CV_ALL = 2 * I13 + 2 * I2 + IWIN + IWG + 3 * ISQ;
DEVI void convert_items(const P& p, ldsp lds, int lane, int wave, int first, int last, int worker, int nworkers) {
    LAS float* scr = (LAS float*)(lds + 32768 + wave * 8704);
    unsigned char* ws = p.ws;
    for (int it = first + worker * NWAVES + wave; it < last; it += nworkers * NWAVES) {
        int r = it;
        if (r < I13) { transpose_item(p.in[9], 5632, 0, (bf16_t*)(ws + WS_W13A), 1024, 0, 1, scr, r, 176, lane); continue; } r -= I13;
        if (r < I2) { transpose_item(p.in[10], 1024, 0, (bf16_t*)(ws + WS_W2A), 2816, 0, 0, scr, r, 32, lane); continue; } r -= I2;
        if (r < I13) { transpose_item(p.in[11], 5632, 0, (bf16_t*)(ws + WS_W13B), 1024, 0, 1, scr, r, 176, lane); continue; } r -= I13;
        if (r < I2) { transpose_item(p.in[12], 1024, 0, (bf16_t*)(ws + WS_W2B), 2816, 0, 0, scr, r, 32, lane); continue; } r -= I2;
        if (r < IWIN) { transpose_item(p.in[13], WIN_N, 0, (bf16_t*)(ws + WS_WIN), 1024, 0, 2, scr, r, 256, lane); continue; } r -= IWIN;
        if (r < IWG) { transpose_item(p.in[13], WIN_N, W_GR, (bf16_t*)(ws + WS_WG), 1024, 0, 0, scr, r, 64, lane); continue; } r -= IWG;
        if (r < ISQ) { transpose_item(p.in[17], 1024, 0, (bf16_t*)(ws + WS_WR), 1024, 0, 0, scr, r, 32, lane); continue; } r -= ISQ;
        if (r < ISQ) { transpose_item(p.in[18], 1024, 0, (bf16_t*)(ws + WS_WH), 1024, 0, 0, scr, r, 32, lane); continue; } r -= ISQ;
        transpose_item(p.in[19], 1024, 0, (bf16_t*)(ws + WS_WO), 1024, 0, 0, scr, r, 32, lane);
    }
}
DEVI void phase_prologue(const P& p, ldsp lds, int tid, int lane, int wave, int G) {
    if ((int)blockIdx.x < 144) {
        LAS float* sc = (LAS float*)lds;
        LAS float* red = sc + 5 * 1024;
        for (int i = tid; i < 5 * 1024; i += 512) { const int r = i >> 10, k = i & 1023; const float v = r == 0 ? p.in[5][k] : p.in[4][(r - 1) * 1024 + k]; sc[i] = siluf_(v); }
        __syncthreads();
        const int col = blockIdx.x * 64 + lane;
        const float* W = p.in[6];
        float a0 = 0.f, a1 = 0.f, a2 = 0.f, a3 = 0.f, a4 = 0.f;
#pragma unroll 8
        for (int kk = 0; kk < 128; ++kk) { const int k = wave * 128 + kk; const float w = W[(size_t)k * NMOD + col];
            a0 += sc[k] * w; a1 += sc[1024 + k] * w; a2 += sc[2048 + k] * w; a3 += sc[3072 + k] * w; a4 += sc[4096 + k] * w; }
        red[(wave * 5 + 0) * 64 + lane] = a0; red[(wave * 5 + 1) * 64 + lane] = a1; red[(wave * 5 + 2) * 64 + lane] = a2; red[(wave * 5 + 3) * 64 + lane] = a3; red[(wave * 5 + 4) * 64 + lane] = a4;
        __syncthreads();
        if (tid < 320) { const int r = tid >> 6, l = tid & 63; float s = 0.f;
#pragma unroll
            for (int w = 0; w < 8; ++w) s += red[(w * 5 + r) * 64 + l];
            const int cc = blockIdx.x * 64 + l;
            ((float*)(p.ws + WS_MOD))[r * NMOD + cc] = s + p.in[7][cc]; }
        __syncthreads();
    }
    if ((int)blockIdx.x == G - 1) {
        for (int i = tid; i < 2048; i += 512) {
            const int d = i >> 10, k = i & 1023;
            const float l0 = p.in[15][(d * 2 + 0) * 1024 + k], l1 = p.in[15][(d * 2 + 1) * 1024 + k];
            ((float*)(p.ws + WS_LB))[i] = 1.0f / (1.0f + expf(l1 - l0));
            const int pos = i >> 5, fi = i & 31;
            const double inv = exp(-(double)fi / 32.0 * log(10000.0));
            const float angf = (float)pos * (float)inv;
            double a = (double)angf; const double twopi = 6.283185307179586476925;
            a -= twopi * rint(a / twopi);
            double s = 0.0, c = 0.0, a2 = a * a, tc = 1.0, ts = a;
            for (int n = 0; n < 14; ++n) { c += tc; s += ts; tc *= -a2 / ((2 * n + 1) * (2 * n + 2)); ts *= -a2 / ((2 * n + 2) * (2 * n + 3)); }
            float* rt = (float*)(p.ws + WS_ROPE); rt[i * 2] = (float)c; rt[i * 2 + 1] = (float)s;
        }
    }
    convert_items(p, lds, lane, wave, 0, CV_G0, blockIdx.x, G);
}

template <int RB> DEVI void modnorm_rows(const P& p, int which, int lane, int m0, int mstep, int nrows) {
    f32x4 v[RB][4];
#pragma unroll
    for (int k = 0; k < RB; ++k) { const int m = m0 + k * mstep; if (k < nrows) {
        const float* xr = which == 0 ? (m < MP ? p.in[0] + (size_t)m * D : p.in[1] + (size_t)(m - MP) * D) : p.out + (size_t)m * D;
#pragma unroll
        for (int j = 0; j < 4; ++j) v[k][j] = *(const f32x4*)(xr + 4 * lane + 256 * j); } }
    f32x4 w[4];
    const float* nw = which == 3 ? p.in[20] : p.in[8] + which * D;
#pragma unroll
    for (int j = 0; j < 4; ++j) w[j] = *(const f32x4*)(nw + 4 * lane + 256 * j);
#pragma unroll
    for (int k = 0; k < RB; ++k) { const int m = m0 + k * mstep; if (k < nrows) {
        float ss = 0.f;
#pragma unroll
        for (int j = 0; j < 4; ++j) ss += (v[k][j][0] * v[k][j][0] + v[k][j][1] * v[k][j][1]) + (v[k][j][2] * v[k][j][2] + v[k][j][3] * v[k][j][3]);
        const float rstd = rsqrtf(wave_sum(ss) * (1.0f / D) + EPS);
        if (which == 3) {
            float* o = p.out + (size_t)m * D;
#pragma unroll
            for (int j = 0; j < 4; ++j) *(f32x4*)(o + 4 * lane + 256 * j) = v[k][j] * rstd * w[j];
        } else {
            const float* mod = (const float*)(p.ws + WS_MOD) + (size_t)mod_row(m) * NMOD;
            const float* sh = mod + (which * 3) * D; const float* sc = mod + (which * 3 + 1) * D;
            bf16_t* h = (bf16_t*)(p.ws + WS_H) + (size_t)m * D;
#pragma unroll
            for (int j = 0; j < 4; ++j) { const int c = 4 * lane + 256 * j;
                const f32x4 s4 = *(const f32x4*)(sc + c), h4 = *(const f32x4*)(sh + c);
                const f32x4 y = v[k][j] * rstd * w[j] * (s4 + 1.0f) + h4;
                u32x2 o; o.x = pk2(y[0], y[1]); o.y = pk2(y[2], y[3]); *(u32x2*)(h + c) = o; }
        } } }
}
DEVI void phase_modnorm(const P& p, int which, int lane, int wave, int G) {
    const int gw = blockIdx.x * NWAVES + wave, NGW = G * NWAVES;
    for (int m = gw; m < MT; m += 6 * NGW) { const int left = (MT - m + NGW - 1) / NGW; modnorm_rows<6>(p, which, lane, m, NGW, left < 6 ? left : 6); }
}

typedef GAS unsigned gu32;
#define RLX_AGENT __ATOMIC_RELAXED, __HIP_MEMORY_SCOPE_AGENT
constexpr size_t WS_BAR = 256 * 1024;
#define XB_TMO      128
#define XB_XCNT(j)  (256  + 64 * (j))
#define XB_XSUB(j)  (1280 + 64 * (j))
#define XB_XGEN(j)  (2304 + 64 * (j))
#define XB_TOP      3328
#define XB_TOPGEN   3392
#define XCD_BAR_WORDS 3456
#define XB_SPIN_CAP (1u << 18)

__device__ __forceinline__ unsigned xb_ld(unsigned* p)              { return __hip_atomic_load(p, __ATOMIC_RELAXED, __HIP_MEMORY_SCOPE_AGENT); }
__device__ __forceinline__ unsigned xb_add(unsigned* p, unsigned v) { return __hip_atomic_fetch_add(p, v, __ATOMIC_RELAXED, __HIP_MEMORY_SCOPE_AGENT); }
__device__ __forceinline__ unsigned xb_xcc_id() { return (unsigned)__builtin_amdgcn_s_getreg((3 << 11) | 20) & 0xFu; }
#define XB_SPIN(cond, bar) do { unsigned _sp = 0; while (cond) { __builtin_amdgcn_s_sleep(1); \
    if ((++_sp & 255u) == 0u) { if (xb_ld(&(bar)[XB_TMO])) break; if (_sp > XB_SPIN_CAP) { atomicAdd(&(bar)[XB_TMO], 1u); break; } } } } while (0)

struct XcdBarrier {
    unsigned* bar; unsigned x;
    volatile LAS unsigned* st;
};

__device__ __forceinline__ XcdBarrier xcd_barrier_post(unsigned* bar, volatile LAS unsigned* st) {
    XcdBarrier b; b.bar = bar; b.x = xb_xcc_id(); b.st = st;
    if (threadIdx.x == 0) (void)xb_add(&bar[XB_XCNT(b.x)], 1u);
    return b;
}
__device__ __forceinline__ void xcd_barrier_complete(unsigned* bar, unsigned x, unsigned& nloc, unsigned& nx) {
    const unsigned G = gridDim.x * gridDim.y * gridDim.z;
    unsigned sum, cnt, mine, sp = 0u;
    for (;;) {
        sum = 0u; cnt = 0u; mine = 0u;
#pragma unroll
        for (unsigned j = 0; j < 16; ++j) { const unsigned c = xb_ld(&bar[XB_XCNT(j)]); sum += c; cnt += (c > 0u) ? 1u : 0u; mine = (j == x) ? c : mine; }
        if (sum == G) break;
        __builtin_amdgcn_s_sleep(1);
        if ((++sp & 255u) == 0u) { if (xb_ld(&bar[XB_TMO])) break; if (sp > XB_SPIN_CAP) { atomicAdd(&bar[XB_TMO], 1u); break; } }
    }
    nloc = mine > 0u ? mine : 1u; nx = cnt > 0u ? cnt : 1u;
}

__device__ __forceinline__ void xcd_barrier(const XcdBarrier& b) {
    asm volatile("s_waitcnt vmcnt(0)" ::: "memory");
    __syncthreads();
    if (threadIdx.x == 0) {
        unsigned* bar = b.bar;
        __builtin_amdgcn_s_waitcnt(0);
        unsigned nloc = b.st[0], nx = b.st[1];
        if (nloc == 0u) { xcd_barrier_complete(bar, b.x, nloc, nx); b.st[0] = nloc; b.st[1] = nx; }
        const unsigned old = xb_add(&bar[XB_XSUB(b.x)], 1u);
        const unsigned gen = old / nloc;
        if (old + 1u == (gen + 1u) * nloc) {
            __builtin_amdgcn_fence(__ATOMIC_RELEASE, "agent");
            asm volatile("s_waitcnt vmcnt(0)" ::: "memory");
            const unsigned og = xb_add(&bar[XB_TOP], 1u);
            const unsigned tg = og / nx;
            if (og + 1u == (tg + 1u) * nx) xb_add(&bar[XB_TOPGEN], 1u);
            else XB_SPIN(xb_ld(&bar[XB_TOPGEN]) == tg, bar);
            __builtin_amdgcn_fence(__ATOMIC_ACQUIRE, "agent");
            xb_add(&bar[XB_XGEN(b.x)], 1u);
            asm volatile("s_waitcnt vmcnt(0)" ::: "memory");
        } else {
            XB_SPIN(xb_ld(&bar[XB_XGEN(b.x)]) == gen, bar);
            __builtin_amdgcn_fence(__ATOMIC_ACQUIRE, "agent");
            asm volatile("s_waitcnt vmcnt(0)" ::: "memory");
        }
    }
    __syncthreads();
}

#ifndef PHMASK
#define PHMASK 0xffff
#endif
#define PH(k) if (p.lo <= (k) && (k) < p.hi)
#define SYNC(k) do { if (p.lo <= (k) && (k) + 1 < p.hi) { if (p.hi > 1000) { asm volatile("s_waitcnt vmcnt(0) lgkmcnt(0)" ::: "memory"); cg::this_grid().sync(); } else xcd_barrier(bar); } } while (0)
#define GEMM_UP(WOFF) do { pg8::Gemm g{(const bf16_t*)(ws + WS_H), (const bf16_t*)(ws + (WOFF)), MT, 2 * FF, D}; \
    pg8::StaticOrder S; S.init(MT, 2 * FF, G, (int)blockIdx.x); pg8::EpiSwiglu E{(bf16_t*)(ws + WS_PROJ)}; \
    pg8::gemm_phase<pg8::EpiSwiglu, pg8::StaticOrder, true, true>(lds, g, S, E); } while (0)
#define GEMM_RES(AOFF, WOFF, KK, XP, XS, GIDX, SCL) do { pg8::Gemm g{(const bf16_t*)(ws + (AOFF)), (const bf16_t*)(ws + (WOFF)), MT, D, (KK)}; \
    pg8::StaticOrder S; S.init(MT, D, G, (int)blockIdx.x); pg8::EpiResid E{(XP), (XS), p.out, (const float*)(ws + WS_MOD), (GIDX), (SCL)}; \
    pg8::gemm_phase<pg8::EpiResid, pg8::StaticOrder, true, true>(lds, g, S, E); } while (0)

__global__ void __launch_bounds__(NWAVES * 64, 2) mk(P p) {
    extern __shared__ __attribute__((aligned(16))) unsigned char lds_raw[];
    ldsp lds = (ldsp)lds_raw;
    const int G = gridDim.x;
    unsigned char* ws = p.ws;
    volatile LAS unsigned* bst = (volatile LAS unsigned*)(lds + LDS_BYTES - 16);
    if (threadIdx.x < 2) bst[threadIdx.x] = 0u;
    __syncthreads();
    const XcdBarrier bar = xcd_barrier_post((unsigned*)(ws + WS_BAR), bst);
#define TIDS int tid = threadIdx.x; asm volatile("" : "+v"(tid)); const int lane = tid & 63, wave = __builtin_amdgcn_readfirstlane(tid >> 6); (void)lane; (void)wave;
    PH(0) { if (PHMASK & 1) { TIDS phase_prologue(p, lds, tid, lane, wave, G); } } SYNC(0);
    PH(1) { if (PHMASK & 2) { TIDS phase_modnorm(p, 0, lane, wave, G); } } SYNC(1);
    PH(2) { if (PHMASK & 4) GEMM_UP(WS_W13A);
        { const int idle0 = (MT / 256) * (2 * FF / 256) - 4 * G;
          if (G == 256 && (int)blockIdx.x >= idle0) { TIDS convert_items(p, lds, lane, wave, CV_G0, CV_G1, blockIdx.x - idle0, G - idle0); }
          else if (G != 256) { TIDS convert_items(p, lds, lane, wave, CV_G0, CV_G1, blockIdx.x, G); } } } SYNC(2);
    PH(3) { if (PHMASK & 8) GEMM_RES(WS_PROJ, WS_W2A, FF, p.in[0], p.in[1], 2, 0.5f);
        { const int idle0 = (MT / 256) * (D / 256);
          if (G == 256 && (int)blockIdx.x >= idle0) { TIDS convert_items(p, lds, lane, wave, CV_G1, CV_ALL, blockIdx.x - idle0, G - idle0); }
          else if (G != 256) { TIDS convert_items(p, lds, lane, wave, CV_G1, CV_ALL, blockIdx.x, G); } } } SYNC(3);
    PH(4) { if (PHMASK & 2) { TIDS phase_modnorm(p, 1, lane, wave, G); } } SYNC(4);
    for (int pass = 0; pass < 3; ++pass) {
        const int b = 5 + 4 * pass;
        PH(b) { if (PHMASK & 16) {
            pg8::Gemm g{(const bf16_t*)(ws + WS_H) + (size_t)pass * PASS_ROWS * D, (const bf16_t*)(ws + WS_WIN), PASS_ROWS, NPROJ, D};
            pg8::StaticOrder S; S.init(PASS_ROWS, NPROJ, G, (int)blockIdx.x);
            pg8::EpiWin E{(bf16_t*)(ws + WS_PROJ), (const float*)(ws + WS_LB), (const float*)(ws + WS_ROPE), pass};
            pg8::gemm_phase<pg8::EpiWin, pg8::StaticOrder, true, true>(lds, g, S, E); } } SYNC(b);
        PH(b + 1) { SCAN_A } SYNC(b + 1);
        PH(b + 2) { SCAN_B } SYNC(b + 2);
        PH(b + 3) { SCAN_C } SYNC(b + 3);
    }
    PH(17) { if (PHMASK & 32) {
        pg8::Gemm g{(const bf16_t*)(ws + WS_H), (const bf16_t*)(ws + WS_WG), MT, 2048, D};
        pg8::StaticOrder S; S.init(MT, 2048, G, (int)blockIdx.x);
        pg8::EpiGates E{(bf16_t*)(ws + WS_PROJ)};
        pg8::gemm_phase<pg8::EpiGates, pg8::StaticOrder, true, true>(lds, g, S, E); } } SYNC(17);
    PH(18) { if (PHMASK & 64) {
        { pg8::Gemm g{(const bf16_t*)(ws + WS_ORET), (const bf16_t*)(ws + WS_WR), MT, D, D};
          pg8::StaticOrder S; S.init(MT, D, G, (int)blockIdx.x);
          pg8::EpiMergeA E{(const bf16_t*)(ws + WS_PROJ), (float*)(ws + WS_ST)};
          pg8::gemm_phase<pg8::EpiMergeA, pg8::StaticOrder, true, true>(lds, g, S, E); }
        { pg8::Gemm g{(const bf16_t*)(ws + WS_OHG), (const bf16_t*)(ws + WS_WH), MT, D, D};
          pg8::StaticOrder S; S.init(MT, D, G, (int)blockIdx.x);
          pg8::EpiMergeB E{(const bf16_t*)(ws + WS_PROJ), (const float*)(ws + WS_ST), (bf16_t*)(ws + WS_H)};
          pg8::gemm_phase<pg8::EpiMergeB, pg8::StaticOrder, true, true>(lds, g, S, E); } } } SYNC(18);
    PH(19) { if (PHMASK & 8) GEMM_RES(WS_H, WS_WO, D, p.out, p.out + (size_t)MP * D, 5, 1.0f); } SYNC(19);
    PH(20) { if (PHMASK & 2) { TIDS phase_modnorm(p, 2, lane, wave, G); } } SYNC(20);
    PH(21) { if (PHMASK & 4) GEMM_UP(WS_W13B); } SYNC(21);
    PH(22) { if (PHMASK & 8) GEMM_RES(WS_PROJ, WS_W2B, FF, p.out, p.out + (size_t)MP * D, 8, 0.5f); } SYNC(22);
    PH(23) { if (PHMASK & 2) { TIDS phase_modnorm(p, 3, lane, wave, G); } }
}

static int g_grid = 0;
static void launch_mk(const P& base, int lo, int hi, hipStream_t stream, bool coop) {
    P p = base; p.lo = lo; p.hi = hi;
    if (coop) { void* args[] = {&p}; hipError_t e = hipLaunchCooperativeKernel((void*)mk, dim3(g_grid), dim3(NWAVES * 64), args, LDS_BYTES, stream);
        if (e != hipSuccess) fprintf(stderr, "cooperative launch failed: %s (grid %d)\n", hipGetErrorString(e), g_grid); }
    else hipLaunchKernelGGL(mk, dim3(g_grid), dim3(NWAVES * 64), LDS_BYTES, stream, p);
}

extern "C" void kernel_launch(void* const* d_in, const int* in_sizes, int n_in, void* d_out, int out_size, void* d_ws, size_t ws_size, hipStream_t stream) {
    if (g_grid == 0) {
        int dev = 0, cus = 0, per_cu = 0;
        hipGetDevice(&dev);
        hipDeviceGetAttribute(&cus, hipDeviceAttributeMultiprocessorCount, dev);
        hipFuncSetAttribute((const void*)mk, hipFuncAttributeMaxDynamicSharedMemorySize, LDS_BYTES);
        hipOccupancyMaxActiveBlocksPerMultiprocessor(&per_cu, (const void*)mk, NWAVES * 64, LDS_BYTES);
        if (per_cu < 1) per_cu = 1;
        g_grid = cus * per_cu;
        (void)hipGetLastError();
    }
    P p{};
    for (int i = 0; i < 21; ++i) p.in[i] = (const float*)d_in[i];
    p.out = (float*)d_out; p.ws = (unsigned char*)d_ws;
#if HYBRID
    launch_mk(p, 0, 5, stream, true);
    for (int pass = 0; pass < 3; ++pass) {
        const int nseq = pass == 0 ? 16 : 2;
        launch_mk(p, 5 + 4 * pass, 9 + 4 * pass, stream, true);
#if HYBRID == 2 || HYBRID == 4
        k_ret_scan<<<nseq * 8, 256, 0, stream>>>(p, pass);
        k_ret_fin<<<PASS_ROWS * 4 / 4, 256, 0, stream>>>(p, pass);
#endif
#if HYBRID == 3 || HYBRID == 4
        k_hg_scan<<<nseq * 16, 128, 0, stream>>>(p, pass);
        k_hg_fin<<<PASS_ROWS * 8 / 4, 256, 0, stream>>>(p, pass);
#endif
    }
    launch_mk(p, 17, 24, stream, true);
#else
    (void)hipMemsetAsync((char*)d_ws + WS_BAR, 0, 16384, stream);
    launch_mk(p, 0, 24, stream, true);
#endif
}
```
